# Optimizing an MI355X kernel written in HIP

```python
import math
import jax, jax.numpy as jnp
from jax import lax
import numpy as np

D_MODEL = 1024
BATCH = 8
SEQ = 2048
DEPTH = 1

HEAD_DIM = 64
ATTN_GROUPS = ((128, 1), (512, 4), (2048, 16))
HEADS_PER_GROUP = 4
N_ATTN_HEADS = HEADS_PER_GROUP * len(ATTN_GROUPS)
ATTN_WIDTH = N_ATTN_HEADS * HEAD_DIM
ATTN_OUT_WIDTH = HEADS_PER_GROUP * HEAD_DIM
CONV_WIDTH = D_MODEL
CONV_K = 3
N_BUCKETS = 32
MAX_DISTANCE = 2048
N_EXPERTS = 32
TOP_K = 4
D_EXPERT = D_MODEL
SWIGLU_LIMIT = 7.0
SWIGLU_ALPHA = 1.702
MOE_BLOCK = 128
EPS = 1e-6
IN_SPLITS = (CONV_WIDTH, CONV_WIDTH, CONV_WIDTH, ATTN_WIDTH, ATTN_WIDTH, ATTN_WIDTH, D_MODEL, D_MODEL)
IN_WIDTH = sum(IN_SPLITS)
IN_CUTS = tuple(int(c) for c in np.cumsum(IN_SPLITS)[:-1])

kernel_name = "hybrid_gated_conv_dilated_attn_moe"


def rms_norm(x, g):
    xf = x.astype(jnp.float32)
    y = xf * lax.rsqrt(jnp.mean(xf * xf, axis=-1, keepdims=True) + EPS)
    return (y * g.astype(jnp.float32)).astype(x.dtype)


def t5_causal_bucket(dist):
    max_exact = N_BUCKETS // 2
    d = jnp.maximum(dist.astype(jnp.float32), 1.0)
    large = max_exact + (jnp.log(d / max_exact) / math.log(MAX_DISTANCE / max_exact)
                         * (N_BUCKETS - max_exact)).astype(jnp.int32)
    large = jnp.minimum(large, N_BUCKETS - 1)
    return jnp.where(dist < max_exact, dist, large)


def dilated_window_attention(q, k, v, rel_bias_g, window, dil):
    B, S, H, Dh = q.shape
    blk = window // dil
    L = -(-S // (dil * blk)) * blk
    pad = L * dil - S
    nblk = L // blk

    def to_blocks(t):
        t = jnp.pad(t, ((0, 0), (0, pad), (0, 0), (0, 0))).reshape(B, L, dil, H, Dh)
        return t.transpose(0, 2, 3, 1, 4).reshape(B, dil, H, nblk, blk, Dh)

    def with_prev(t):
        prev = jnp.pad(t, ((0, 0), (0, 0), (0, 0), (1, 0), (0, 0), (0, 0)))[:, :, :, :-1]
        return jnp.concatenate([prev, t], axis=4)

    qb = to_blocks(q)
    kw = with_prev(to_blocks(k))
    vw = with_prev(to_blocks(v))

    qi = jnp.arange(blk)[:, None]
    kj = jnp.arange(2 * blk)[None, :]
    delta = qi + blk - kj
    band = (delta >= 0) & (delta <= blk)
    valid = band[None] & ((jnp.arange(nblk)[:, None, None] > 0) | (kj[None] >= blk))
    bucket = t5_causal_bucket(jnp.clip(delta, 0, blk) * dil)
    bias = rel_bias_g[bucket].transpose(2, 0, 1).astype(jnp.float32)

    logits = jnp.einsum('brhnqd,brhnkd->brhnqk', qb, kw,
                        preferred_element_type=jnp.float32) * (Dh ** -0.5)
    logits = logits + bias[:, None]
    logits = jnp.where(valid, logits, -jnp.inf)
    m = jnp.max(logits, axis=-1, keepdims=True)
    p = jnp.exp(logits - m)
    s = jnp.sum(p, axis=-1, keepdims=True)
    o = jnp.einsum('brhnqk,brhnkd->brhnqd', p, vw.astype(jnp.float32)) / s
    lse = (m + jnp.log(s))[..., 0]

    o = o.reshape(B, dil, H, L, Dh).transpose(0, 3, 1, 2, 4).reshape(B, L * dil, H, Dh)[:, :S]
    lse = lse.reshape(B, dil, H, L).transpose(0, 3, 1, 2).reshape(B, L * dil, H)[:, :S]
    return o, lse


def token_mixer(h, w_in, q_norm_g, k_norm_g, rel_bias, conv_w, w_branch_conv, w_branch_attn, w_out):
    B, S, _ = h.shape
    proj = h @ w_in
    c_b, c_c, c_x, q, k, v, g_conv, g_attn = jnp.split(proj, IN_CUTS, axis=-1)

    u = c_c * c_x
    u = lax.conv_general_dilated(u, conv_w.reshape(CONV_K, 1, CONV_WIDTH).astype(u.dtype),
                                 window_strides=(1,), padding=[(CONV_K - 1, 0)],
                                 dimension_numbers=('NWC', 'WIO', 'NWC'),
                                 feature_group_count=CONV_WIDTH)
    y_conv = (c_b * u) @ w_branch_conv

    q = rms_norm(q.reshape(B, S, N_ATTN_HEADS, HEAD_DIM), q_norm_g)
    k = rms_norm(k.reshape(B, S, N_ATTN_HEADS, HEAD_DIM), k_norm_g)
    v = v.reshape(B, S, N_ATTN_HEADS, HEAD_DIM)
    outs, lses = [], []
    for gi, (window, dil) in enumerate(ATTN_GROUPS):
        hs = slice(gi * HEADS_PER_GROUP, (gi + 1) * HEADS_PER_GROUP)
        o_g, lse_g = dilated_window_attention(q[:, :, hs], k[:, :, hs], v[:, :, hs],
                                              rel_bias[:, hs], window, dil)
        outs.append(o_g)
        lses.append(lse_g)
    outs = jnp.stack(outs, axis=0)
    wts = jax.nn.softmax(jnp.stack(lses, axis=0), axis=0)
    o = jnp.sum(wts[..., None] * outs, axis=0).astype(h.dtype)
    y_attn = o.reshape(B, S, ATTN_OUT_WIDTH) @ w_branch_attn

    merged = jax.nn.sigmoid(g_conv) * y_conv + jax.nn.sigmoid(g_attn) * y_attn
    return merged @ w_out


def moe(h, w_router, b_router, w_gate_up, b_gate_up, w_down, b_down):
    B, S, D = h.shape
    T = B * S
    TK = T * TOP_K
    hf = h.reshape(T, D)
    logits = (hf @ w_router + b_router).astype(jnp.float32)
    top_vals, top_idx = lax.top_k(logits, TOP_K)
    gates = jax.nn.softmax(top_vals, axis=-1).astype(h.dtype)

    flat_e = top_idx.reshape(-1)
    flat_tok = jnp.arange(TK, dtype=jnp.int32) // TOP_K
    order = jnp.argsort(flat_e, stable=True)
    sorted_e = flat_e[order]
    sorted_tok = flat_tok[order]
    sorted_w = gates.reshape(-1)[order]

    counts = jax.ops.segment_sum(jnp.ones((TK,), jnp.int32), flat_e, num_segments=N_EXPERTS)
    start = jnp.cumsum(counts) - counts
    pcounts = (counts + MOE_BLOCK - 1) // MOE_BLOCK * MOE_BLOCK
    pend = jnp.cumsum(pcounts)
    poff = pend - pcounts
    dest = poff[sorted_e] + (jnp.arange(TK, dtype=jnp.int32) - start[sorted_e])

    p_max = TK + N_EXPERTS * MOE_BLOCK
    n_blocks = p_max // MOE_BLOCK
    row_tok = jnp.full((p_max,), T, jnp.int32).at[dest].set(sorted_tok)
    hp = jnp.concatenate([hf, jnp.zeros((1, D), hf.dtype)], axis=0)
    xs = hp[row_tok].reshape(n_blocks, MOE_BLOCK, D)
    block_e = jnp.clip(jnp.searchsorted(pend, jnp.arange(n_blocks) * MOE_BLOCK, side='right'),
                       0, N_EXPERTS - 1)

    def expert_block(args):
        xb, e = args
        gu = xb @ w_gate_up[e] + b_gate_up[e]
        gate, up = gu[:, :D_EXPERT], gu[:, D_EXPERT:]
        gate = jnp.minimum(gate, SWIGLU_LIMIT)
        up = jnp.clip(up, -SWIGLU_LIMIT, SWIGLU_LIMIT)
        act = (up + 1) * (gate * jax.nn.sigmoid(SWIGLU_ALPHA * gate))
        return act @ w_down[e] + b_down[e]

    ys = lax.map(expert_block, (xs, block_e)).reshape(p_max, D)
    y_assign = ys[dest] * sorted_w[:, None]
    out = jax.ops.segment_sum(y_assign, sorted_tok, num_segments=T)
    return out.reshape(B, S, D)


def setup_inputs(seed: int = 0) -> dict:
    key = jax.random.key(seed)
    ks = jax.random.split(key, 20)
    f32 = jnp.float32
    nrm = lambda k, shape, scale: jax.random.normal(k, shape, f32) * scale
    return {
        "x": nrm(ks[0], (BATCH, SEQ, D_MODEL), 1.0),
        "norm1_g": 1.0 + nrm(ks[1], (DEPTH, D_MODEL), 0.01),
        "w_in": nrm(ks[2], (DEPTH, D_MODEL, IN_WIDTH), D_MODEL ** -0.5),
        "q_norm_g": 1.0 + nrm(ks[3], (DEPTH, HEAD_DIM), 0.01),
        "k_norm_g": 1.0 + nrm(ks[4], (DEPTH, HEAD_DIM), 0.01),
        "rel_bias": nrm(ks[5], (N_BUCKETS, N_ATTN_HEADS), 0.1),
        "conv_w": nrm(ks[6], (DEPTH, CONV_K, CONV_WIDTH), CONV_K ** -0.5),
        "w_branch_conv": nrm(ks[7], (DEPTH, CONV_WIDTH, D_MODEL), CONV_WIDTH ** -0.5),
        "w_branch_attn": nrm(ks[8], (DEPTH, ATTN_OUT_WIDTH, D_MODEL), ATTN_OUT_WIDTH ** -0.5),
        "w_out": nrm(ks[9], (DEPTH, D_MODEL, D_MODEL), D_MODEL ** -0.5),
        "norm2_g": 1.0 + nrm(ks[10], (DEPTH, D_MODEL), 0.01),
        "w_router": nrm(ks[11], (DEPTH, D_MODEL, N_EXPERTS), D_MODEL ** -0.5),
        "b_router": nrm(ks[12], (DEPTH, N_EXPERTS), 0.01),
        "w_gate_up": nrm(ks[13], (DEPTH, N_EXPERTS, D_MODEL, 2 * D_EXPERT), D_MODEL ** -0.5),
        "b_gate_up": nrm(ks[14], (DEPTH, N_EXPERTS, 2 * D_EXPERT), 0.01),
        "w_down": nrm(ks[15], (DEPTH, N_EXPERTS, D_EXPERT, D_MODEL), D_EXPERT ** -0.5),
        "b_down": nrm(ks[16], (DEPTH, N_EXPERTS, D_MODEL), 0.01),
    }


def reference(x, norm1_g, w_in, q_norm_g, k_norm_g, rel_bias, conv_w, w_branch_conv,
              w_branch_attn, w_out, norm2_g, w_router, b_router, w_gate_up, b_gate_up,
              w_down, b_down):
    for l in range(DEPTH):
        h = rms_norm(x, norm1_g[l])
        x = x + token_mixer(h, w_in[l], q_norm_g[l], k_norm_g[l], rel_bias, conv_w[l],
                            w_branch_conv[l], w_branch_attn[l], w_out[l])
        h = rms_norm(x, norm2_g[l])
        x = x + moe(h, w_router[l], b_router[l], w_gate_up[l], b_gate_up[l],
                    w_down[l], b_down[l])
    return x
```

```cpp
#include <hip/hip_runtime.h>
#include <stdint.h>

constexpr int B_ = 8, S_ = 2048, D_ = 1024, T_ = B_ * S_;
constexpr int NH = 12, HD = 64, AOW = 256, INW = 7424;
constexpr int NE = 32, TOPK = 4;
constexpr int OFF_CB = 0, OFF_CC = 1024, OFF_CX = 2048, OFF_Q = 3072, OFF_K = 3840, OFF_V = 4608, OFF_GC = 5376, OFF_GA = 6400;
constexpr float EPS = 1e-6f;
constexpr size_t MiB = 1u << 20;

struct GemmArgs {
    const float* A; long long lda; const int* rowidx; size_t rowidx_zstride;
    const float* Bm; long long ldb; size_t b_zstride;
    const int* Mcount; long long M; long long N; long long K;
};
template <class Epi>
__global__ __launch_bounds__(256) void sgemm_k(GemmArgs g, Epi epi) {
    __shared__ float As[16][68];
    __shared__ float Bs[16][68];
    const int tid = threadIdx.x, tx = tid & 15, ty = tid >> 4, z = blockIdx.z;
    const int M = g.Mcount ? g.Mcount[z] : (int)g.M;
    const int m0 = blockIdx.y * 64, n0 = blockIdx.x * 64;
    if (m0 >= M) return;
    const float* Bp = g.Bm + (size_t)z * g.b_zstride;
    const int* ridx = g.rowidx ? g.rowidx + (size_t)z * g.rowidx_zstride : nullptr;
    float acc[4][4];
#pragma unroll
    for (int i = 0; i < 4; ++i)
#pragma unroll
        for (int j = 0; j < 4; ++j) acc[i][j] = 0.f;
    const int ar = tid >> 2, akq = (tid & 3) * 4;
    const int gr = m0 + ar;
    int src = -1;
    if (gr < M) src = ridx ? ridx[gr] : gr;
    const int bk = tid >> 4, bnq = (tid & 15) * 4;
    const int Kd = (int)g.K, lda = (int)g.lda, ldb = (int)g.ldb;
    for (int k0 = 0; k0 < Kd; k0 += 16) {
        float4 av = make_float4(0.f, 0.f, 0.f, 0.f);
        if (src >= 0) av = *(const float4*)&g.A[(size_t)src * lda + k0 + akq];
        As[akq + 0][ar] = av.x; As[akq + 1][ar] = av.y; As[akq + 2][ar] = av.z; As[akq + 3][ar] = av.w;
        const float4 bv = *(const float4*)&Bp[(size_t)(k0 + bk) * ldb + n0 + bnq];
        *(float4*)&Bs[bk][bnq] = bv;
        __syncthreads();
#pragma unroll
        for (int kk = 0; kk < 16; ++kk) {
            const float4 a = *(const float4*)&As[kk][ty * 4];
            const float4 b = *(const float4*)&Bs[kk][tx * 4];
            const float aa[4] = {a.x, a.y, a.z, a.w}, bb[4] = {b.x, b.y, b.z, b.w};
#pragma unroll
            for (int i = 0; i < 4; ++i)
#pragma unroll
                for (int j = 0; j < 4; ++j) acc[i][j] = fmaf(aa[i], bb[j], acc[i][j]);
        }
        __syncthreads();
    }
#pragma unroll
    for (int i = 0; i < 4; ++i) {
        const int r = m0 + ty * 4 + i;
        if (r < M) {
#pragma unroll
            for (int j = 0; j < 4; ++j) epi(z, r, n0 + tx * 4 + j, acc[i][j]);
        }
    }
}

struct EpiStore { float* C; long long ldc; __device__ void operator()(int, int r, int c, float v) const { C[(size_t)r * ldc + c] = v; } };
struct EpiResid { float* C; const float* X; long long ldc; __device__ void operator()(int, int r, int c, float v) const { C[(size_t)r * ldc + c] = X[(size_t)r * ldc + c] + v; } };
struct EpiGU { float* GU; const float* bias; const int* poff; __device__ void operator()(int z, int r, int c, float v) const { GU[(size_t)(poff[z] + r) * 2048 + c] = v + bias[(size_t)z * 2048 + c]; } };
struct EpiDown { float* YS; const float* bias; const int* poff; __device__ void operator()(int z, int r, int c, float v) const { YS[(size_t)(poff[z] + r) * 1024 + c] = v + bias[(size_t)z * 1024 + c]; } };

__global__ __launch_bounds__(256) void rmsnorm_k(const float* x, const float* g, float* out, int rows) {
    const int w = (blockIdx.x * 256 + threadIdx.x) >> 6, lane = threadIdx.x & 63;
    if (w >= rows) return;
    const float* xr = x + (size_t)w * 1024;
    float v[16]; float ss = 0.f;
#pragma unroll
    for (int i = 0; i < 16; ++i) { v[i] = xr[lane + 64 * i]; ss += v[i] * v[i]; }
#pragma unroll
    for (int o = 32; o >= 1; o >>= 1) ss += __shfl_xor(ss, o);
    const float rstd = rsqrtf(ss * (1.f / 1024.f) + EPS);
#pragma unroll
    for (int i = 0; i < 16; ++i) out[(size_t)w * 1024 + lane + 64 * i] = v[i] * rstd * g[lane + 64 * i];
}

__global__ __launch_bounds__(256) void qknorm_k(float* proj, const float* gq, const float* gk) {
    const int w = (blockIdx.x * 256 + threadIdx.x) >> 6, lane = threadIdx.x & 63;
    if (w >= T_ * 24) return;
    const int t = w / 24, r = w % 24, isk = r / 12, h = r % 12;
    float* p = proj + (size_t)t * INW + (isk ? OFF_K : OFF_Q) + h * 64;
    const float v = p[lane]; float ss = v * v;
#pragma unroll
    for (int o = 32; o >= 1; o >>= 1) ss += __shfl_xor(ss, o);
    const float rstd = rsqrtf(ss * (1.f / 64.f) + EPS);
    p[lane] = v * rstd * (isk ? gk[lane] : gq[lane]);
}

__global__ __launch_bounds__(256) void conv_k(const float* proj, const float* cw, float* cbu) {
    const size_t idx = (size_t)blockIdx.x * 256 + threadIdx.x;
    if (idx >= (size_t)T_ * 1024) return;
    const int t = (int)(idx >> 10), c = (int)(idx & 1023), s = t % S_;
    const float* p = proj + (size_t)t * INW;
    float acc = cw[2 * 1024 + c] * (p[OFF_CC + c] * p[OFF_CX + c]);
    if (s >= 1) { const float* p1 = p - INW; acc += cw[1 * 1024 + c] * (p1[OFF_CC + c] * p1[OFF_CX + c]); }
    if (s >= 2) { const float* p2 = p - 2 * INW; acc += cw[0 * 1024 + c] * (p2[OFF_CC + c] * p2[OFF_CX + c]); }
    cbu[idx] = p[OFF_CB + c] * acc;
}

__global__ void bucket_k(int* tab) {
    const int i = threadIdx.x + blockIdx.x * blockDim.x;
    if (i >= 3 * 129) return;
    const int g = i / 129, dl = i % 129, dil = (g == 0) ? 1 : (g == 1 ? 4 : 16);
    const int dist = dl * dil;
    int b;
    if (dist < 16) b = dist;
    else { const double x = log((double)dist / 16.0) / log(128.0) * 16.0; b = 16 + (int)x; if (b > 31) b = 31; }
    tab[i] = b;
}

__global__ __launch_bounds__(256) void attn_k(const float* proj, const float* rel_bias, const int* btab, float* o) {
    __shared__ float sp[4][400];
    __shared__ int   st[4][400];
    const int wl = threadIdx.x >> 6, lane = threadIdx.x & 63;
    const int w = blockIdx.x * 4 + wl;
    const int t = w >> 2, j = w & 3, s = t % S_;
    float mx = -INFINITY;
    for (int i = lane; i < 387; i += 64) {
        const int g = i / 129, dl = i % 129, dil = (g == 0) ? 1 : (g == 1 ? 4 : 16);
        const int sk = s - dl * dil;
        float sc = -INFINITY;
        if (sk >= 0) {
            const int h = g * 4 + j;
            const float* q = proj + (size_t)t * INW + OFF_Q + h * 64;
            const float* k = proj + (size_t)(t - dl * dil) * INW + OFF_K + h * 64;
            float d = 0.f;
            for (int e = 0; e < 64; ++e) d = fmaf(q[e], k[e], d);
            sc = d * 0.125f + rel_bias[btab[i] * 12 + h];
        }
        sp[wl][i] = sc; st[wl][i] = sk;
        mx = fmaxf(mx, sc);
    }
#pragma unroll
    for (int o2 = 32; o2 >= 1; o2 >>= 1) mx = fmaxf(mx, __shfl_xor(mx, o2));
    float sum = 0.f;
    for (int i = lane; i < 387; i += 64) { const float sc = sp[wl][i]; const float p = (sc == -INFINITY) ? 0.f : __expf(sc - mx); sp[wl][i] = p; sum += p; }
#pragma unroll
    for (int o2 = 32; o2 >= 1; o2 >>= 1) sum += __shfl_xor(sum, o2);
    __syncthreads();
    float acc = 0.f;
    for (int i = 0; i < 387; ++i) {
        const float p = sp[wl][i];
        if (p != 0.f) {
            const int g = i / 129, dl = i % 129, dil = (g == 0) ? 1 : (g == 1 ? 4 : 16);
            acc = fmaf(p, proj[(size_t)(t - dl * dil) * INW + OFF_V + (g * 4 + j) * 64 + lane], acc);
        }
    }
    o[(size_t)t * AOW + j * 64 + lane] = acc / sum;
}

__global__ __launch_bounds__(256) void merge_k(const float* proj, const float* yc, const float* ya, float* merged) {
    const size_t idx = (size_t)blockIdx.x * 256 + threadIdx.x;
    if (idx >= (size_t)T_ * 1024) return;
    const int t = (int)(idx >> 10), c = (int)(idx & 1023);
    const float gc = proj[(size_t)t * INW + OFF_GC + c], ga = proj[(size_t)t * INW + OFF_GA + c];
    merged[idx] = yc[idx] / (1.f + __expf(-gc)) + ya[idx] / (1.f + __expf(-ga));
}

__global__ __launch_bounds__(256) void router_k(const float* h2, const float* wr, const float* br, int* counts, int* lists, int* tok_e, int* tok_slot, float* tok_w) {
    const int w = (blockIdx.x * 256 + threadIdx.x) >> 6, lane = threadIdx.x & 63;
    if (w >= T_) return;
    const float* xr = h2 + (size_t)w * 1024;
    float xv[16];
#pragma unroll
    for (int i = 0; i < 16; ++i) xv[i] = xr[lane + 64 * i];
    float bv0 = -INFINITY, bv1 = -INFINITY, bv2 = -INFINITY, bv3 = -INFINITY; int bi0 = 0, bi1 = 0, bi2 = 0, bi3 = 0;
    for (int e = 0; e < NE; ++e) {
        float d = 0.f;
#pragma unroll
        for (int i = 0; i < 16; ++i) d = fmaf(xv[i], wr[(size_t)(lane + 64 * i) * NE + e], d);
#pragma unroll
        for (int o = 32; o >= 1; o >>= 1) d += __shfl_xor(d, o);
        d += br[e];
        if (d > bv0) { bv3 = bv2; bi3 = bi2; bv2 = bv1; bi2 = bi1; bv1 = bv0; bi1 = bi0; bv0 = d; bi0 = e; }
        else if (d > bv1) { bv3 = bv2; bi3 = bi2; bv2 = bv1; bi2 = bi1; bv1 = d; bi1 = e; }
        else if (d > bv2) { bv3 = bv2; bi3 = bi2; bv2 = d; bi2 = e; }
        else if (d > bv3) { bv3 = d; bi3 = e; }
    }
    if (lane == 0) {
        const float e0 = 1.f, e1 = __expf(bv1 - bv0), e2 = __expf(bv2 - bv0), e3 = __expf(bv3 - bv0);
        const float inv = 1.f / (e0 + e1 + e2 + e3);
        const int ee[4] = {bi0, bi1, bi2, bi3}; const float ww[4] = {e0 * inv, e1 * inv, e2 * inv, e3 * inv};
#pragma unroll
        for (int k = 0; k < 4; ++k) {
            const int slot = atomicAdd(&counts[ee[k]], 1);
            lists[(size_t)ee[k] * T_ + slot] = w;
            tok_e[w * 4 + k] = ee[k]; tok_slot[w * 4 + k] = slot; tok_w[w * 4 + k] = ww[k];
        }
    }
}
__global__ void poff_k(const int* counts, int* poff) {
    if (threadIdx.x == 0) { int a = 0; for (int e = 0; e < NE; ++e) { poff[e] = a; a += (counts[e] + 63) / 64 * 64; } }
}
__global__ __launch_bounds__(256) void act_k(const float* gu, float* act, const int* counts, const int* poff) {
    const int e = blockIdx.y; const int cnt = counts[e];
    for (size_t idx = (size_t)blockIdx.x * 256 + threadIdx.x; idx < (size_t)cnt * 1024; idx += (size_t)gridDim.x * 256) {
        const int r = (int)(idx >> 10), c = (int)(idx & 1023);
        const float* gr = gu + (size_t)(poff[e] + r) * 2048;
        float gate = fminf(gr[c], 7.f); float up = fminf(fmaxf(gr[1024 + c], -7.f), 7.f);
        act[(size_t)(poff[e] + r) * 1024 + c] = (up + 1.f) * (gate / (1.f + __expf(-1.702f * gate)));
    }
}
__global__ __launch_bounds__(256) void combine_k(float* out, const float* ys, const int* tok_e, const int* tok_slot, const float* tok_w, const int* poff) {
    const size_t idx = (size_t)blockIdx.x * 256 + threadIdx.x;
    if (idx >= (size_t)T_ * 1024) return;
    const int t = (int)(idx >> 10), c = (int)(idx & 1023);
    float a = out[idx];
#pragma unroll
    for (int k = 0; k < 4; ++k) a += tok_w[t * 4 + k] * ys[(size_t)(poff[tok_e[t * 4 + k]] + tok_slot[t * 4 + k]) * 1024 + c];
    out[idx] = a;
}

__global__ void fill_k(int* idx2, const int* counts, const int* poff) { const int e = blockIdx.y; for (int r = blockIdx.x * 256 + threadIdx.x; r < counts[e]; r += gridDim.x * 256) idx2[(size_t)e * T_ + r] = poff[e] + r; }

extern "C" void kernel_launch(void* const* d_in, const int* in_sizes, int n_in, void* d_out, int out_size, void* d_ws, size_t ws_size, hipStream_t stream) {
    const float* x = (const float*)d_in[0]; const float* n1g = (const float*)d_in[1]; const float* w_in = (const float*)d_in[2];
    const float* gq = (const float*)d_in[3]; const float* gk = (const float*)d_in[4]; const float* relb = (const float*)d_in[5];
    const float* convw = (const float*)d_in[6]; const float* w_bc = (const float*)d_in[7]; const float* w_ba = (const float*)d_in[8];
    const float* w_out = (const float*)d_in[9]; const float* n2g = (const float*)d_in[10]; const float* w_r = (const float*)d_in[11];
    const float* b_r = (const float*)d_in[12]; const float* w_gu = (const float*)d_in[13]; const float* b_gu = (const float*)d_in[14];
    const float* w_d = (const float*)d_in[15]; const float* b_d = (const float*)d_in[16];
    float* out = (float*)d_out; char* ws = (char*)d_ws;
    float* proj = (float*)(ws);
    float* h = (float*)(ws + 512 * MiB);
    float* cbu = (float*)(ws + 576 * MiB);
    float* o = (float*)(ws + 640 * MiB);
    float* ya = (float*)(ws + 656 * MiB);
    float* yc = (float*)(ws + 720 * MiB);
    float* merged = (float*)(ws + 784 * MiB);
    char* small = ws + 1000 * MiB;
    int* counts = (int*)small; int* poff = (int*)(small + 256); int* btab = (int*)(small + 1024);
    int* tok_e = (int*)(small + 1 * MiB); int* tok_slot = (int*)(small + 2 * MiB); float* tok_w = (float*)(small + 3 * MiB);
    int* lists = (int*)(small + 4 * MiB);
    float* gu = (float*)(ws);
    float* h2 = (float*)(ws + 900 * MiB);
    float* act = (float*)(ws + 576 * MiB);
    float* ys = (float*)(ws);

    (void)hipMemsetAsync(counts, 0, 256, stream);
    rmsnorm_k<<<T_ / 4, 256, 0, stream>>>(x, n1g, h, T_);
    { GemmArgs g{h, 1024, nullptr, 0, w_in, INW, 0, nullptr, T_, INW, 1024}; sgemm_k<<<dim3(INW / 64, T_ / 64, 1), 256, 0, stream>>>(g, EpiStore{proj, INW}); }
    qknorm_k<<<T_ * 24 / 4, 256, 0, stream>>>(proj, gq, gk);
    conv_k<<<T_ * 1024 / 256, 256, 0, stream>>>(proj, convw, cbu);
    bucket_k<<<2, 256, 0, stream>>>(btab);
    attn_k<<<T_, 256, 0, stream>>>(proj, relb, btab, o);
    { GemmArgs g{cbu, 1024, nullptr, 0, w_bc, 1024, 0, nullptr, T_, 1024, 1024}; sgemm_k<<<dim3(16, T_ / 64, 1), 256, 0, stream>>>(g, EpiStore{yc, 1024}); }
    { GemmArgs g{o, 256, nullptr, 0, w_ba, 1024, 0, nullptr, T_, 1024, 256}; sgemm_k<<<dim3(16, T_ / 64, 1), 256, 0, stream>>>(g, EpiStore{ya, 1024}); }
    merge_k<<<T_ * 1024 / 256, 256, 0, stream>>>(proj, yc, ya, merged);
    { GemmArgs g{merged, 1024, nullptr, 0, w_out, 1024, 0, nullptr, T_, 1024, 1024}; sgemm_k<<<dim3(16, T_ / 64, 1), 256, 0, stream>>>(g, EpiResid{out, x, 1024}); }
    rmsnorm_k<<<T_ / 4, 256, 0, stream>>>(out, n2g, h2, T_);
    router_k<<<T_ / 4, 256, 0, stream>>>(h2, w_r, b_r, counts, lists, tok_e, tok_slot, tok_w);
    poff_k<<<1, 64, 0, stream>>>(counts, poff);
    { GemmArgs g{h2, 1024, lists, (size_t)T_, w_gu, 2048, (size_t)1024 * 2048, counts, 0, 2048, 1024}; sgemm_k<<<dim3(32, T_ / 64, NE), 256, 0, stream>>>(g, EpiGU{gu, b_gu, poff}); }
    act_k<<<dim3(512, NE), 256, 0, stream>>>(gu, act, counts, poff);
    {
        int* idx2 = (int*)(small + 8 * MiB);
        fill_k<<<dim3(64, NE), 256, 0, stream>>>(idx2, counts, poff);
        GemmArgs g{act, 1024, idx2, (size_t)T_, w_d, 1024, (size_t)1024 * 1024, counts, 0, 1024, 1024};
        sgemm_k<<<dim3(16, T_ / 64, NE), 256, 0, stream>>>(g, EpiDown{ys, b_d, poff});
    }
    combine_k<<<T_ * 1024 / 256, 256, 0, stream>>>(out, ys, tok_e, tok_slot, tok_w, poff);
}
```

```cpp
#include <hip/hip_runtime.h>
#include <stdint.h>
#include <cstdio>

constexpr int B_ = 8, S_ = 2048, D_ = 1024, T_ = B_ * S_;
constexpr int INW = 7424, NE = 32;
constexpr int OFF_CB = 0, OFF_CC = 1024, OFF_CX = 2048, OFF_Q = 3072, OFF_K = 3840, OFF_V = 4608, OFF_GC = 5376, OFF_GA = 6400;
constexpr float EPS = 1e-6f;
constexpr float LOG2E = 1.4426950408889634f, LN2 = 0.6931471805599453f;
constexpr float QSCALE = 0.125f * LOG2E;
constexpr int K2 = 1280;
constexpr int PMAX = 65536 + 32 * 256;

#define GAS __attribute__((address_space(1)))
#define LAS __attribute__((address_space(3)))
typedef unsigned short bf16;
typedef short bf16x8 __attribute__((ext_vector_type(8)));
typedef short s16x4 __attribute__((ext_vector_type(4)));
typedef float f32x4 __attribute__((ext_vector_type(4)));
typedef float f32x2 __attribute__((ext_vector_type(2)));
typedef unsigned u32x4 __attribute__((ext_vector_type(4)));
typedef unsigned u32x2 __attribute__((ext_vector_type(2)));
typedef __bf16 bf16x2_t __attribute__((ext_vector_type(2)));

__device__ __forceinline__ unsigned pk2(float lo, float hi) { f32x2 v = {lo, hi}; bf16x2_t b = __builtin_convertvector(v, bf16x2_t); return __builtin_bit_cast(unsigned, b); }
__device__ __forceinline__ float bf_lo(unsigned u) { return __uint_as_float(u << 16); }
__device__ __forceinline__ float bf_hi(unsigned u) { return __uint_as_float(u & 0xffff0000u); }
__device__ __forceinline__ float sigmoidf_(float x) { return __builtin_amdgcn_rcpf(1.f + __builtin_amdgcn_exp2f(-LOG2E * x)); }

namespace pg8 {
constexpr int BM = 256, BK = 64, HALF = 128, HTB = HALF * BK * 2, STAGE_BYTES = 8 * HTB, NXCD = 8, WGM = 8;
__host__ __device__ __forceinline__ int lds_byte(int r, int c) { const int st = (r >> 4) * 2 + (c >> 5), rr = r & 15, cc = c & 31, ob = rr * 64 + cc * 2; return st * 1024 + (ob ^ (((ob >> 9) & 1) << 5)); }
__host__ __device__ __forceinline__ void stage_rc(int b, int& R, int& C) { const int st = b / 1024, sb = b % 1024, swz = sb ^ (((sb >> 9) & 1) << 5); R = (st >> 1) * 16 + swz / 64; C = (st & 1) * 32 + (swz % 64) / 2; }
__host__ __device__ __forceinline__ int perm32(int rho) { const int n = rho >> 4, i = rho & 15; return 8 * (i >> 2) + 4 * n + (i & 3); }

struct Unit { const char* a; const char* b; int pm, pn, e, rows; };

struct DenseOrder {
    const char* A; const char* Bt; int K, nM, nN, nwg, G, c;
    __device__ void init(const void* A_, const void* Bt_, int M, int N, int K_, int G_, int c_) { A = (const char*)A_; Bt = (const char*)Bt_; K = K_; nM = M / BM; nN = N / BM; nwg = nM * nN; G = G_; c = c_; }
    __device__ bool next(int i, Unit& u) const {
        const long L = (long)i * G + c; if (L >= nwg) return false;
        int wgid = (int)L; { const int q = nwg / NXCD, r = nwg % NXCD, xcd = wgid % NXCD, off = wgid / NXCD; wgid = (xcd < r ? xcd * (q + 1) : r * (q + 1) + (xcd - r) * q) + off; }
        const int nig = WGM * nN, gid = wgid / nig, fm = gid * WGM, gsz = (nM - fm) < WGM ? (nM - fm) : WGM;
        u.pm = fm + ((wgid % nig) % gsz); u.pn = (wgid % nig) / gsz; u.e = 0; u.rows = 256;
        u.a = A + (size_t)u.pm * BM * K * 2; u.b = Bt + (size_t)u.pn * BM * K * 2; return true;
    }
    __device__ __forceinline__ unsigned row_off(const Unit&, int) const { return 0u; }
};

template <class Epi, class Sched, bool ALIGN_EPI, bool GATHER>
__device__ __forceinline__ void gemm_phase(LAS unsigned char* lds, const int K, const Sched& S, const Epi& E) {
    const int tid = threadIdx.x, wid = __builtin_amdgcn_readfirstlane(tid >> 6), lane = tid & 63, wr = wid >> 2, wc = wid & 3, fr = lane & 15, fq = lane >> 4;
    const int nt = K / BK;
    unsigned voffA[2], voffB[2]; int RA[2]; unsigned CA2[2];
#pragma unroll
    for (int i = 0; i < 2; ++i) { int R, C; stage_rc(tid * 16 + i * 8192, R, C); const int Rb = (R & ~31) + perm32(R & 31);
        voffA[i] = (unsigned)(R * K + C) * 2u; voffB[i] = (unsigned)(Rb * K + C) * 2u; RA[i] = R; CA2[i] = (unsigned)C * 2u; }
    const size_t kstep = (size_t)(BK * 2);
    const size_t hstep = (size_t)HALF * K * 2;
    const unsigned ldsw = (unsigned)wid * 1024u;
    const int aoff = lds_byte(wr * 64 + fr, fq * 8), boff = lds_byte(wc * 32 + fr, fq * 8);
#define PG8_SA(b, h) (((b) * 2 + (h)) * HTB)
#define PG8_SB(b, h) ((4 + (b) * 2 + (h)) * HTB)
#define PG8_STAGE2(bufoff, gbase, o0, o1) do { \
        __builtin_amdgcn_global_load_lds((const unsigned*)((const char*)(gbase) + (o0)), (LAS unsigned*)(lds + (bufoff) + ldsw), 16, 0, 0); \
        __builtin_amdgcn_global_load_lds((const unsigned*)((const char*)(gbase) + (o1)), (LAS unsigned*)(lds + (bufoff) + ldsw + 8192), 16, 0, 0); } while (0)
#define PG8_STB(bufoff, gbase) PG8_STAGE2(bufoff, gbase, voffB[0], voffB[1])
#define PG8_STA(bufoff, gbase, h, nx) do { if constexpr (GATHER) { const unsigned o0_ = (nx) ? gn[h][0] : gc[h][0], o1_ = (nx) ? gn[h][1] : gc[h][1]; PG8_STAGE2(bufoff, gbase, o0_, o1_); } \
        else { PG8_STAGE2(bufoff, (gbase) + (h) * hstep, voffA[0], voffA[1]); } } while (0)
#define PG8_LDA(dst, b, h) do { _Pragma("unroll") for (int m = 0; m < 4; ++m) _Pragma("unroll") for (int k = 0; k < 2; ++k) dst[m][k] = *(const LAS bf16x8*)(lds + PG8_SA(b, h) + aoff + m * 2048 + k * 1024); } while (0)
#define PG8_LDB(dst, b, h) do { _Pragma("unroll") for (int n = 0; n < 2; ++n) _Pragma("unroll") for (int k = 0; k < 2; ++k) dst[n][k] = *(const LAS bf16x8*)(lds + PG8_SB(b, h) + boff + n * 2048 + k * 1024); } while (0)
#define PG8_MMA(ai, bj, At, Bt) do { __builtin_amdgcn_s_setprio(1); _Pragma("unroll") for (int m = 0; m < 4; ++m) _Pragma("unroll") for (int n = 0; n < 2; ++n) _Pragma("unroll") for (int k = 0; k < 2; ++k) \
        acc[ai][bj][m][n] = __builtin_amdgcn_mfma_f32_16x16x32_bf16(Bt[n][k], At[m][k], acc[ai][bj][m][n], 0, 0, 0); __builtin_amdgcn_s_setprio(0); } while (0)
#define PG8_WAIT_V(n) asm volatile("s_waitcnt vmcnt(" #n ")" ::: "memory")
#define PG8_WAIT_L(n) asm volatile("s_waitcnt lgkmcnt(" #n ")" ::: "memory")
#define PG8_BAR __builtin_amdgcn_s_barrier()
#define PG8_SCHED __builtin_amdgcn_sched_barrier(0)
#define PG8_KBODY do { \
            const bool last = (t == nt - 2); \
            const char* a1 = cA + (size_t)(t + 1) * kstep; \
            const char* a2 = last ? nA : cA + (size_t)(t + 2) * kstep; const char* b2 = last ? nB : cB + (size_t)(t + 2) * kstep; \
            const char* a3 = a2 + kstep; const char* b3 = b2 + kstep; \
            PG8_LDB(B0, 0, 0); PG8_LDB(B1, 0, 1); PG8_SCHED; PG8_LDA(At, 0, 0); PG8_STA(PG8_SA(1, 1), a1, 1, false); \
            PG8_WAIT_V(8); PG8_WAIT_L(0); PG8_BAR; PG8_MMA(0, 0, At, B0); PG8_MMA(0, 1, At, B1); PG8_BAR; PG8_SCHED; \
            PG8_LDA(At, 0, 1); PG8_STB(PG8_SB(0, 0), b2); PG8_STB(PG8_SB(0, 1), b2 + hstep); PG8_STA(PG8_SA(0, 0), a2, 0, last); \
            PG8_WAIT_V(8); PG8_WAIT_L(0); PG8_BAR; PG8_MMA(1, 0, At, B0); PG8_MMA(1, 1, At, B1); PG8_BAR; PG8_SCHED; \
            PG8_LDB(B0, 1, 0); PG8_LDB(B1, 1, 1); PG8_SCHED; PG8_LDA(At, 1, 0); PG8_STA(PG8_SA(0, 1), a2, 1, last); \
            PG8_WAIT_V(8); PG8_WAIT_L(0); PG8_BAR; PG8_MMA(0, 0, At, B0); PG8_MMA(0, 1, At, B1); PG8_BAR; PG8_SCHED; \
            PG8_LDA(At, 1, 1); PG8_STB(PG8_SB(1, 0), b3); PG8_STB(PG8_SB(1, 1), b3 + hstep); PG8_STA(PG8_SA(1, 0), a3, 0, last); \
            PG8_WAIT_V(8); PG8_WAIT_L(0); PG8_BAR; PG8_MMA(1, 0, At, B0); PG8_MMA(1, 1, At, B1); PG8_BAR; PG8_SCHED; \
        } while (0)
    Unit cur, nxt; int ui = 0;
    if (!S.next(0, cur)) return;
    f32x4 acc[2][2][4][2];
#pragma unroll
    for (int a = 0; a < 2; ++a)
#pragma unroll
        for (int b = 0; b < 2; ++b)
#pragma unroll
            for (int m = 0; m < 4; ++m)
#pragma unroll
                for (int n = 0; n < 2; ++n) acc[a][b][m][n] = (f32x4){0.f, 0.f, 0.f, 0.f};
    bf16x8 At[4][2], B0[2][2], B1[2][2];
    unsigned gc[2][2], gn[2][2];
    if constexpr (GATHER) {
#pragma unroll
        for (int h = 0; h < 2; ++h)
#pragma unroll
            for (int i = 0; i < 2; ++i) { gc[h][i] = S.row_off(cur, h * HALF + RA[i]) + CA2[i]; gn[h][i] = gc[h][i]; }
    }
    const char* cA = cur.a; const char* cB = cur.b;
    PG8_STB(PG8_SB(0, 0), cB); PG8_STB(PG8_SB(0, 1), cB + hstep); PG8_STA(PG8_SA(0, 0), cA, 0, false); PG8_STA(PG8_SA(0, 1), cA, 1, false);
    if (wr == 1) PG8_BAR;
    PG8_WAIT_V(2); PG8_BAR;
    PG8_STB(PG8_SB(1, 0), cB + kstep); PG8_STA(PG8_SA(1, 0), cA + kstep, 0, false); PG8_STB(PG8_SB(1, 1), cB + hstep + kstep);
    PG8_WAIT_V(6); PG8_BAR;
    for (;;) {
        const bool has_next = S.next(ui + 1, nxt);
        if constexpr (GATHER) {
            if (has_next) {
#pragma unroll
                for (int h = 0; h < 2; ++h)
#pragma unroll
                    for (int i = 0; i < 2; ++i) gn[h][i] = S.row_off(nxt, h * HALF + RA[i]) + CA2[i];
            }
        }
        const char* nA = has_next ? nxt.a : cA; const char* nB = has_next ? nxt.b : cB;
        if constexpr (Epi::MID_T > 0) {
            for (int t = 0; t < Epi::MID_T; t += 2) PG8_KBODY;
            E.mid(acc, cur, wr, wc, fr, fq);
            for (int t = Epi::MID_T; t < nt; t += 2) PG8_KBODY;
        } else {
            for (int t = 0; t < nt; t += 2) PG8_KBODY;
        }
        if constexpr (ALIGN_EPI) { if (wr == 0) PG8_BAR; }
        E(acc, cur, wr, wc, fr, fq);
        if (!has_next) break;
#pragma unroll
        for (int a = 0; a < 2; ++a)
#pragma unroll
            for (int b = 0; b < 2; ++b)
#pragma unroll
                for (int m = 0; m < 4; ++m)
#pragma unroll
                    for (int n = 0; n < 2; ++n) acc[a][b][m][n] = (f32x4){0.f, 0.f, 0.f, 0.f};
        cur = nxt; cA = nA; cB = nB; ++ui;
        if constexpr (GATHER) {
#pragma unroll
            for (int h = 0; h < 2; ++h)
#pragma unroll
                for (int i = 0; i < 2; ++i) gc[h][i] = gn[h][i];
        }
        if constexpr (ALIGN_EPI) { if (wr == 1) PG8_BAR; }
    }
    PG8_WAIT_V(0);
    if constexpr (!ALIGN_EPI) { if (wr == 0) PG8_BAR; }
    PG8_BAR;
#undef PG8_KBODY
#undef PG8_SA
#undef PG8_SB
#undef PG8_STAGE2
#undef PG8_STB
#undef PG8_STA
#undef PG8_LDA
#undef PG8_LDB
#undef PG8_MMA
#undef PG8_WAIT_V
#undef PG8_WAIT_L
#undef PG8_BAR
#undef PG8_SCHED
}
}
__device__ __forceinline__ int deint_row(int g, int t) {
    const int b = t & ~2047, s = t & 2047;
    if (g == 0) return t;
    if (g == 1) return b + (s & 3) * 512 + (s >> 2);
    return b + (s & 15) * 128 + (s >> 4);
}
__device__ __forceinline__ int reint_row(int g, int R) {
    const int b = R & ~2047, s = R & 2047;
    if (g == 0) return R;
    if (g == 1) return b + (s & 511) * 4 + (s >> 9);
    return b + (s & 127) * 16 + (s >> 7);
}
__device__ __forceinline__ u32x4 pack8(const f32x4 a, const f32x4 b) { u32x4 w; w.x = pk2(a[0], a[1]); w.y = pk2(a[2], a[3]); w.z = pk2(b[0], b[1]); w.w = pk2(b[2], b[3]); return w; }

__host__ __device__ __forceinline__ int colmap1(int nphys) {
    const int pn = nphys >> 8, x = nphys & 255, bj = x >> 7, y = x & 127;
    if (pn < 8) return (bj ? OFF_CX : OFF_CC) + 128 * pn + y;
    if (pn < 12) return OFF_CB + 256 * (pn - 8) + x;
    if (pn < 18) { const int isk = pn >= 15, g = (pn - 12) % 3, wc = y >> 5, xx = y & 31; return (isk ? OFF_K : OFF_Q) + 256 * g + 64 * wc + 32 * bj + xx; }
    if (pn < 21) return OFF_V + 256 * (pn - 18) + x;
    return (bj ? OFF_GA : OFF_GC) + 128 * (pn - 21) + y;
}
struct Epi1 {
    static constexpr int MID_T = 0;
    bf16* U; bf16* CB; bf16* QG; bf16* KG; bf16* VG; bf16* SGC; bf16* RAT; const float* gq; const float* gk;
    __device__ __forceinline__ void mid(f32x4 (&)[2][2][4][2], const pg8::Unit&, int, int, int, int) const {}
    __device__ __forceinline__ void operator()(const f32x4 (&acc)[2][2][4][2], const pg8::Unit& u, int wr, int wc, int fr, int fq) const {
        const int pn = u.pn, row0 = u.pm * 256 + wr * 64 + fr;
        if (pn < 8) {
            const int col = 128 * pn + 32 * wc + 8 * fq;
#pragma unroll
            for (int ai = 0; ai < 2; ++ai)
#pragma unroll
                for (int m = 0; m < 4; ++m) { const int row = row0 + ai * 128 + m * 16;
                    *(u32x4*)(U + (size_t)row * 1024 + col) = pack8(acc[ai][0][m][0] * acc[ai][1][m][0], acc[ai][0][m][1] * acc[ai][1][m][1]); }
        } else if (pn < 12) {
            const int col = 256 * (pn - 8) + 32 * wc + 8 * fq;
#pragma unroll
            for (int ai = 0; ai < 2; ++ai)
#pragma unroll
                for (int m = 0; m < 4; ++m) { const int row = row0 + ai * 128 + m * 16;
#pragma unroll
                    for (int bj = 0; bj < 2; ++bj) *(u32x4*)(CB + (size_t)row * 1024 + col + 128 * bj) = pack8(acc[ai][bj][m][0], acc[ai][bj][m][1]); }
        } else if (pn < 18) {
            const bool isk = pn >= 15; const int g = (pn - 12) % 3;
            const float* gg = isk ? gk : gq; bf16* dst = (isk ? KG : QG) + (size_t)g * T_ * 256;
            f32x4 gv[2][2];
#pragma unroll
            for (int bj = 0; bj < 2; ++bj)
#pragma unroll
                for (int n = 0; n < 2; ++n) gv[bj][n] = *(const f32x4*)(gg + 32 * bj + 8 * fq + 4 * n);
            const float sc = isk ? 1.f : QSCALE;
#pragma unroll
            for (int ai = 0; ai < 2; ++ai)
#pragma unroll
                for (int m = 0; m < 4; ++m) {
                    float ss = 0.f;
#pragma unroll
                    for (int bj = 0; bj < 2; ++bj)
#pragma unroll
                        for (int n = 0; n < 2; ++n) { const f32x4 x = acc[ai][bj][m][n]; ss += (x[0] * x[0] + x[1] * x[1]) + (x[2] * x[2] + x[3] * x[3]); }
                    ss += __shfl_xor(ss, 16); ss += __shfl_xor(ss, 32);
                    const float rs = __builtin_amdgcn_rsqf(ss * (1.f / 64.f) + EPS) * sc;
                    const int drow = deint_row(g, row0 + ai * 128 + m * 16);
                    bf16* p = dst + ((size_t)drow * 4 + wc) * 64 + 8 * fq;
#pragma unroll
                    for (int bj = 0; bj < 2; ++bj) *(u32x4*)(p + 32 * bj) = pack8(acc[ai][bj][m][0] * gv[bj][0] * rs, acc[ai][bj][m][1] * gv[bj][1] * rs);
                }
        } else if (pn < 21) {
            const int g = pn - 18; bf16* dst = VG + (size_t)g * T_ * 256;
#pragma unroll
            for (int ai = 0; ai < 2; ++ai)
#pragma unroll
                for (int m = 0; m < 4; ++m) { const int drow = deint_row(g, row0 + ai * 128 + m * 16);
#pragma unroll
                    for (int bj = 0; bj < 2; ++bj) *(u32x4*)(dst + (size_t)drow * 256 + 128 * bj + 32 * wc + 8 * fq) = pack8(acc[ai][bj][m][0], acc[ai][bj][m][1]); }
        } else {
            const int col = 128 * (pn - 21) + 32 * wc + 8 * fq;
#pragma unroll
            for (int ai = 0; ai < 2; ++ai)
#pragma unroll
                for (int m = 0; m < 4; ++m) { const int row = row0 + ai * 128 + m * 16;
                    f32x4 sc[2], rt[2];
#pragma unroll
                    for (int n = 0; n < 2; ++n)
#pragma unroll
                        for (int i = 0; i < 4; ++i) { const float s0 = sigmoidf_(acc[ai][0][m][n][i]), s1 = sigmoidf_(acc[ai][1][m][n][i]); sc[n][i] = s0; rt[n][i] = s1 * __builtin_amdgcn_rcpf(s0); }
                    *(u32x4*)(SGC + (size_t)row * 1024 + col) = pack8(sc[0], sc[1]);
                    *(u32x4*)(RAT + (size_t)row * 1024 + col) = pack8(rt[0], rt[1]); }
        }
    }
};

struct Epi2 {
    static constexpr int MID_T = 4;
    const bf16* SGC; const bf16* RAT; bf16* MERGED;
    __device__ __forceinline__ void mid(f32x4 (&acc)[2][2][4][2], const pg8::Unit& u, int wr, int wc, int fr, int fq) const {
        const int row0 = u.pm * 256 + wr * 64 + fr, col0 = u.pn * 256 + 32 * wc + 8 * fq;
#pragma unroll
        for (int ai = 0; ai < 2; ++ai)
#pragma unroll
            for (int m = 0; m < 4; ++m) {
#pragma unroll
                for (int bj = 0; bj < 2; ++bj) { const u32x4 r = *(const u32x4*)(RAT + (size_t)(row0 + ai * 128 + m * 16) * 1024 + col0 + 128 * bj);
                    acc[ai][bj][m][0] *= (f32x4){bf_lo(r.x), bf_hi(r.x), bf_lo(r.y), bf_hi(r.y)}; acc[ai][bj][m][1] *= (f32x4){bf_lo(r.z), bf_hi(r.z), bf_lo(r.w), bf_hi(r.w)}; }
                asm volatile("" : "+v"(acc[ai][0][m][0]), "+v"(acc[ai][0][m][1]), "+v"(acc[ai][1][m][0]), "+v"(acc[ai][1][m][1]));
                if (m & 1) asm volatile("" ::: "memory"); }
    }
    __device__ __forceinline__ void operator()(const f32x4 (&acc)[2][2][4][2], const pg8::Unit& u, int wr, int wc, int fr, int fq) const {
        const int row0 = u.pm * 256 + wr * 64 + fr, col0 = u.pn * 256 + 32 * wc + 8 * fq;
#pragma unroll
        for (int ai = 0; ai < 2; ++ai)
#pragma unroll
            for (int m = 0; m < 4; ++m)
#pragma unroll
                for (int bj = 0; bj < 2; ++bj) { const size_t off = (size_t)(row0 + ai * 128 + m * 16) * 1024 + col0 + 128 * bj; const u32x4 r = *(const u32x4*)(SGC + off);
                    *(u32x4*)(MERGED + off) = pack8(acc[ai][bj][m][0] * (f32x4){bf_lo(r.x), bf_hi(r.x), bf_lo(r.y), bf_hi(r.y)}, acc[ai][bj][m][1] * (f32x4){bf_lo(r.z), bf_hi(r.z), bf_lo(r.w), bf_hi(r.w)}); }
    }
};

struct Epi3 {
    static constexpr int MID_T = 0;
    const float* X; float* OUT;
    __device__ __forceinline__ void mid(f32x4 (&)[2][2][4][2], const pg8::Unit&, int, int, int, int) const {}
    __device__ __forceinline__ void operator()(const f32x4 (&acc)[2][2][4][2], const pg8::Unit& u, int wr, int wc, int fr, int fq) const {
        const int row0 = u.pm * 256 + wr * 64 + fr, col0 = u.pn * 256 + 32 * wc + 8 * fq;
#pragma unroll
        for (int ai = 0; ai < 2; ++ai)
#pragma unroll
            for (int m = 0; m < 4; ++m)
#pragma unroll
                for (int bj = 0; bj < 2; ++bj)
#pragma unroll
                    for (int n = 0; n < 2; ++n) { const size_t off = (size_t)(row0 + ai * 128 + m * 16) * 1024 + col0 + 128 * bj + 4 * n;
                        *(f32x4*)(OUT + off) = *(const f32x4*)(X + off) + acc[ai][bj][m][n]; }
    }
};

struct EpiGU {
    static constexpr int MID_T = 0;
    bf16* ACT; const float* bgu;
    __device__ __forceinline__ void mid(f32x4 (&)[2][2][4][2], const pg8::Unit&, int, int, int, int) const {}
    __device__ __forceinline__ void operator()(const f32x4 (&acc)[2][2][4][2], const pg8::Unit& u, int wr, int wc, int fr, int fq) const {
        const int row0 = u.pm * 256 + wr * 64 + fr, col = 128 * u.pn + 32 * wc + 8 * fq;
        const float* bg = bgu + (size_t)u.e * 2048 + col;
        f32x4 bgate[2], bup[2];
#pragma unroll
        for (int n = 0; n < 2; ++n) { bgate[n] = *(const f32x4*)(bg + 4 * n); bup[n] = *(const f32x4*)(bg + 1024 + 4 * n); }
#pragma unroll
        for (int ai = 0; ai < 2; ++ai)
#pragma unroll
            for (int m = 0; m < 4; ++m) { f32x4 o[2];
#pragma unroll
                for (int n = 0; n < 2; ++n)
#pragma unroll
                    for (int i = 0; i < 4; ++i) { const float gt = fminf(acc[ai][0][m][n][i] + bgate[n][i], 7.f); const float up = fminf(fmaxf(acc[ai][1][m][n][i] + bup[n][i], -7.f), 7.f);
                        o[n][i] = (up + 1.f) * gt * __builtin_amdgcn_rcpf(1.f + __builtin_amdgcn_exp2f(-1.702f * LOG2E * gt)); }
                *(u32x4*)(ACT + (size_t)(row0 + ai * 128 + m * 16) * 1024 + col) = pack8(o[0], o[1]); }
    }
};
struct EpiDN {
    static constexpr int MID_T = 0;
    bf16* YS; const float* bd;
    __device__ __forceinline__ void mid(f32x4 (&)[2][2][4][2], const pg8::Unit&, int, int, int, int) const {}
    __device__ __forceinline__ void operator()(const f32x4 (&acc)[2][2][4][2], const pg8::Unit& u, int wr, int wc, int fr, int fq) const {
        const int row0 = u.pm * 256 + wr * 64 + fr, col0 = 256 * u.pn + 32 * wc + 8 * fq;
        const float* bb = bd + (size_t)u.e * 1024 + col0;
        f32x4 bv[2][2];
#pragma unroll
        for (int bj = 0; bj < 2; ++bj)
#pragma unroll
            for (int n = 0; n < 2; ++n) bv[bj][n] = *(const f32x4*)(bb + 128 * bj + 4 * n);
#pragma unroll
        for (int ai = 0; ai < 2; ++ai)
#pragma unroll
            for (int m = 0; m < 4; ++m)
#pragma unroll
                for (int bj = 0; bj < 2; ++bj)
                    *(u32x4*)(YS + (size_t)(row0 + ai * 128 + m * 16) * 1024 + col0 + 128 * bj) = pack8(acc[ai][bj][m][0] + bv[bj][0], acc[ai][bj][m][1] + bv[bj][1]);
    }
};
namespace attn {
constexpr int KROW = 144;
constexpr int LDS_K = 0, LDS_V = 256 * KROW, LDS_BIAS = 2 * 256 * KROW, BIAS_STRIDE = 132;
constexpr int LDS_END = LDS_BIAS + 12 * BIAS_STRIDE * 4;
typedef short v4i16_t __attribute__((ext_vector_type(4)));
__device__ __forceinline__ s16x4 vtr(const LAS unsigned char* p) { return __builtin_bit_cast(s16x4, __builtin_amdgcn_ds_read_tr16_b64_v4i16((LAS v4i16_t*)p)); }

__device__ __forceinline__ void item(LAS unsigned char* lds, int g, int q, int j, const bf16* QG, const bf16* KG, const bf16* VG, bf16* OG, float* LSE, int tid, int lane, int wave) {
    const int nbm1 = (g == 0) ? 15 : (g == 1 ? 3 : 0);
    const bool hasprev = (q & nbm1) != 0;
    const size_t gofs = (size_t)g * T_ * 256 + j * 64;
    const bf16* Kg = KG + gofs; const bf16* Vg = VG + gofs; const bf16* Qg = QG + gofs;
    const int R0 = 128 * (q - 1), klo = hasprev ? 0 : 128;
#pragma unroll
    for (int it = 0; it < 4; ++it) {
        const int c = tid + it * 512, r = c >> 3, ch = c & 7;
        if (r >= klo) {
            const u32x4 kv = *(const u32x4*)(Kg + (size_t)(R0 + r) * 256 + ch * 8);
            const u32x4 vv = *(const u32x4*)(Vg + (size_t)(R0 + r) * 256 + ch * 8);
            *(LAS u32x4*)(lds + LDS_K + r * KROW + ch * 16) = kv;
            *(LAS u32x4*)(lds + LDS_V + r * KROW + ch * 16) = vv;
        }
    }
    const int ql = lane & 15, quad = lane >> 4;
    const int qi = 16 * wave + ql;
    const bf16* qp = Qg + (size_t)(128 * q + qi) * 256 + 8 * quad;
    const bf16x8 qf0 = *(const bf16x8*)(qp), qf1 = *(const bf16x8*)(qp + 32);
    __syncthreads();
    const LAS float* bias = (const LAS float*)(lds + LDS_BIAS) + (g * 4 + j) * BIAS_STRIDE;
    float m = -1e30f, l = 0.f;
    f32x4 o[4];
#pragma unroll
    for (int dt = 0; dt < 4; ++dt) o[dt] = (f32x4){0.f, 0.f, 0.f, 0.f};
    const int s_lo = hasprev ? (wave >> 1) : 4, s_hi = (wave >> 1) + 4;
    const LAS unsigned char* kbase = lds + LDS_K + ql * KROW + quad * 16;
    const LAS unsigned char* vbase = lds + LDS_V + (4 * quad + (ql >> 2)) * KROW + (ql & 3) * 8;
    for (int s = s_lo; s <= s_hi; ++s) {
        const LAS unsigned char* kp = kbase + 32 * s * KROW;
        const bf16x8 k00 = *(const LAS bf16x8*)(kp), k01 = *(const LAS bf16x8*)(kp + 64);
        const bf16x8 k10 = *(const LAS bf16x8*)(kp + 16 * KROW), k11 = *(const LAS bf16x8*)(kp + 16 * KROW + 64);
        f32x4 c0 = (f32x4){0.f, 0.f, 0.f, 0.f}, c1 = (f32x4){0.f, 0.f, 0.f, 0.f};
        c0 = __builtin_amdgcn_mfma_f32_16x16x32_bf16(k00, qf0, c0, 0, 0, 0);
        c0 = __builtin_amdgcn_mfma_f32_16x16x32_bf16(k01, qf1, c0, 0, 0, 0);
        c1 = __builtin_amdgcn_mfma_f32_16x16x32_bf16(k10, qf0, c1, 0, 0, 0);
        c1 = __builtin_amdgcn_mfma_f32_16x16x32_bf16(k11, qf1, c1, 0, 0, 0);
        float mx = -INFINITY;
#pragma unroll
        for (int i = 0; i < 4; ++i) {
            const int kj0 = 32 * s + 4 * quad + i, d0 = qi + 128 - kj0, d1 = d0 - 16;
            const bool v0 = (d0 >= 0) && (d0 <= 128) && (hasprev || kj0 >= 128);
            const bool v1 = (d1 >= 0) && (d1 <= 128) && (hasprev || kj0 + 16 >= 128);
            const float b0 = bias[min(max(d0, 0), 128)], b1 = bias[min(max(d1, 0), 128)];
            c0[i] = v0 ? c0[i] + b0 : -INFINITY; c1[i] = v1 ? c1[i] + b1 : -INFINITY;
            mx = fmaxf(mx, fmaxf(c0[i], c1[i]));
        }
        mx = fmaxf(mx, __shfl_xor(mx, 16)); mx = fmaxf(mx, __shfl_xor(mx, 32));
        const float mn = fmaxf(m, mx), alpha = __builtin_amdgcn_exp2f(m - mn);
        m = mn;
        float ps = 0.f;
#pragma unroll
        for (int i = 0; i < 4; ++i) { c0[i] = __builtin_amdgcn_exp2f(c0[i] - mn); c1[i] = __builtin_amdgcn_exp2f(c1[i] - mn); ps += c0[i] + c1[i]; }
        l = l * alpha + ps;
        u32x4 pw; pw.x = pk2(c0[0], c0[1]); pw.y = pk2(c0[2], c0[3]); pw.z = pk2(c1[0], c1[1]); pw.w = pk2(c1[2], c1[3]);
        const bf16x8 pf = __builtin_bit_cast(bf16x8, pw);
        const LAS unsigned char* vp = vbase + 32 * s * KROW;
#pragma unroll
        for (int dt = 0; dt < 4; ++dt) {
            const s16x4 lo = vtr(vp + dt * 32), hi = vtr(vp + dt * 32 + 16 * KROW);
            const bf16x8 vf = (bf16x8){lo[0], lo[1], lo[2], lo[3], hi[0], hi[1], hi[2], hi[3]};
            o[dt] = o[dt] * alpha;
            o[dt] = __builtin_amdgcn_mfma_f32_16x16x32_bf16(vf, pf, o[dt], 0, 0, 0);
        }
    }
    l += __shfl_xor(l, 16); l += __shfl_xor(l, 32);
    const float inv = __builtin_amdgcn_rcpf(l);
    const int tok = reint_row(g, 128 * q + qi);
    bf16* op = OG + (size_t)g * T_ * 256 + (size_t)tok * 256 + j * 64 + 4 * quad;
#pragma unroll
    for (int dt = 0; dt < 4; ++dt) { u32x2 w; w.x = pk2(o[dt][0] * inv, o[dt][1] * inv); w.y = pk2(o[dt][2] * inv, o[dt][3] * inv); *(u32x2*)(op + 16 * dt) = w; }
    if (quad == 0) LSE[(size_t)g * T_ * 4 + tok * 4 + j] = m + __builtin_amdgcn_logf(l);
    __syncthreads();
}
}
constexpr int NWAVES = 8;
constexpr size_t MiB = 1u << 20;
constexpr size_t WS_CTL = 0, CTL_ZERO_BYTES = 256 * 1024;
constexpr size_t WS_WT1 = 2 * MiB;
constexpr size_t WS_WT2 = 17 * MiB;
constexpr size_t WS_WT3 = 20 * MiB;
constexpr size_t WS_WGU = 24 * MiB;
constexpr size_t WS_WD = 152 * MiB;
constexpr size_t WS_H = 216 * MiB;
constexpr size_t WS_U = 248 * MiB;
constexpr size_t WS_CB = 280 * MiB;
constexpr size_t WS_QG = 312 * MiB, WS_KG = 336 * MiB, WS_VG = 360 * MiB;
constexpr size_t WS_SGC = 384 * MiB, WS_RAT = 416 * MiB;
constexpr size_t WS_OG = 448 * MiB;
constexpr size_t WS_LSE = 472 * MiB;
constexpr size_t WS_A2 = 474 * MiB;
constexpr size_t WS_MERGED = 514 * MiB;
constexpr size_t WS_ACT = 546 * MiB;
constexpr size_t WS_YS = 690 * MiB;
constexpr size_t WS_LISTS = 834 * MiB;
constexpr size_t WS_TOKE = 836 * MiB, WS_TOKS = WS_TOKE + 256 * 1024, WS_TOKW = WS_TOKS + 256 * 1024;
constexpr size_t WS_BIAS2 = 837 * MiB;
constexpr size_t WS_END = 838 * MiB;
constexpr int CW_TMO = 0, CW_BAR = 4096, CW_CNT = 8192;
constexpr int RING_OFF = 0, RING_BYTES = 131072;
constexpr int LDSCTL_OFF = RING_BYTES + 1024, MISC_OFF = LDSCTL_OFF + 320;
constexpr int LDS_TOK = MISC_OFF + 128;
constexpr int LDS_BYTES = 147456;

typedef GAS unsigned gu32;
#define RLX_AGENT __ATOMIC_RELAXED, __HIP_MEMORY_SCOPE_AGENT
#define LDS_WAIT() asm volatile("s_waitcnt lgkmcnt(0)" ::: "memory")
#define VM_WAIT() asm volatile("s_waitcnt vmcnt(0)" ::: "memory")

#define XB_TMO      128
#define XB_XCNT(j)  (256  + 64 * (j))
#define XB_XSUB(j)  (1280 + 64 * (j))
#define XB_XGEN(j)  (2304 + 64 * (j))
#define XB_TOP      3328
#define XB_TOPGEN   3392
#define XCD_BAR_WORDS 3456
#define XB_SPIN_CAP (1u << 18)
__device__ __forceinline__ unsigned xb_ld(unsigned* p)              { return __hip_atomic_load(p, __ATOMIC_RELAXED, __HIP_MEMORY_SCOPE_AGENT); }
__device__ __forceinline__ unsigned xb_add(unsigned* p, unsigned v) { return __hip_atomic_fetch_add(p, v, __ATOMIC_RELAXED, __HIP_MEMORY_SCOPE_AGENT); }
__device__ __forceinline__ unsigned xb_xcc_id() { return (unsigned)__builtin_amdgcn_s_getreg((3 << 11) | 20) & 0xFu; }
#define XB_SPIN(cond, bar) do { unsigned _sp = 0; while (cond) { __builtin_amdgcn_s_sleep(1); \
    if ((++_sp & 255u) == 0u) { if (xb_ld(&(bar)[XB_TMO])) break; if (_sp > XB_SPIN_CAP) { atomicAdd(&(bar)[XB_TMO], 1u); break; } } } } while (0)
struct XcdBarrier { unsigned* bar; unsigned x; volatile LAS unsigned* st; };
__device__ __forceinline__ XcdBarrier xcd_barrier_post(unsigned* bar, volatile LAS unsigned* st) {
    XcdBarrier b; b.bar = bar; b.x = xb_xcc_id(); b.st = st;
    if (threadIdx.x == 0) (void)xb_add(&bar[XB_XCNT(b.x)], 1u);
    return b;
}
__device__ __forceinline__ void xcd_barrier_complete(unsigned* bar, unsigned x, unsigned& nloc, unsigned& nx) {
    const unsigned G = gridDim.x * gridDim.y * gridDim.z;
    unsigned sum, cnt, mine, sp = 0u;
    for (;;) {
        sum = 0u; cnt = 0u; mine = 0u;
#pragma unroll
        for (unsigned j = 0; j < 16; ++j) { const unsigned c = xb_ld(&bar[XB_XCNT(j)]); sum += c; cnt += (c > 0u) ? 1u : 0u; mine = (j == x) ? c : mine; }
        if (sum == G) break;
        __builtin_amdgcn_s_sleep(1);
        if ((++sp & 255u) == 0u) { if (xb_ld(&bar[XB_TMO])) break; if (sp > XB_SPIN_CAP) { atomicAdd(&bar[XB_TMO], 1u); break; } }
    }
    nloc = mine > 0u ? mine : 1u; nx = cnt > 0u ? cnt : 1u;
}
__device__ __forceinline__ void xcd_barrier(const XcdBarrier& b) {
    asm volatile("s_waitcnt vmcnt(0)" ::: "memory");
    __syncthreads();
    if (threadIdx.x == 0) {
        unsigned* bar = b.bar;
        __builtin_amdgcn_s_waitcnt(0);
        unsigned nloc = b.st[0], nx = b.st[1];
        if (nloc == 0u) { xcd_barrier_complete(bar, b.x, nloc, nx); b.st[0] = nloc; b.st[1] = nx; }
        const unsigned old = xb_add(&bar[XB_XSUB(b.x)], 1u);
        const unsigned gen = old / nloc;
        if (old + 1u == (gen + 1u) * nloc) {
            __builtin_amdgcn_fence(__ATOMIC_RELEASE, "agent");
            asm volatile("s_waitcnt vmcnt(0)" ::: "memory");
            const unsigned og = xb_add(&bar[XB_TOP], 1u);
            const unsigned tg = og / nx;
            if (og + 1u == (tg + 1u) * nx) xb_add(&bar[XB_TOPGEN], 1u);
            else XB_SPIN(xb_ld(&bar[XB_TOPGEN]) == tg, bar);
            __builtin_amdgcn_fence(__ATOMIC_ACQUIRE, "agent");
            xb_add(&bar[XB_XGEN(b.x)], 1u);
            asm volatile("s_waitcnt vmcnt(0)" ::: "memory");
        } else {
            XB_SPIN(xb_ld(&bar[XB_XGEN(b.x)]) == gen, bar);
            __builtin_amdgcn_fence(__ATOMIC_ACQUIRE, "agent");
            asm volatile("s_waitcnt vmcnt(0)" ::: "memory");
        }
    }
    __syncthreads();
}

struct Frame {
    LAS unsigned char* lds; volatile LAS unsigned* MISC; gu32* ctl;
    int tid, lane, wave, vcu, G;
    const float *x, *n1g, *w_in, *gq, *gk, *relb, *convw, *w_bc, *w_ba, *w_out, *n2g, *w_r, *b_r, *w_gu, *b_gu, *w_d, *b_d; float* out;
    bf16 *WT1, *WT2, *WT3, *WGU, *WD, *H, *U, *CB, *QG, *KG, *VG, *SGC, *RAT, *OG, *A2, *MERGED, *ACT, *YS;
    float *LSE, *BIAS2, *TOKW; int *LISTS, *TOKE, *TOKS; int* CNT;
};
__device__ __forceinline__ float wave_sum(float v) {
#pragma unroll
    for (int o = 1; o < 64; o <<= 1) v += __shfl_xor(v, o);
    return v;
}
__device__ __forceinline__ float wave_max(float v) {
#pragma unroll
    for (int o = 1; o < 64; o <<= 1) v = fmaxf(v, __shfl_xor(v, o));
    return v;
}

__device__ __forceinline__ void p0_transpose_item(const float* W, int ldw, int k0, int nsrc0, bf16* WT, int ldt, int ndst0, int kdst0, LAS float* scr, int lane) {
#pragma unroll 8
    for (int i = 0; i < 32; ++i) { const int kk = 2 * i + (lane >> 5); scr[kk * 33 + (lane & 31)] = W[(size_t)(k0 + kk) * ldw + nsrc0 + (lane & 31)]; }
    LDS_WAIT(); asm volatile("" ::: "memory");
    const int c = lane & 7;
#pragma unroll
    for (int j = 0; j < 4; ++j) { const int n = (lane >> 3) + 8 * j; const LAS float* s = scr + (8 * c) * 33 + n;
        u32x4 o; o.x = pk2(s[0 * 33], s[1 * 33]); o.y = pk2(s[2 * 33], s[3 * 33]); o.z = pk2(s[4 * 33], s[5 * 33]); o.w = pk2(s[6 * 33], s[7 * 33]);
        *(GAS u32x4*)(WT + (size_t)(ndst0 + n) * ldt + kdst0 + 8 * c) = o; }
    LDS_WAIT(); asm volatile("" ::: "memory");
}
__device__ __forceinline__ void rms_row_to_bf16(const float* xrow, const float* g, bf16* orow, int lane) {
    const GAS f32x4* xr = (const GAS f32x4*)xrow + lane; const GAS f32x4* gr = (const GAS f32x4*)g + lane;
    f32x4 v[4]; float s2 = 0.f;
#pragma unroll
    for (int j = 0; j < 4; ++j) { v[j] = xr[64 * j]; s2 += (v[j].x * v[j].x + v[j].y * v[j].y) + (v[j].z * v[j].z + v[j].w * v[j].w); }
    const float rstd = 1.f / sqrtf(wave_sum(s2) * (1.f / D_) + EPS);
    GAS unsigned long long* o8 = (GAS unsigned long long*)orow + lane;
#pragma unroll
    for (int j = 0; j < 4; ++j) { const f32x4 gg = gr[64 * j]; o8[64 * j] = (unsigned long long)pk2(v[j].x * rstd * gg.x, v[j].y * rstd * gg.y) | ((unsigned long long)pk2(v[j].z * rstd * gg.z, v[j].w * rstd * gg.w) << 32); }
}
__device__ __forceinline__ void p0_prologue(Frame& F) {
    LAS float* scr = (LAS float*)(F.lds + RING_OFF + F.wave * 16384);
    const int gw = F.vcu * NWAVES + F.wave, NGW = F.G * NWAVES;
    constexpr int I1 = (INW / 32) * 16, I2A = 32 * 4, I2B = 32 * 16, I3 = 32 * 16, I4 = NE * 64 * 16, I5 = NE * 32 * 16;
    constexpr int NITEMS = I1 + I2A + I2B + I3 + I4 + I5;
    for (int it = gw; it < NITEMS; it += NGW) {
        int r = it;
        if (r < I1) { const int gb = r >> 4, kb = r & 15; p0_transpose_item(F.w_in, INW, 64 * kb, colmap1(32 * gb), F.WT1, 1024, 32 * gb, 64 * kb, scr, F.lane); continue; } r -= I1;
        if (r < I2A) { const int gb = r >> 2, kb = r & 3; p0_transpose_item(F.w_ba, 1024, 64 * kb, 32 * gb, F.WT2, K2, 32 * gb, 64 * kb, scr, F.lane); continue; } r -= I2A;
        if (r < I2B) { const int gb = r >> 4, kb = r & 15; p0_transpose_item(F.w_bc, 1024, 64 * kb, 32 * gb, F.WT2, K2, 32 * gb, 256 + 64 * kb, scr, F.lane); continue; } r -= I2B;
        if (r < I3) { const int gb = r >> 4, kb = r & 15; p0_transpose_item(F.w_out, 1024, 64 * kb, 32 * gb, F.WT3, 1024, 32 * gb, 64 * kb, scr, F.lane); continue; } r -= I3;
        if (r < I4) { const int e = r >> 10, gb = (r >> 4) & 63, kb = r & 15; const int nphys = 32 * gb, pn = nphys >> 8, bj = (nphys >> 7) & 1, y = nphys & 127;
            p0_transpose_item(F.w_gu + (size_t)e * 1024 * 2048, 2048, 64 * kb, (bj ? 1024 : 0) + 128 * pn + y, F.WGU + (size_t)e * 2048 * 1024, 1024, nphys, 64 * kb, scr, F.lane); continue; } r -= I4;
        { const int e = r >> 9, gb = (r >> 4) & 31, kb = r & 15;
            p0_transpose_item(F.w_d + (size_t)e * 1024 * 1024, 1024, 64 * kb, 32 * gb, F.WD + (size_t)e * 1024 * 1024, 1024, 32 * gb, 64 * kb, scr, F.lane); }
    }
    for (int m = gw; m < T_; m += NGW) rms_row_to_bf16(F.x + (size_t)m * D_, F.n1g, F.H + (size_t)m * D_, F.lane);
    if (blockIdx.x == 0) {
        for (int i = F.tid; i < 12 * 129; i += NWAVES * 64) {
            const int hh = i / 129, dl = i % 129, g = hh >> 2, dil = (g == 0) ? 1 : (g == 1 ? 4 : 16), dist = dl * dil;
            int b;
            if (dist < 16) b = dist; else { const double xx = log((double)dist / 16.0) / log(128.0) * 16.0; b = 16 + (int)xx; if (b > 31) b = 31; }
            F.BIAS2[hh * attn::BIAS_STRIDE + dl] = F.relb[b * 12 + hh] * LOG2E;
        }
    }
}

__device__ __forceinline__ void p2_attn_conv(Frame& F) {
    LAS unsigned char* lds = F.lds + RING_OFF;
    for (int i = F.tid; i < 12 * attn::BIAS_STRIDE; i += NWAVES * 64) ((LAS float*)(lds + attn::LDS_BIAS))[i] = F.BIAS2[i];
    __syncthreads();
    for (int it = F.vcu; it < 3 * 128 * 4; it += F.G) {
        const int j = it & 3, q = (it >> 2) & 127, g = it >> 9;
        attn::item(lds, g, q, j, F.QG, F.KG, F.VG, F.OG, F.LSE, F.tid, F.lane, F.wave);
    }
    const int ch = F.tid & 127;
    f32x4 w0[2], w1[2], w2[2];
#pragma unroll
    for (int h = 0; h < 2; ++h) { w0[h] = *(const f32x4*)(F.convw + 8 * ch + 4 * h); w1[h] = *(const f32x4*)(F.convw + 1024 + 8 * ch + 4 * h); w2[h] = *(const f32x4*)(F.convw + 2048 + 8 * ch + 4 * h); }
    for (int tile = F.vcu; tile < T_ / 64; tile += F.G) {
#pragma unroll 4
        for (int i = 0; i < 16; ++i) {
            const int t = tile * 64 + (F.tid >> 7) + 4 * i, s = t & 2047;
            const u32x4 z = (u32x4){0u, 0u, 0u, 0u};
            const u32x4 a0 = *(const u32x4*)(F.U + (size_t)t * 1024 + 8 * ch);
            const u32x4 a1 = (s >= 1) ? *(const u32x4*)(F.U + (size_t)(t - 1) * 1024 + 8 * ch) : z;
            const u32x4 a2 = (s >= 2) ? *(const u32x4*)(F.U + (size_t)(t - 2) * 1024 + 8 * ch) : z;
            const u32x4 cb = *(const u32x4*)(F.CB + (size_t)t * 1024 + 8 * ch);
            f32x4 r0, r1;
            r0[0] = bf_lo(cb.x) * (w2[0][0] * bf_lo(a0.x) + w1[0][0] * bf_lo(a1.x) + w0[0][0] * bf_lo(a2.x));
            r0[1] = bf_hi(cb.x) * (w2[0][1] * bf_hi(a0.x) + w1[0][1] * bf_hi(a1.x) + w0[0][1] * bf_hi(a2.x));
            r0[2] = bf_lo(cb.y) * (w2[0][2] * bf_lo(a0.y) + w1[0][2] * bf_lo(a1.y) + w0[0][2] * bf_lo(a2.y));
            r0[3] = bf_hi(cb.y) * (w2[0][3] * bf_hi(a0.y) + w1[0][3] * bf_hi(a1.y) + w0[0][3] * bf_hi(a2.y));
            r1[0] = bf_lo(cb.z) * (w2[1][0] * bf_lo(a0.z) + w1[1][0] * bf_lo(a1.z) + w0[1][0] * bf_lo(a2.z));
            r1[1] = bf_hi(cb.z) * (w2[1][1] * bf_hi(a0.z) + w1[1][1] * bf_hi(a1.z) + w0[1][1] * bf_hi(a2.z));
            r1[2] = bf_lo(cb.w) * (w2[1][2] * bf_lo(a0.w) + w1[1][2] * bf_lo(a1.w) + w0[1][2] * bf_lo(a2.w));
            r1[3] = bf_hi(cb.w) * (w2[1][3] * bf_hi(a0.w) + w1[1][3] * bf_hi(a1.w) + w0[1][3] * bf_hi(a2.w));
            *(u32x4*)(F.A2 + (size_t)t * K2 + 256 + 8 * ch) = pack8(r0, r1);
        }
    }
}
__device__ __forceinline__ void p2b_combine(Frame& F) {
    const int gt = F.vcu * NWAVES * 64 + F.tid, NT = F.G * NWAVES * 64;
    for (int idx = gt; idx < T_ * 32; idx += NT) {
        const int t = idx >> 5, c8 = idx & 31, j = c8 >> 3;
        const float l0 = F.LSE[(size_t)t * 4 + j], l1 = F.LSE[(size_t)T_ * 4 + t * 4 + j], l2 = F.LSE[(size_t)2 * T_ * 4 + t * 4 + j];
        const float mx = fmaxf(l0, fmaxf(l1, l2));
        float e0 = __builtin_amdgcn_exp2f(l0 - mx), e1 = __builtin_amdgcn_exp2f(l1 - mx), e2 = __builtin_amdgcn_exp2f(l2 - mx);
        const float inv = __builtin_amdgcn_rcpf(e0 + e1 + e2); e0 *= inv; e1 *= inv; e2 *= inv;
        const u32x4 a = *(const u32x4*)(F.OG + (size_t)t * 256 + 8 * c8), b = *(const u32x4*)(F.OG + (size_t)T_ * 256 + (size_t)t * 256 + 8 * c8), c = *(const u32x4*)(F.OG + (size_t)2 * T_ * 256 + (size_t)t * 256 + 8 * c8);
        u32x4 w;
        w.x = pk2(e0 * bf_lo(a.x) + e1 * bf_lo(b.x) + e2 * bf_lo(c.x), e0 * bf_hi(a.x) + e1 * bf_hi(b.x) + e2 * bf_hi(c.x));
        w.y = pk2(e0 * bf_lo(a.y) + e1 * bf_lo(b.y) + e2 * bf_lo(c.y), e0 * bf_hi(a.y) + e1 * bf_hi(b.y) + e2 * bf_hi(c.y));
        w.z = pk2(e0 * bf_lo(a.z) + e1 * bf_lo(b.z) + e2 * bf_lo(c.z), e0 * bf_hi(a.z) + e1 * bf_hi(b.z) + e2 * bf_hi(c.z));
        w.w = pk2(e0 * bf_lo(a.w) + e1 * bf_lo(b.w) + e2 * bf_lo(c.w), e0 * bf_hi(a.w) + e1 * bf_hi(b.w) + e2 * bf_hi(c.w));
        *(u32x4*)(F.A2 + (size_t)t * K2 + 8 * c8) = w;
    }
}
__device__ __forceinline__ void p5_router(Frame& F) {
    LAS float* wt = (LAS float*)(F.lds + RING_OFF);
    constexpr int WTS = 1028;
    LAS int* te = (LAS int*)(F.lds + LDS_TOK); LAS float* tw = (LAS float*)(F.lds + LDS_TOK + 1024); LAS int* rk = (LAS int*)(F.lds + LDS_TOK + 2048);
    LAS int* hist = (LAS int*)(F.lds + LDS_TOK + 3072); LAS int* base = hist + 32;
    for (int i = F.tid; i < 1024 * 32; i += NWAVES * 64) { const int k = i >> 5, e = i & 31; wt[e * WTS + k] = F.w_r[i]; }
    const int lane = F.lane;
    const int myexp = lane >> 1;
    const float mybias = F.b_r[myexp];
    for (int tile = F.vcu; tile < T_ / 64; tile += F.G) {
        if (F.tid < 32) hist[F.tid] = 0;
        __syncthreads();
        for (int i = 0; i < 8; ++i) {
            const int tl = F.wave * 8 + i, t = tile * 64 + tl;
            const GAS f32x4* xr = (const GAS f32x4*)(F.out + (size_t)t * D_) + lane; const GAS f32x4* gr = (const GAS f32x4*)F.n2g + lane;
            f32x4 v[4]; float s2 = 0.f;
#pragma unroll
            for (int j = 0; j < 4; ++j) { v[j] = xr[64 * j]; s2 += (v[j].x * v[j].x + v[j].y * v[j].y) + (v[j].z * v[j].z + v[j].w * v[j].w); }
            const float rstd = 1.f / sqrtf(wave_sum(s2) * (1.f / D_) + EPS);
            GAS unsigned long long* o8 = (GAS unsigned long long*)(F.H + (size_t)t * D_) + lane;
#pragma unroll
            for (int j = 0; j < 4; ++j) { const f32x4 gg = gr[64 * j]; v[j] = v[j] * rstd * gg;
                o8[64 * j] = (unsigned long long)pk2(v[j].x, v[j].y) | ((unsigned long long)pk2(v[j].z, v[j].w) << 32); }
            float lg[32];
#pragma unroll
            for (int e = 0; e < 32; ++e) {
                float a = 0.f;
#pragma unroll
                for (int j = 0; j < 4; ++j) { const f32x4 w = *(const LAS f32x4*)(wt + e * WTS + 256 * j + 4 * lane); a += (v[j].x * w.x + v[j].y * w.y) + (v[j].z * w.z + v[j].w * w.w); }
                lg[e] = a;
            }
            { const bool hi = (lane & 32) != 0;
#pragma unroll
              for (int k = 0; k < 16; ++k) { const float send = hi ? lg[k] : lg[k + 16], keep = hi ? lg[k + 16] : lg[k]; lg[k] = keep + __shfl_xor(send, 32); } }
            { const bool hi = (lane & 16) != 0;
#pragma unroll
              for (int k = 0; k < 8; ++k) { const float send = hi ? lg[k] : lg[k + 8], keep = hi ? lg[k + 8] : lg[k]; lg[k] = keep + __shfl_xor(send, 16); } }
            { const bool hi = (lane & 8) != 0;
#pragma unroll
              for (int k = 0; k < 4; ++k) { const float send = hi ? lg[k] : lg[k + 4], keep = hi ? lg[k + 4] : lg[k]; lg[k] = keep + __shfl_xor(send, 8); } }
            { const bool hi = (lane & 4) != 0;
#pragma unroll
              for (int k = 0; k < 2; ++k) { const float send = hi ? lg[k] : lg[k + 2], keep = hi ? lg[k + 2] : lg[k]; lg[k] = keep + __shfl_xor(send, 4); } }
            { const bool hi = (lane & 2) != 0; const float send = hi ? lg[0] : lg[1], keep = hi ? lg[1] : lg[0]; lg[0] = keep + __shfl_xor(send, 2); }
            float val = lg[0] + __shfl_xor(lg[0], 1) + mybias;
            float tv[4]; int ti[4];
#pragma unroll
            for (int k = 0; k < 4; ++k) {
                const float mx = wave_max(val);
                const unsigned long long bal = __ballot(val == mx);
                const int src = __ffsll((long long)bal) - 1;
                ti[k] = src >> 1; tv[k] = mx;
                if (myexp == ti[k]) val = -INFINITY;
            }
            if (lane == 0) {
                const float e1 = __expf(tv[1] - tv[0]), e2 = __expf(tv[2] - tv[0]), e3 = __expf(tv[3] - tv[0]);
                const float inv = 1.f / (1.f + e1 + e2 + e3);
                const float ww[4] = {inv, e1 * inv, e2 * inv, e3 * inv};
#pragma unroll
                for (int k = 0; k < 4; ++k) { te[tl * 4 + k] = ti[k]; tw[tl * 4 + k] = ww[k]; rk[tl * 4 + k] = atomicAdd((int*)&hist[ti[k]], 1); }
            }
        }
        __syncthreads();
        if (F.tid < 32) base[F.tid] = (int)__hip_atomic_fetch_add((unsigned*)F.CNT + F.tid, (unsigned)hist[F.tid], __ATOMIC_RELAXED, __HIP_MEMORY_SCOPE_AGENT);
        __syncthreads();
        if (F.tid < 256) {
            const int tl = F.tid >> 2, t = tile * 64 + tl, e = te[F.tid], slot = base[e] + rk[F.tid];
            F.LISTS[(size_t)e * T_ + slot] = t; F.TOKE[t * 4 + (F.tid & 3)] = e; F.TOKS[t * 4 + (F.tid & 3)] = slot; F.TOKW[t * 4 + (F.tid & 3)] = tw[F.tid];
        }
        __syncthreads();
    }
}

struct MoeTable { LAS int* cnt; LAS int* tstart; };
__device__ __forceinline__ MoeTable moe_table(Frame& F) {
    MoeTable M; M.cnt = (LAS int*)(F.lds + LDSCTL_OFF); M.tstart = M.cnt + 32;
    if (F.tid < 32) M.cnt[F.tid] = (int)__hip_atomic_load((unsigned*)F.CNT + F.tid, __ATOMIC_RELAXED, __HIP_MEMORY_SCOPE_AGENT);
    __syncthreads();
    if (F.tid == 0) { int a = 0; for (int e = 0; e < 32; ++e) { M.tstart[e] = a; a += (M.cnt[e] + 255) >> 8; } M.tstart[32] = a; }
    __syncthreads();
    return M;
}
template <int NN, bool GU>
struct MoeOrder {
    MoeTable M; const char* A; const char* Bt; const int* lists; int G, c, total;
    __device__ void init(const MoeTable& M_, const void* A_, const void* Bt_, const int* lists_, int G_, int c_) { M = M_; A = (const char*)A_; Bt = (const char*)Bt_; lists = lists_; G = G_; c = c_; total = M.tstart[32] * NN; }
    __device__ bool next(int i, pg8::Unit& u) const {
        const int L = i * G + c; if (L >= total) return false;
        const int mt = L / NN, pn = L % NN;
        int e = 0; while (M.tstart[e + 1] <= mt) ++e;
        u.pm = mt; u.pn = pn; u.e = e; u.rows = (mt - M.tstart[e]) * 256;
        u.b = Bt + ((size_t)e * (NN * 256) + (size_t)pn * 256) * 1024 * 2;
        u.a = GU ? A : A + (size_t)mt * 256 * 1024 * 2;
        return true;
    }
    __device__ __forceinline__ unsigned row_off(const pg8::Unit& u, int r) const {
        int lr = u.rows + r; const int ce = M.cnt[u.e]; if (lr >= ce) lr = 0;
        return (unsigned)lists[(size_t)u.e * T_ + lr] * 2048u;
    }
};

__device__ __forceinline__ void p8_final(Frame& F, const MoeTable& M) {
    const int gw = F.vcu * NWAVES + F.wave, NGW = F.G * NWAVES, lane = F.lane;
    for (int t = gw; t < T_; t += NGW) {
        int e4 = 0, s4 = 0; float w4 = 0.f;
        if (lane < 4) { e4 = F.TOKE[t * 4 + lane]; s4 = F.TOKS[t * 4 + lane]; w4 = F.TOKW[t * 4 + lane]; }
        f32x4 a[4];
        GAS f32x4* op = (GAS f32x4*)(F.out + (size_t)t * D_) + 2 * lane;
#pragma unroll
        for (int h = 0; h < 2; ++h) { a[2 * h] = op[128 * h]; a[2 * h + 1] = op[128 * h + 1]; }
#pragma unroll
        for (int k = 0; k < 4; ++k) {
            const int e = __shfl(e4, k), sl = __shfl(s4, k); const float w = __shfl(w4, k);
            const bf16* yr = F.YS + ((size_t)M.tstart[e] * 256 + sl) * 1024 + 8 * lane;
#pragma unroll
            for (int h = 0; h < 2; ++h) { const u32x4 y = *(const u32x4*)(yr + 512 * h);
                a[2 * h] += w * (f32x4){bf_lo(y.x), bf_hi(y.x), bf_lo(y.y), bf_hi(y.y)}; a[2 * h + 1] += w * (f32x4){bf_lo(y.z), bf_hi(y.z), bf_lo(y.w), bf_hi(y.w)}; }
        }
#pragma unroll
        for (int h = 0; h < 2; ++h) { op[128 * h] = a[2 * h]; op[128 * h + 1] = a[2 * h + 1]; }
    }
}
struct Args { const float* in[17]; float* out; unsigned char* ws; int ph_lo, ph_hi; };
constexpr int N_PHASES = 10;
__global__ void __launch_bounds__(NWAVES * 64, 2) mk_fwd(Args args) {
    extern __shared__ __attribute__((aligned(16))) unsigned char lds[];
    Frame F;
    F.lds = (LAS unsigned char*)lds;
    F.MISC = (volatile LAS unsigned*)(F.lds + MISC_OFF);
    F.tid = threadIdx.x; F.lane = F.tid & 63; F.wave = __builtin_amdgcn_readfirstlane(F.tid >> 6);
    F.G = gridDim.x; { const int bx = blockIdx.x; F.vcu = (F.G % 8 == 0) ? (bx % 8) * (F.G / 8) + bx / 8 : bx; }
    unsigned char* ws = args.ws;
    F.ctl = (gu32*)(ws + WS_CTL);
    F.x = args.in[0]; F.n1g = args.in[1]; F.w_in = args.in[2]; F.gq = args.in[3]; F.gk = args.in[4]; F.relb = args.in[5]; F.convw = args.in[6]; F.w_bc = args.in[7]; F.w_ba = args.in[8];
    F.w_out = args.in[9]; F.n2g = args.in[10]; F.w_r = args.in[11]; F.b_r = args.in[12]; F.w_gu = args.in[13]; F.b_gu = args.in[14]; F.w_d = args.in[15]; F.b_d = args.in[16]; F.out = args.out;
    F.WT1 = (bf16*)(ws + WS_WT1); F.WT2 = (bf16*)(ws + WS_WT2); F.WT3 = (bf16*)(ws + WS_WT3); F.WGU = (bf16*)(ws + WS_WGU); F.WD = (bf16*)(ws + WS_WD);
    F.H = (bf16*)(ws + WS_H); F.U = (bf16*)(ws + WS_U); F.CB = (bf16*)(ws + WS_CB); F.QG = (bf16*)(ws + WS_QG); F.KG = (bf16*)(ws + WS_KG); F.VG = (bf16*)(ws + WS_VG);
    F.SGC = (bf16*)(ws + WS_SGC); F.RAT = (bf16*)(ws + WS_RAT); F.OG = (bf16*)(ws + WS_OG); F.A2 = (bf16*)(ws + WS_A2); F.MERGED = (bf16*)(ws + WS_MERGED);
    F.ACT = (bf16*)(ws + WS_ACT); F.YS = (bf16*)(ws + WS_YS); F.LSE = (float*)(ws + WS_LSE); F.BIAS2 = (float*)(ws + WS_BIAS2); F.TOKW = (float*)(ws + WS_TOKW);
    F.LISTS = (int*)(ws + WS_LISTS); F.TOKE = (int*)(ws + WS_TOKE); F.TOKS = (int*)(ws + WS_TOKS); F.CNT = (int*)(ws + WS_CTL) + CW_CNT;
    for (int u = F.tid; u < (LDS_BYTES - LDSCTL_OFF) / 4; u += NWAVES * 64) ((LAS unsigned*)(F.lds + LDSCTL_OFF))[u] = 0u;
    __syncthreads();
    const int lo = args.ph_lo, hi = args.ph_hi;
    const bool multi = (hi - lo) > 1;
    XcdBarrier bar; bar.bar = (unsigned*)(F.ctl + CW_BAR); bar.x = 0; bar.st = nullptr;
    if (multi) bar = xcd_barrier_post((unsigned*)(F.ctl + CW_BAR), F.MISC + 8);
#ifndef PH_MASK
#define PH_MASK 0x3ff
#endif
#define IN(k) (((PH_MASK >> (k)) & 1) && lo <= (k) && (k) < hi)
#define SEAM(k) do { if (IN(k) && IN((k) + 1)) xcd_barrier(bar); } while (0)
    if (IN(0)) { p0_prologue(F); } SEAM(0);
    if (IN(1)) {
        pg8::DenseOrder S; S.init(F.H, F.WT1, T_, INW, 1024, F.G, (int)blockIdx.x);
        Epi1 E{F.U, F.CB, F.QG, F.KG, F.VG, F.SGC, F.RAT, F.gq, F.gk};
        pg8::gemm_phase<Epi1, pg8::DenseOrder, true, false>(F.lds + RING_OFF, 1024, S, E);
    } SEAM(1);
    if (IN(2)) { p2_attn_conv(F); } SEAM(2);
    if (IN(3)) { p2b_combine(F); } SEAM(3);
    if (IN(4)) {
        pg8::DenseOrder S; S.init(F.A2, F.WT2, T_, 1024, K2, F.G, (int)blockIdx.x);
        Epi2 E{F.SGC, F.RAT, F.MERGED};
        pg8::gemm_phase<Epi2, pg8::DenseOrder, true, false>(F.lds + RING_OFF, K2, S, E);
    } SEAM(4);
    if (IN(5)) {
        pg8::DenseOrder S; S.init(F.MERGED, F.WT3, T_, 1024, 1024, F.G, (int)blockIdx.x);
        Epi3 E{F.x, F.out};
        pg8::gemm_phase<Epi3, pg8::DenseOrder, true, false>(F.lds + RING_OFF, 1024, S, E);
    } SEAM(5);
    if (IN(6)) { p5_router(F); } SEAM(6);
    if (IN(7)) {
        const MoeTable M = moe_table(F);
        MoeOrder<8, true> S; S.init(M, F.H, F.WGU, F.LISTS, F.G, (int)blockIdx.x);
        EpiGU E{F.ACT, F.b_gu};
        pg8::gemm_phase<EpiGU, MoeOrder<8, true>, true, true>(F.lds + RING_OFF, 1024, S, E);
    } SEAM(7);
    if (IN(8)) {
        const MoeTable M = moe_table(F);
        MoeOrder<4, false> S; S.init(M, F.ACT, F.WD, F.LISTS, F.G, (int)blockIdx.x);
        EpiDN E{F.YS, F.b_d};
        pg8::gemm_phase<EpiDN, MoeOrder<4, false>, true, false>(F.lds + RING_OFF, 1024, S, E);
    } SEAM(8);
    if (IN(9)) { const MoeTable M = moe_table(F); p8_final(F, M); }
#undef IN
#undef SEAM
}

static int mk_grid = 0;
static int mk_setup() {
    if (mk_grid != 0) return mk_grid;
    int dev = 0, cus = 0, per_cu = 0;
    if (hipGetDevice(&dev) != hipSuccess || hipDeviceGetAttribute(&cus, hipDeviceAttributeMultiprocessorCount, dev) != hipSuccess) { mk_grid = -1; return mk_grid; }
    if (hipFuncSetAttribute((const void*)mk_fwd, hipFuncAttributeMaxDynamicSharedMemorySize, LDS_BYTES) != hipSuccess) { fprintf(stderr, "hipFuncSetAttribute failed\n"); mk_grid = -1; return mk_grid; }
    if (hipOccupancyMaxActiveBlocksPerMultiprocessor(&per_cu, (const void*)mk_fwd, NWAVES * 64, LDS_BYTES) != hipSuccess || per_cu < 1) { fprintf(stderr, "occupancy query: %d blocks/CU\n", per_cu); (void)hipGetLastError(); mk_grid = -1; return mk_grid; }
    mk_grid = cus;
    return mk_grid;
}
static void mk_launch(void* const* d_in, void* d_out, void* d_ws, hipStream_t stream, int lo, int hi) {
    const int grid = mk_setup(); if (grid <= 0) return;
    Args a{};
    for (int i = 0; i < 17; ++i) a.in[i] = (const float*)d_in[i];
    a.out = (float*)d_out; a.ws = (unsigned char*)d_ws; a.ph_lo = lo; a.ph_hi = hi;
    hipLaunchKernelGGL(mk_fwd, dim3(grid), dim3(NWAVES * 64), LDS_BYTES, stream, a);
}
extern "C" void kernel_launch(void* const* d_in, const int* in_sizes, int n_in, void* d_out, int out_size, void* d_ws, size_t ws_size, hipStream_t stream) {
    (void)hipMemsetAsync((char*)d_ws + WS_CTL, 0, CTL_ZERO_BYTES, stream);
    for (int p = 0; p < N_PHASES; ++p) mk_launch(d_in, d_out, d_ws, stream, p, p + 1);
}
```

```cpp
#include <hip/hip_runtime.h>
#include <stdint.h>
#include <cstdio>

constexpr int B_ = 8, S_ = 2048, D_ = 1024, T_ = B_ * S_;
constexpr int INW = 7424, NE = 32;
constexpr int OFF_CB = 0, OFF_CC = 1024, OFF_CX = 2048, OFF_Q = 3072, OFF_K = 3840, OFF_V = 4608, OFF_GC = 5376, OFF_GA = 6400;
constexpr float EPS = 1e-6f;
constexpr float LOG2E = 1.4426950408889634f, LN2 = 0.6931471805599453f;
constexpr float QSCALE = 0.125f * LOG2E;
constexpr int K2 = 1280;
constexpr int PMAX = 65536 + 32 * 256;

#define GAS __attribute__((address_space(1)))
#define LAS __attribute__((address_space(3)))
typedef unsigned short bf16;
typedef short bf16x8 __attribute__((ext_vector_type(8)));
typedef short s16x4 __attribute__((ext_vector_type(4)));
typedef float f32x4 __attribute__((ext_vector_type(4)));
typedef float f32x2 __attribute__((ext_vector_type(2)));
typedef unsigned u32x4 __attribute__((ext_vector_type(4)));
typedef unsigned u32x2 __attribute__((ext_vector_type(2)));
typedef __bf16 bf16x2_t __attribute__((ext_vector_type(2)));

__device__ __forceinline__ unsigned pk2(float lo, float hi) { f32x2 v = {lo, hi}; bf16x2_t b = __builtin_convertvector(v, bf16x2_t); return __builtin_bit_cast(unsigned, b); }
__device__ __forceinline__ float bf_lo(unsigned u) { return __uint_as_float(u << 16); }
__device__ __forceinline__ float bf_hi(unsigned u) { return __uint_as_float(u & 0xffff0000u); }
__device__ __forceinline__ float sigmoidf_(float x) { return __builtin_amdgcn_rcpf(1.f + __builtin_amdgcn_exp2f(-LOG2E * x)); }

namespace pg8 {
constexpr int BM = 256, BK = 64, HALF = 128, HTB = HALF * BK * 2, STAGE_BYTES = 8 * HTB, NXCD = 8, WGM = 8;
__host__ __device__ __forceinline__ int lds_byte(int r, int c) { const int st = (r >> 4) * 2 + (c >> 5), rr = r & 15, cc = c & 31, ob = rr * 64 + cc * 2; return st * 1024 + (ob ^ (((ob >> 9) & 1) << 5)); }
__host__ __device__ __forceinline__ void stage_rc(int b, int& R, int& C) { const int st = b / 1024, sb = b % 1024, swz = sb ^ (((sb >> 9) & 1) << 5); R = (st >> 1) * 16 + swz / 64; C = (st & 1) * 32 + (swz % 64) / 2; }
__host__ __device__ __forceinline__ int perm32(int rho) { const int n = rho >> 4, i = rho & 15; return 8 * (i >> 2) + 4 * n + (i & 3); }

struct Unit { const char* a; const char* b; int pm, pn, e, rows; };

struct DenseOrder {
    const char* A; const char* Bt; int K, nM, nN, nwg, G, c;
    __device__ void init(const void* A_, const void* Bt_, int M, int N, int K_, int G_, int c_) { A = (const char*)A_; Bt = (const char*)Bt_; K = K_; nM = M / BM; nN = N / BM; nwg = nM * nN; G = G_; c = c_; }
    __device__ bool next(int i, Unit& u) const {
        const long L = (long)i * G + c; if (L >= nwg) return false;
        int wgid = (int)L; { const int q = nwg / NXCD, r = nwg % NXCD, xcd = wgid % NXCD, off = wgid / NXCD; wgid = (xcd < r ? xcd * (q + 1) : r * (q + 1) + (xcd - r) * q) + off; }
        const int nig = WGM * nN, gid = wgid / nig, fm = gid * WGM, gsz = (nM - fm) < WGM ? (nM - fm) : WGM;
        u.pm = fm + ((wgid % nig) % gsz); u.pn = (wgid % nig) / gsz; u.e = 0; u.rows = 256;
        u.a = A + (size_t)u.pm * BM * K * 2; u.b = Bt + (size_t)u.pn * BM * K * 2; return true;
    }
    __device__ __forceinline__ unsigned row_off(const Unit&, int) const { return 0u; }
};

template <class Epi, class Sched, bool ALIGN_EPI, bool GATHER>
__device__ __forceinline__ void gemm_phase(LAS unsigned char* lds, const int K, const Sched& S, const Epi& E) {
    const int tid = threadIdx.x, wid = __builtin_amdgcn_readfirstlane(tid >> 6), lane = tid & 63, wr = wid >> 2, wc = wid & 3, fr = lane & 15, fq = lane >> 4;
    const int nt = K / BK;
    unsigned voffA[2], voffB[2]; int RA[2]; unsigned CA2[2];
#pragma unroll
    for (int i = 0; i < 2; ++i) { int R, C; stage_rc(tid * 16 + i * 8192, R, C); const int Rb = (R & ~31) + perm32(R & 31);
        voffA[i] = (unsigned)(R * K + C) * 2u; voffB[i] = (unsigned)(Rb * K + C) * 2u; RA[i] = R; CA2[i] = (unsigned)C * 2u; }
    const size_t kstep = (size_t)(BK * 2);
    const size_t hstep = (size_t)HALF * K * 2;
    const unsigned ldsw = (unsigned)wid * 1024u;
    const int aoff = lds_byte(wr * 64 + fr, fq * 8), boff = lds_byte(wc * 32 + fr, fq * 8);
#define PG8_SA(b, h) (((b) * 2 + (h)) * HTB)
#define PG8_SB(b, h) ((4 + (b) * 2 + (h)) * HTB)
#define PG8_STAGE2(bufoff, gbase, o0, o1) do { \
        __builtin_amdgcn_global_load_lds((const unsigned*)((const char*)(gbase) + (o0)), (LAS unsigned*)(lds + (bufoff) + ldsw), 16, 0, 0); \
        __builtin_amdgcn_global_load_lds((const unsigned*)((const char*)(gbase) + (o1)), (LAS unsigned*)(lds + (bufoff) + ldsw + 8192), 16, 0, 0); } while (0)
#define PG8_STB(bufoff, gbase) PG8_STAGE2(bufoff, gbase, voffB[0], voffB[1])
#define PG8_STA(bufoff, gbase, h, nx) do { if constexpr (GATHER) { const unsigned o0_ = (nx) ? gn[h][0] : gc[h][0], o1_ = (nx) ? gn[h][1] : gc[h][1]; PG8_STAGE2(bufoff, gbase, o0_, o1_); } \
        else { PG8_STAGE2(bufoff, (gbase) + (h) * hstep, voffA[0], voffA[1]); } } while (0)
#define PG8_LDA(dst, b, h) do { _Pragma("unroll") for (int m = 0; m < 4; ++m) _Pragma("unroll") for (int k = 0; k < 2; ++k) dst[m][k] = *(const LAS bf16x8*)(lds + PG8_SA(b, h) + aoff + m * 2048 + k * 1024); } while (0)
#define PG8_LDB(dst, b, h) do { _Pragma("unroll") for (int n = 0; n < 2; ++n) _Pragma("unroll") for (int k = 0; k < 2; ++k) dst[n][k] = *(const LAS bf16x8*)(lds + PG8_SB(b, h) + boff + n * 2048 + k * 1024); } while (0)
#define PG8_MMA(ai, bj, At, Bt) do { __builtin_amdgcn_s_setprio(1); _Pragma("unroll") for (int m = 0; m < 4; ++m) _Pragma("unroll") for (int n = 0; n < 2; ++n) _Pragma("unroll") for (int k = 0; k < 2; ++k) \
        acc[ai][bj][m][n] = __builtin_amdgcn_mfma_f32_16x16x32_bf16(Bt[n][k], At[m][k], acc[ai][bj][m][n], 0, 0, 0); __builtin_amdgcn_s_setprio(0); } while (0)
#define PG8_WAIT_V(n) asm volatile("s_waitcnt vmcnt(" #n ")" ::: "memory")
#define PG8_WAIT_L(n) asm volatile("s_waitcnt lgkmcnt(" #n ")" ::: "memory")
#define PG8_BAR __builtin_amdgcn_s_barrier()
#define PG8_SCHED __builtin_amdgcn_sched_barrier(0)
#define PG8_KBODY do { \
            const bool last = (t == nt - 2); \
            const char* a1 = cA + (size_t)(t + 1) * kstep; \
            const char* a2 = last ? nA : cA + (size_t)(t + 2) * kstep; const char* b2 = last ? nB : cB + (size_t)(t + 2) * kstep; \
            const char* a3 = a2 + kstep; const char* b3 = b2 + kstep; \
            PG8_LDB(B0, 0, 0); PG8_LDB(B1, 0, 1); PG8_SCHED; PG8_LDA(At, 0, 0); PG8_STA(PG8_SA(1, 1), a1, 1, false); \
            PG8_WAIT_V(8); PG8_WAIT_L(0); PG8_BAR; PG8_MMA(0, 0, At, B0); PG8_MMA(0, 1, At, B1); PG8_BAR; PG8_SCHED; \
            PG8_LDA(At, 0, 1); PG8_STB(PG8_SB(0, 0), b2); PG8_STB(PG8_SB(0, 1), b2 + hstep); PG8_STA(PG8_SA(0, 0), a2, 0, last); \
            PG8_WAIT_V(8); PG8_WAIT_L(0); PG8_BAR; PG8_MMA(1, 0, At, B0); PG8_MMA(1, 1, At, B1); PG8_BAR; PG8_SCHED; \
            PG8_LDB(B0, 1, 0); PG8_LDB(B1, 1, 1); PG8_SCHED; PG8_LDA(At, 1, 0); PG8_STA(PG8_SA(0, 1), a2, 1, last); \
            PG8_WAIT_V(8); PG8_WAIT_L(0); PG8_BAR; PG8_MMA(0, 0, At, B0); PG8_MMA(0, 1, At, B1); PG8_BAR; PG8_SCHED; \
            PG8_LDA(At, 1, 1); PG8_STB(PG8_SB(1, 0), b3); PG8_STB(PG8_SB(1, 1), b3 + hstep); PG8_STA(PG8_SA(1, 0), a3, 0, last); \
            PG8_WAIT_V(8); PG8_WAIT_L(0); PG8_BAR; PG8_MMA(1, 0, At, B0); PG8_MMA(1, 1, At, B1); PG8_BAR; PG8_SCHED; \
        } while (0)
    Unit cur, nxt; int ui = 0;
    if (!S.next(0, cur)) return;
    f32x4 acc[2][2][4][2];
#pragma unroll
    for (int a = 0; a < 2; ++a)
#pragma unroll
        for (int b = 0; b < 2; ++b)
#pragma unroll
            for (int m = 0; m < 4; ++m)
#pragma unroll
                for (int n = 0; n < 2; ++n) acc[a][b][m][n] = (f32x4){0.f, 0.f, 0.f, 0.f};
    bf16x8 At[4][2], B0[2][2], B1[2][2];
    unsigned gc[2][2], gn[2][2];
    if constexpr (GATHER) {
#pragma unroll
        for (int h = 0; h < 2; ++h)
#pragma unroll
            for (int i = 0; i < 2; ++i) { gc[h][i] = S.row_off(cur, h * HALF + RA[i]) + CA2[i]; gn[h][i] = gc[h][i]; }
    }
    const char* cA = cur.a; const char* cB = cur.b;
    PG8_STB(PG8_SB(0, 0), cB); PG8_STB(PG8_SB(0, 1), cB + hstep); PG8_STA(PG8_SA(0, 0), cA, 0, false); PG8_STA(PG8_SA(0, 1), cA, 1, false);
    if (wr == 1) PG8_BAR;
    PG8_WAIT_V(2); PG8_BAR;
    PG8_STB(PG8_SB(1, 0), cB + kstep); PG8_STA(PG8_SA(1, 0), cA + kstep, 0, false); PG8_STB(PG8_SB(1, 1), cB + hstep + kstep);
    PG8_WAIT_V(6); PG8_BAR;
    for (;;) {
        const bool has_next = S.next(ui + 1, nxt);
        if constexpr (GATHER) {
            if (has_next) {
#pragma unroll
                for (int h = 0; h < 2; ++h)
#pragma unroll
                    for (int i = 0; i < 2; ++i) gn[h][i] = S.row_off(nxt, h * HALF + RA[i]) + CA2[i];
            }
        }
        const char* nA = has_next ? nxt.a : cA; const char* nB = has_next ? nxt.b : cB;
        if constexpr (Epi::MID_T > 0) {
            for (int t = 0; t < Epi::MID_T; t += 2) PG8_KBODY;
            E.mid(acc, cur, wr, wc, fr, fq);
            for (int t = Epi::MID_T; t < nt; t += 2) PG8_KBODY;
        } else {
            for (int t = 0; t < nt; t += 2) PG8_KBODY;
        }
        if constexpr (ALIGN_EPI) { if (wr == 0) PG8_BAR; }
        E(acc, cur, wr, wc, fr, fq);
        if (!has_next) break;
#pragma unroll
        for (int a = 0; a < 2; ++a)
#pragma unroll
            for (int b = 0; b < 2; ++b)
#pragma unroll
                for (int m = 0; m < 4; ++m)
#pragma unroll
                    for (int n = 0; n < 2; ++n) acc[a][b][m][n] = (f32x4){0.f, 0.f, 0.f, 0.f};
        cur = nxt; cA = nA; cB = nB; ++ui;
        if constexpr (GATHER) {
#pragma unroll
            for (int h = 0; h < 2; ++h)
#pragma unroll
                for (int i = 0; i < 2; ++i) gc[h][i] = gn[h][i];
        }
        if constexpr (ALIGN_EPI) { if (wr == 1) PG8_BAR; }
    }
    PG8_WAIT_V(0);
    if constexpr (!ALIGN_EPI) { if (wr == 0) PG8_BAR; }
    PG8_BAR;
#undef PG8_KBODY
#undef PG8_SA
#undef PG8_SB
#undef PG8_STAGE2
#undef PG8_STB
#undef PG8_STA
#undef PG8_LDA
#undef PG8_LDB
#undef PG8_MMA
#undef PG8_WAIT_V
#undef PG8_WAIT_L
#undef PG8_BAR
#undef PG8_SCHED
}
}
__device__ __forceinline__ int deint_row(int g, int t) {
    const int b = t & ~2047, s = t & 2047;
    if (g == 0) return t;
    if (g == 1) return b + (s & 3) * 512 + (s >> 2);
    return b + (s & 15) * 128 + (s >> 4);
}
__device__ __forceinline__ int reint_row(int g, int R) {
    const int b = R & ~2047, s = R & 2047;
    if (g == 0) return R;
    if (g == 1) return b + (s & 511) * 4 + (s >> 9);
    return b + (s & 127) * 16 + (s >> 7);
}
__device__ __forceinline__ u32x4 pack8(const f32x4 a, const f32x4 b) { u32x4 w; w.x = pk2(a[0], a[1]); w.y = pk2(a[2], a[3]); w.z = pk2(b[0], b[1]); w.w = pk2(b[2], b[3]); return w; }

__host__ __device__ __forceinline__ int colmap1(int nphys) {
    const int pn = nphys >> 8, x = nphys & 255, bj = x >> 7, y = x & 127;
    if (pn < 8) return (bj ? OFF_CX : OFF_CC) + 128 * pn + y;
    if (pn < 12) return OFF_CB + 256 * (pn - 8) + x;
    if (pn < 18) { const int isk = pn >= 15, g = (pn - 12) % 3, wc = y >> 5, xx = y & 31; return (isk ? OFF_K : OFF_Q) + 256 * g + 64 * wc + 32 * bj + xx; }
    if (pn < 21) return OFF_V + 256 * (pn - 18) + x;
    return (bj ? OFF_GA : OFF_GC) + 128 * (pn - 21) + y;
}
struct Epi1 {
    static constexpr int MID_T = 0;
    bf16* U; bf16* CB; bf16* QG; bf16* KG; bf16* VG; bf16* SGC; bf16* RAT; const float* gq; const float* gk;
    __device__ __forceinline__ void mid(f32x4 (&)[2][2][4][2], const pg8::Unit&, int, int, int, int) const {}
    __device__ __forceinline__ void operator()(const f32x4 (&acc)[2][2][4][2], const pg8::Unit& u, int wr, int wc, int fr, int fq) const {
        const int pn = u.pn, row0 = u.pm * 256 + wr * 64 + fr;
        if (pn < 8) {
            const int col = 128 * pn + 32 * wc + 8 * fq;
#pragma unroll
            for (int ai = 0; ai < 2; ++ai)
#pragma unroll
                for (int m = 0; m < 4; ++m) { const int row = row0 + ai * 128 + m * 16;
                    *(u32x4*)(U + (size_t)row * 1024 + col) = pack8(acc[ai][0][m][0] * acc[ai][1][m][0], acc[ai][0][m][1] * acc[ai][1][m][1]); }
        } else if (pn < 12) {
            const int col = 256 * (pn - 8) + 32 * wc + 8 * fq;
#pragma unroll
            for (int ai = 0; ai < 2; ++ai)
#pragma unroll
                for (int m = 0; m < 4; ++m) { const int row = row0 + ai * 128 + m * 16;
#pragma unroll
                    for (int bj = 0; bj < 2; ++bj) *(u32x4*)(CB + (size_t)row * 1024 + col + 128 * bj) = pack8(acc[ai][bj][m][0], acc[ai][bj][m][1]); }
        } else if (pn < 18) {
            const bool isk = pn >= 15; const int g = (pn - 12) % 3;
            const float* gg = isk ? gk : gq; bf16* dst = (isk ? KG : QG) + (size_t)g * T_ * 256;
            f32x4 gv[2][2];
#pragma unroll
            for (int bj = 0; bj < 2; ++bj)
#pragma unroll
                for (int n = 0; n < 2; ++n) gv[bj][n] = *(const f32x4*)(gg + 32 * bj + 8 * fq + 4 * n);
            const float sc = isk ? 1.f : QSCALE;
#pragma unroll
            for (int ai = 0; ai < 2; ++ai)
#pragma unroll
                for (int m = 0; m < 4; ++m) {
                    float ss = 0.f;
#pragma unroll
                    for (int bj = 0; bj < 2; ++bj)
#pragma unroll
                        for (int n = 0; n < 2; ++n) { const f32x4 x = acc[ai][bj][m][n]; ss += (x[0] * x[0] + x[1] * x[1]) + (x[2] * x[2] + x[3] * x[3]); }
                    ss += __shfl_xor(ss, 16); ss += __shfl_xor(ss, 32);
                    const float rs = __builtin_amdgcn_rsqf(ss * (1.f / 64.f) + EPS) * sc;
                    const int drow = deint_row(g, row0 + ai * 128 + m * 16);
                    bf16* p = dst + ((size_t)drow * 4 + wc) * 64 + 8 * fq;
#pragma unroll
                    for (int bj = 0; bj < 2; ++bj) *(u32x4*)(p + 32 * bj) = pack8(acc[ai][bj][m][0] * gv[bj][0] * rs, acc[ai][bj][m][1] * gv[bj][1] * rs);
                }
        } else if (pn < 21) {
            const int g = pn - 18; bf16* dst = VG + (size_t)g * T_ * 256;
#pragma unroll
            for (int ai = 0; ai < 2; ++ai)
#pragma unroll
                for (int m = 0; m < 4; ++m) { const int drow = deint_row(g, row0 + ai * 128 + m * 16);
#pragma unroll
                    for (int bj = 0; bj < 2; ++bj) *(u32x4*)(dst + (size_t)drow * 256 + 128 * bj + 32 * wc + 8 * fq) = pack8(acc[ai][bj][m][0], acc[ai][bj][m][1]); }
        } else {
            const int col = 128 * (pn - 21) + 32 * wc + 8 * fq;
#pragma unroll
            for (int ai = 0; ai < 2; ++ai)
#pragma unroll
                for (int m = 0; m < 4; ++m) { const int row = row0 + ai * 128 + m * 16;
                    f32x4 sc[2], rt[2];
#pragma unroll
                    for (int n = 0; n < 2; ++n)
#pragma unroll
                        for (int i = 0; i < 4; ++i) { const float s0 = sigmoidf_(acc[ai][0][m][n][i]), s1 = sigmoidf_(acc[ai][1][m][n][i]); sc[n][i] = s0; rt[n][i] = s1 * __builtin_amdgcn_rcpf(s0); }
                    *(u32x4*)(SGC + (size_t)row * 1024 + col) = pack8(sc[0], sc[1]);
                    *(u32x4*)(RAT + (size_t)row * 1024 + col) = pack8(rt[0], rt[1]); }
        }
    }
};

struct Epi2 {
    static constexpr int MID_T = 4;
    const bf16* SGC; const bf16* RAT; bf16* MERGED;
    __device__ __forceinline__ void mid(f32x4 (&acc)[2][2][4][2], const pg8::Unit& u, int wr, int wc, int fr, int fq) const {
        const int row0 = u.pm * 256 + wr * 64 + fr, col0 = u.pn * 256 + 32 * wc + 8 * fq;
#pragma unroll
        for (int ai = 0; ai < 2; ++ai)
#pragma unroll
            for (int m = 0; m < 4; ++m) {
#pragma unroll
                for (int bj = 0; bj < 2; ++bj) { const u32x4 r = *(const u32x4*)(RAT + (size_t)(row0 + ai * 128 + m * 16) * 1024 + col0 + 128 * bj);
                    acc[ai][bj][m][0] *= (f32x4){bf_lo(r.x), bf_hi(r.x), bf_lo(r.y), bf_hi(r.y)}; acc[ai][bj][m][1] *= (f32x4){bf_lo(r.z), bf_hi(r.z), bf_lo(r.w), bf_hi(r.w)}; }
                asm volatile("" : "+v"(acc[ai][0][m][0]), "+v"(acc[ai][0][m][1]), "+v"(acc[ai][1][m][0]), "+v"(acc[ai][1][m][1]));
                if (m & 1) asm volatile("" ::: "memory"); }
    }
    __device__ __forceinline__ void operator()(const f32x4 (&acc)[2][2][4][2], const pg8::Unit& u, int wr, int wc, int fr, int fq) const {
        const int row0 = u.pm * 256 + wr * 64 + fr, col0 = u.pn * 256 + 32 * wc + 8 * fq;
#pragma unroll
        for (int ai = 0; ai < 2; ++ai)
#pragma unroll
            for (int m = 0; m < 4; ++m)
#pragma unroll
                for (int bj = 0; bj < 2; ++bj) { const size_t off = (size_t)(row0 + ai * 128 + m * 16) * 1024 + col0 + 128 * bj; const u32x4 r = *(const u32x4*)(SGC + off);
                    *(u32x4*)(MERGED + off) = pack8(acc[ai][bj][m][0] * (f32x4){bf_lo(r.x), bf_hi(r.x), bf_lo(r.y), bf_hi(r.y)}, acc[ai][bj][m][1] * (f32x4){bf_lo(r.z), bf_hi(r.z), bf_lo(r.w), bf_hi(r.w)}); }
    }
};

struct Epi3 {
    static constexpr int MID_T = 0;
    const float* X; float* OUT;
    __device__ __forceinline__ void mid(f32x4 (&)[2][2][4][2], const pg8::Unit&, int, int, int, int) const {}
    __device__ __forceinline__ void operator()(const f32x4 (&acc)[2][2][4][2], const pg8::Unit& u, int wr, int wc, int fr, int fq) const {
        const int row0 = u.pm * 256 + wr * 64 + fr, col0 = u.pn * 256 + 32 * wc + 8 * fq;
#pragma unroll
        for (int ai = 0; ai < 2; ++ai)
#pragma unroll
            for (int m = 0; m < 4; ++m)
#pragma unroll
                for (int bj = 0; bj < 2; ++bj)
#pragma unroll
                    for (int n = 0; n < 2; ++n) { const size_t off = (size_t)(row0 + ai * 128 + m * 16) * 1024 + col0 + 128 * bj + 4 * n;
                        *(f32x4*)(OUT + off) = *(const f32x4*)(X + off) + acc[ai][bj][m][n]; }
    }
};

struct EpiGU {
    static constexpr int MID_T = 0;
    bf16* ACT; const float* bgu;
    __device__ __forceinline__ void mid(f32x4 (&)[2][2][4][2], const pg8::Unit&, int, int, int, int) const {}
    __device__ __forceinline__ void operator()(const f32x4 (&acc)[2][2][4][2], const pg8::Unit& u, int wr, int wc, int fr, int fq) const {
        const int row0 = u.pm * 256 + wr * 64 + fr, col = 128 * u.pn + 32 * wc + 8 * fq;
        const float* bg = bgu + (size_t)u.e * 2048 + col;
        f32x4 bgate[2], bup[2];
#pragma unroll
        for (int n = 0; n < 2; ++n) { bgate[n] = *(const f32x4*)(bg + 4 * n); bup[n] = *(const f32x4*)(bg + 1024 + 4 * n); }
#pragma unroll
        for (int ai = 0; ai < 2; ++ai)
#pragma unroll
            for (int m = 0; m < 4; ++m) { f32x4 o[2];
#pragma unroll
                for (int n = 0; n < 2; ++n)
#pragma unroll
                    for (int i = 0; i < 4; ++i) { const float gt = fminf(acc[ai][0][m][n][i] + bgate[n][i], 7.f); const float up = fminf(fmaxf(acc[ai][1][m][n][i] + bup[n][i], -7.f), 7.f);
                        o[n][i] = (up + 1.f) * gt * __builtin_amdgcn_rcpf(1.f + __builtin_amdgcn_exp2f(-1.702f * LOG2E * gt)); }
                *(u32x4*)(ACT + (size_t)(row0 + ai * 128 + m * 16) * 1024 + col) = pack8(o[0], o[1]); }
    }
};
struct EpiDN {
    static constexpr int MID_T = 0;
    bf16* YS; const float* bd;
    __device__ __forceinline__ void mid(f32x4 (&)[2][2][4][2], const pg8::Unit&, int, int, int, int) const {}
    __device__ __forceinline__ void operator()(const f32x4 (&acc)[2][2][4][2], const pg8::Unit& u, int wr, int wc, int fr, int fq) const {
        const int row0 = u.pm * 256 + wr * 64 + fr, col0 = 256 * u.pn + 32 * wc + 8 * fq;
        const float* bb = bd + (size_t)u.e * 1024 + col0;
        f32x4 bv[2][2];
#pragma unroll
        for (int bj = 0; bj < 2; ++bj)
#pragma unroll
            for (int n = 0; n < 2; ++n) bv[bj][n] = *(const f32x4*)(bb + 128 * bj + 4 * n);
#pragma unroll
        for (int ai = 0; ai < 2; ++ai)
#pragma unroll
            for (int m = 0; m < 4; ++m)
#pragma unroll
                for (int bj = 0; bj < 2; ++bj)
                    *(u32x4*)(YS + (size_t)(row0 + ai * 128 + m * 16) * 1024 + col0 + 128 * bj) = pack8(acc[ai][bj][m][0] + bv[bj][0], acc[ai][bj][m][1] + bv[bj][1]);
    }
};
namespace attn {
constexpr int KROW = 144;
constexpr int LDS_K = 0, LDS_V = 256 * KROW, LDS_BIAS = 2 * 256 * KROW, BIAS_STRIDE = 132;
constexpr int LDS_END = LDS_BIAS + 12 * BIAS_STRIDE * 4;
typedef short v4i16_t __attribute__((ext_vector_type(4)));
__device__ __forceinline__ s16x4 vtr(const LAS unsigned char* p) { return __builtin_bit_cast(s16x4, __builtin_amdgcn_ds_read_tr16_b64_v4i16((LAS v4i16_t*)p)); }

__device__ __forceinline__ void item(LAS unsigned char* lds, int g, int q, int j, const bf16* QG, const bf16* KG, const bf16* VG, bf16* OG, float* LSE, int tid, int lane, int wave) {
    const int nbm1 = (g == 0) ? 15 : (g == 1 ? 3 : 0);
    const bool hasprev = (q & nbm1) != 0;
    const size_t gofs = (size_t)g * T_ * 256 + j * 64;
    const bf16* Kg = KG + gofs; const bf16* Vg = VG + gofs; const bf16* Qg = QG + gofs;
    const int R0 = 128 * (q - 1), klo = hasprev ? 0 : 128;
#pragma unroll
    for (int it = 0; it < 4; ++it) {
        const int c = tid + it * 512, r = c >> 3, ch = c & 7;
        if (r >= klo) {
            const u32x4 kv = *(const u32x4*)(Kg + (size_t)(R0 + r) * 256 + ch * 8);
            const u32x4 vv = *(const u32x4*)(Vg + (size_t)(R0 + r) * 256 + ch * 8);
            *(LAS u32x4*)(lds + LDS_K + r * KROW + ch * 16) = kv;
            *(LAS u32x4*)(lds + LDS_V + r * KROW + ch * 16) = vv;
        }
    }
    const int ql = lane & 15, quad = lane >> 4;
    const int qi = 16 * wave + ql;
    const bf16* qp = Qg + (size_t)(128 * q + qi) * 256 + 8 * quad;
    const bf16x8 qf0 = *(const bf16x8*)(qp), qf1 = *(const bf16x8*)(qp + 32);
    __syncthreads();
    const LAS float* bias = (const LAS float*)(lds + LDS_BIAS) + (g * 4 + j) * BIAS_STRIDE;
    float m = -1e30f, l = 0.f;
    f32x4 o[4];
#pragma unroll
    for (int dt = 0; dt < 4; ++dt) o[dt] = (f32x4){0.f, 0.f, 0.f, 0.f};
    const int s_lo = hasprev ? (wave >> 1) : 4, s_hi = (wave >> 1) + 4;
    const LAS unsigned char* kbase = lds + LDS_K + ql * KROW + quad * 16;
    const LAS unsigned char* vbase = lds + LDS_V + (4 * quad + (ql >> 2)) * KROW + (ql & 3) * 8;
    for (int s = s_lo; s <= s_hi; ++s) {
        const LAS unsigned char* kp = kbase + 32 * s * KROW;
        const bf16x8 k00 = *(const LAS bf16x8*)(kp), k01 = *(const LAS bf16x8*)(kp + 64);
        const bf16x8 k10 = *(const LAS bf16x8*)(kp + 16 * KROW), k11 = *(const LAS bf16x8*)(kp + 16 * KROW + 64);
        f32x4 c0 = (f32x4){0.f, 0.f, 0.f, 0.f}, c1 = (f32x4){0.f, 0.f, 0.f, 0.f};
        c0 = __builtin_amdgcn_mfma_f32_16x16x32_bf16(k00, qf0, c0, 0, 0, 0);
        c0 = __builtin_amdgcn_mfma_f32_16x16x32_bf16(k01, qf1, c0, 0, 0, 0);
        c1 = __builtin_amdgcn_mfma_f32_16x16x32_bf16(k10, qf0, c1, 0, 0, 0);
        c1 = __builtin_amdgcn_mfma_f32_16x16x32_bf16(k11, qf1, c1, 0, 0, 0);
        float mx = -INFINITY;
#pragma unroll
        for (int i = 0; i < 4; ++i) {
            const int kj0 = 32 * s + 4 * quad + i, d0 = qi + 128 - kj0, d1 = d0 - 16;
            const bool v0 = (d0 >= 0) && (d0 <= 128) && (hasprev || kj0 >= 128);
            const bool v1 = (d1 >= 0) && (d1 <= 128) && (hasprev || kj0 + 16 >= 128);
            const float b0 = bias[min(max(d0, 0), 128)], b1 = bias[min(max(d1, 0), 128)];
            c0[i] = v0 ? c0[i] + b0 : -INFINITY; c1[i] = v1 ? c1[i] + b1 : -INFINITY;
            mx = fmaxf(mx, fmaxf(c0[i], c1[i]));
        }
        mx = fmaxf(mx, __shfl_xor(mx, 16)); mx = fmaxf(mx, __shfl_xor(mx, 32));
        const float mn = fmaxf(m, mx), alpha = __builtin_amdgcn_exp2f(m - mn);
        m = mn;
        float ps = 0.f;
#pragma unroll
        for (int i = 0; i < 4; ++i) { c0[i] = __builtin_amdgcn_exp2f(c0[i] - mn); c1[i] = __builtin_amdgcn_exp2f(c1[i] - mn); ps += c0[i] + c1[i]; }
        l = l * alpha + ps;
        u32x4 pw; pw.x = pk2(c0[0], c0[1]); pw.y = pk2(c0[2], c0[3]); pw.z = pk2(c1[0], c1[1]); pw.w = pk2(c1[2], c1[3]);
        const bf16x8 pf = __builtin_bit_cast(bf16x8, pw);
        const LAS unsigned char* vp = vbase + 32 * s * KROW;
#pragma unroll
        for (int dt = 0; dt < 4; ++dt) {
            const s16x4 lo = vtr(vp + dt * 32), hi = vtr(vp + dt * 32 + 16 * KROW);
            const bf16x8 vf = (bf16x8){lo[0], lo[1], lo[2], lo[3], hi[0], hi[1], hi[2], hi[3]};
            o[dt] = o[dt] * alpha;
            o[dt] = __builtin_amdgcn_mfma_f32_16x16x32_bf16(vf, pf, o[dt], 0, 0, 0);
        }
    }
    l += __shfl_xor(l, 16); l += __shfl_xor(l, 32);
    const float inv = __builtin_amdgcn_rcpf(l);
    const int tok = reint_row(g, 128 * q + qi);
    bf16* op = OG + (size_t)g * T_ * 256 + (size_t)tok * 256 + j * 64 + 4 * quad;
#pragma unroll
    for (int dt = 0; dt < 4; ++dt) { u32x2 w; w.x = pk2(o[dt][0] * inv, o[dt][1] * inv); w.y = pk2(o[dt][2] * inv, o[dt][3] * inv); *(u32x2*)(op + 16 * dt) = w; }
    if (quad == 0) LSE[(size_t)g * T_ * 4 + tok * 4 + j] = m + __builtin_amdgcn_logf(l);
    __syncthreads();
}
}
constexpr int NWAVES = 8;
constexpr size_t MiB = 1u << 20;
constexpr size_t WS_CTL = 0, CTL_ZERO_BYTES = 256 * 1024;
constexpr size_t WS_WT1 = 2 * MiB;
constexpr size_t WS_WT2 = 17 * MiB;
constexpr size_t WS_WT3 = 20 * MiB;
constexpr size_t WS_WGU = 24 * MiB;
constexpr size_t WS_WD = 152 * MiB;
constexpr size_t WS_H = 216 * MiB;
constexpr size_t WS_U = 248 * MiB;
constexpr size_t WS_CB = 280 * MiB;
constexpr size_t WS_QG = 312 * MiB, WS_KG = 336 * MiB, WS_VG = 360 * MiB;
constexpr size_t WS_SGC = 384 * MiB, WS_RAT = 416 * MiB;
constexpr size_t WS_OG = 448 * MiB;
constexpr size_t WS_LSE = 472 * MiB;
constexpr size_t WS_A2 = 474 * MiB;
constexpr size_t WS_MERGED = 514 * MiB;
constexpr size_t WS_ACT = 546 * MiB;
constexpr size_t WS_YS = 690 * MiB;
constexpr size_t WS_LISTS = 834 * MiB;
constexpr size_t WS_TOKE = 836 * MiB, WS_TOKS = WS_TOKE + 256 * 1024, WS_TOKW = WS_TOKS + 256 * 1024;
constexpr size_t WS_BIAS2 = 837 * MiB;
constexpr size_t WS_END = 838 * MiB;
constexpr int CW_TMO = 0, CW_BAR = 4096, CW_CNT = 8192;
constexpr int RING_OFF = 0, RING_BYTES = 131072;
constexpr int LDSCTL_OFF = RING_BYTES + 1024, MISC_OFF = LDSCTL_OFF + 320;
constexpr int LDS_TOK = MISC_OFF + 128;
constexpr int LDS_BYTES = 147456;

typedef GAS unsigned gu32;
#define RLX_AGENT __ATOMIC_RELAXED, __HIP_MEMORY_SCOPE_AGENT
#define LDS_WAIT() asm volatile("s_waitcnt lgkmcnt(0)" ::: "memory")
#define VM_WAIT() asm volatile("s_waitcnt vmcnt(0)" ::: "memory")

#define XB_TMO      128
#define XB_XCNT(j)  (256  + 64 * (j))
#define XB_XSUB(j)  (1280 + 64 * (j))
#define XB_XGEN(j)  (2304 + 64 * (j))
#define XB_TOP      3328
#define XB_TOPGEN   3392
#define XCD_BAR_WORDS 3456
#define XB_SPIN_CAP (1u << 18)
__device__ __forceinline__ unsigned xb_ld(unsigned* p)              { return __hip_atomic_load(p, __ATOMIC_RELAXED, __HIP_MEMORY_SCOPE_AGENT); }
__device__ __forceinline__ unsigned xb_add(unsigned* p, unsigned v) { return __hip_atomic_fetch_add(p, v, __ATOMIC_RELAXED, __HIP_MEMORY_SCOPE_AGENT); }
__device__ __forceinline__ unsigned xb_xcc_id() { return (unsigned)__builtin_amdgcn_s_getreg((3 << 11) | 20) & 0xFu; }
#define XB_SPIN(cond, bar) do { unsigned _sp = 0; while (cond) { __builtin_amdgcn_s_sleep(1); \
    if ((++_sp & 255u) == 0u) { if (xb_ld(&(bar)[XB_TMO])) break; if (_sp > XB_SPIN_CAP) { atomicAdd(&(bar)[XB_TMO], 1u); break; } } } } while (0)
struct XcdBarrier { unsigned* bar; unsigned x; volatile LAS unsigned* st; };
__device__ __forceinline__ XcdBarrier xcd_barrier_post(unsigned* bar, volatile LAS unsigned* st) {
    XcdBarrier b; b.bar = bar; b.x = xb_xcc_id(); b.st = st;
    if (threadIdx.x == 0) (void)xb_add(&bar[XB_XCNT(b.x)], 1u);
    return b;
}
__device__ __forceinline__ void xcd_barrier_complete(unsigned* bar, unsigned x, unsigned& nloc, unsigned& nx) {
    const unsigned G = gridDim.x * gridDim.y * gridDim.z;
    unsigned sum, cnt, mine, sp = 0u;
    for (;;) {
        sum = 0u; cnt = 0u; mine = 0u;
#pragma unroll
        for (unsigned j = 0; j < 16; ++j) { const unsigned c = xb_ld(&bar[XB_XCNT(j)]); sum += c; cnt += (c > 0u) ? 1u : 0u; mine = (j == x) ? c : mine; }
        if (sum == G) break;
        __builtin_amdgcn_s_sleep(1);
        if ((++sp & 255u) == 0u) { if (xb_ld(&bar[XB_TMO])) break; if (sp > XB_SPIN_CAP) { atomicAdd(&bar[XB_TMO], 1u); break; } }
    }
    nloc = mine > 0u ? mine : 1u; nx = cnt > 0u ? cnt : 1u;
}
__device__ __forceinline__ void xcd_barrier(const XcdBarrier& b) {
    asm volatile("s_waitcnt vmcnt(0)" ::: "memory");
    __syncthreads();
    if (threadIdx.x == 0) {
        unsigned* bar = b.bar;
        __builtin_amdgcn_s_waitcnt(0);
        unsigned nloc = b.st[0], nx = b.st[1];
        if (nloc == 0u) { xcd_barrier_complete(bar, b.x, nloc, nx); b.st[0] = nloc; b.st[1] = nx; }
        const unsigned old = xb_add(&bar[XB_XSUB(b.x)], 1u);
        const unsigned gen = old / nloc;
        if (old + 1u == (gen + 1u) * nloc) {
            __builtin_amdgcn_fence(__ATOMIC_RELEASE, "agent");
            asm volatile("s_waitcnt vmcnt(0)" ::: "memory");
            const unsigned og = xb_add(&bar[XB_TOP], 1u);
            const unsigned tg = og / nx;
            if (og + 1u == (tg + 1u) * nx) xb_add(&bar[XB_TOPGEN], 1u);
            else XB_SPIN(xb_ld(&bar[XB_TOPGEN]) == tg, bar);
            __builtin_amdgcn_fence(__ATOMIC_ACQUIRE, "agent");
            xb_add(&bar[XB_XGEN(b.x)], 1u);
            asm volatile("s_waitcnt vmcnt(0)" ::: "memory");
        } else {
            XB_SPIN(xb_ld(&bar[XB_XGEN(b.x)]) == gen, bar);
            __builtin_amdgcn_fence(__ATOMIC_ACQUIRE, "agent");
            asm volatile("s_waitcnt vmcnt(0)" ::: "memory");
        }
    }
    __syncthreads();
}

struct Frame {
    LAS unsigned char* lds; volatile LAS unsigned* MISC; gu32* ctl;
    int tid, lane, wave, vcu, G;
    const float *x, *n1g, *w_in, *gq, *gk, *relb, *convw, *w_bc, *w_ba, *w_out, *n2g, *w_r, *b_r, *w_gu, *b_gu, *w_d, *b_d; float* out;
    bf16 *WT1, *WT2, *WT3, *WGU, *WD, *H, *U, *CB, *QG, *KG, *VG, *SGC, *RAT, *OG, *A2, *MERGED, *ACT, *YS;
    float *LSE, *BIAS2, *TOKW; int *LISTS, *TOKE, *TOKS; int* CNT;
};
__device__ __forceinline__ float wave_sum(float v) {
#pragma unroll
    for (int o = 1; o < 64; o <<= 1) v += __shfl_xor(v, o);
    return v;
}
__device__ __forceinline__ float wave_max(float v) {
#pragma unroll
    for (int o = 1; o < 64; o <<= 1) v = fmaxf(v, __shfl_xor(v, o));
    return v;
}

__device__ __forceinline__ void p0_transpose_item(const float* W, int ldw, int k0, int nsrc0, bf16* WT, int ldt, int ndst0, int kdst0, LAS float* scr, int lane) {
#pragma unroll 8
    for (int i = 0; i < 32; ++i) { const int kk = 2 * i + (lane >> 5); scr[kk * 33 + (lane & 31)] = W[(size_t)(k0 + kk) * ldw + nsrc0 + (lane & 31)]; }
    LDS_WAIT(); asm volatile("" ::: "memory");
    const int c = lane & 7;
#pragma unroll
    for (int j = 0; j < 4; ++j) { const int n = (lane >> 3) + 8 * j; const LAS float* s = scr + (8 * c) * 33 + n;
        u32x4 o; o.x = pk2(s[0 * 33], s[1 * 33]); o.y = pk2(s[2 * 33], s[3 * 33]); o.z = pk2(s[4 * 33], s[5 * 33]); o.w = pk2(s[6 * 33], s[7 * 33]);
        *(GAS u32x4*)(WT + (size_t)(ndst0 + n) * ldt + kdst0 + 8 * c) = o; }
    LDS_WAIT(); asm volatile("" ::: "memory");
}
__device__ __forceinline__ void rms_row_to_bf16(const float* xrow, const float* g, bf16* orow, int lane) {
    const GAS f32x4* xr = (const GAS f32x4*)xrow + lane; const GAS f32x4* gr = (const GAS f32x4*)g + lane;
    f32x4 v[4]; float s2 = 0.f;
#pragma unroll
    for (int j = 0; j < 4; ++j) { v[j] = xr[64 * j]; s2 += (v[j].x * v[j].x + v[j].y * v[j].y) + (v[j].z * v[j].z + v[j].w * v[j].w); }
    const float rstd = 1.f / sqrtf(wave_sum(s2) * (1.f / D_) + EPS);
    GAS unsigned long long* o8 = (GAS unsigned long long*)orow + lane;
#pragma unroll
    for (int j = 0; j < 4; ++j) { const f32x4 gg = gr[64 * j]; o8[64 * j] = (unsigned long long)pk2(v[j].x * rstd * gg.x, v[j].y * rstd * gg.y) | ((unsigned long long)pk2(v[j].z * rstd * gg.z, v[j].w * rstd * gg.w) << 32); }
}
__device__ __forceinline__ void p0_prologue(Frame& F) {
    LAS float* scr = (LAS float*)(F.lds + RING_OFF + F.wave * 16384);
    const int gw = F.vcu * NWAVES + F.wave, NGW = F.G * NWAVES;
    constexpr int I1 = (INW / 32) * 16, I2A = 32 * 4, I2B = 32 * 16, I3 = 32 * 16, I4 = NE * 64 * 16, I5 = NE * 32 * 16;
    constexpr int NITEMS = I1 + I2A + I2B + I3 + I4 + I5;
    for (int it = gw; it < NITEMS; it += NGW) {
        int r = it;
        if (r < I1) { const int gb = r >> 4, kb = r & 15; p0_transpose_item(F.w_in, INW, 64 * kb, colmap1(32 * gb), F.WT1, 1024, 32 * gb, 64 * kb, scr, F.lane); continue; } r -= I1;
        if (r < I2A) { const int gb = r >> 2, kb = r & 3; p0_transpose_item(F.w_ba, 1024, 64 * kb, 32 * gb, F.WT2, K2, 32 * gb, 64 * kb, scr, F.lane); continue; } r -= I2A;
        if (r < I2B) { const int gb = r >> 4, kb = r & 15; p0_transpose_item(F.w_bc, 1024, 64 * kb, 32 * gb, F.WT2, K2, 32 * gb, 256 + 64 * kb, scr, F.lane); continue; } r -= I2B;
        if (r < I3) { const int gb = r >> 4, kb = r & 15; p0_transpose_item(F.w_out, 1024, 64 * kb, 32 * gb, F.WT3, 1024, 32 * gb, 64 * kb, scr, F.lane); continue; } r -= I3;
        if (r < I4) { const int e = r >> 10, gb = (r >> 4) & 63, kb = r & 15; const int nphys = 32 * gb, pn = nphys >> 8, bj = (nphys >> 7) & 1, y = nphys & 127;
            p0_transpose_item(F.w_gu + (size_t)e * 1024 * 2048, 2048, 64 * kb, (bj ? 1024 : 0) + 128 * pn + y, F.WGU + (size_t)e * 2048 * 1024, 1024, nphys, 64 * kb, scr, F.lane); continue; } r -= I4;
        { const int e = r >> 9, gb = (r >> 4) & 31, kb = r & 15;
            p0_transpose_item(F.w_d + (size_t)e * 1024 * 1024, 1024, 64 * kb, 32 * gb, F.WD + (size_t)e * 1024 * 1024, 1024, 32 * gb, 64 * kb, scr, F.lane); }
    }
    for (int m = gw; m < T_; m += NGW) rms_row_to_bf16(F.x + (size_t)m * D_, F.n1g, F.H + (size_t)m * D_, F.lane);
    if (blockIdx.x == 0) {
        for (int i = F.tid; i < 12 * 129; i += NWAVES * 64) {
            const int hh = i / 129, dl = i % 129, g = hh >> 2, dil = (g == 0) ? 1 : (g == 1 ? 4 : 16), dist = dl * dil;
            int b;
            if (dist < 16) b = dist; else { const double xx = log((double)dist / 16.0) / log(128.0) * 16.0; b = 16 + (int)xx; if (b > 31) b = 31; }
            F.BIAS2[hh * attn::BIAS_STRIDE + dl] = F.relb[b * 12 + hh] * LOG2E;
        }
    }
}

__device__ __forceinline__ void p2_attn_conv(Frame& F) {
    LAS unsigned char* lds = F.lds + RING_OFF;
    for (int i = F.tid; i < 12 * attn::BIAS_STRIDE; i += NWAVES * 64) ((LAS float*)(lds + attn::LDS_BIAS))[i] = F.BIAS2[i];
    __syncthreads();
    for (int it = F.vcu; it < 3 * 128 * 4; it += F.G) {
        const int j = it & 3, q = (it >> 2) & 127, g = it >> 9;
        attn::item(lds, g, q, j, F.QG, F.KG, F.VG, F.OG, F.LSE, F.tid, F.lane, F.wave);
    }
    const int ch = F.tid & 127;
    f32x4 w0[2], w1[2], w2[2];
#pragma unroll
    for (int h = 0; h < 2; ++h) { w0[h] = *(const f32x4*)(F.convw + 8 * ch + 4 * h); w1[h] = *(const f32x4*)(F.convw + 1024 + 8 * ch + 4 * h); w2[h] = *(const f32x4*)(F.convw + 2048 + 8 * ch + 4 * h); }
    for (int tile = F.vcu; tile < T_ / 64; tile += F.G) {
#pragma unroll 4
        for (int i = 0; i < 16; ++i) {
            const int t = tile * 64 + (F.tid >> 7) + 4 * i, s = t & 2047;
            const u32x4 z = (u32x4){0u, 0u, 0u, 0u};
            const u32x4 a0 = *(const u32x4*)(F.U + (size_t)t * 1024 + 8 * ch);
            const u32x4 a1 = (s >= 1) ? *(const u32x4*)(F.U + (size_t)(t - 1) * 1024 + 8 * ch) : z;
            const u32x4 a2 = (s >= 2) ? *(const u32x4*)(F.U + (size_t)(t - 2) * 1024 + 8 * ch) : z;
            const u32x4 cb = *(const u32x4*)(F.CB + (size_t)t * 1024 + 8 * ch);
            f32x4 r0, r1;
            r0[0] = bf_lo(cb.x) * (w2[0][0] * bf_lo(a0.x) + w1[0][0] * bf_lo(a1.x) + w0[0][0] * bf_lo(a2.x));
            r0[1] = bf_hi(cb.x) * (w2[0][1] * bf_hi(a0.x) + w1[0][1] * bf_hi(a1.x) + w0[0][1] * bf_hi(a2.x));
            r0[2] = bf_lo(cb.y) * (w2[0][2] * bf_lo(a0.y) + w1[0][2] * bf_lo(a1.y) + w0[0][2] * bf_lo(a2.y));
            r0[3] = bf_hi(cb.y) * (w2[0][3] * bf_hi(a0.y) + w1[0][3] * bf_hi(a1.y) + w0[0][3] * bf_hi(a2.y));
            r1[0] = bf_lo(cb.z) * (w2[1][0] * bf_lo(a0.z) + w1[1][0] * bf_lo(a1.z) + w0[1][0] * bf_lo(a2.z));
            r1[1] = bf_hi(cb.z) * (w2[1][1] * bf_hi(a0.z) + w1[1][1] * bf_hi(a1.z) + w0[1][1] * bf_hi(a2.z));
            r1[2] = bf_lo(cb.w) * (w2[1][2] * bf_lo(a0.w) + w1[1][2] * bf_lo(a1.w) + w0[1][2] * bf_lo(a2.w));
            r1[3] = bf_hi(cb.w) * (w2[1][3] * bf_hi(a0.w) + w1[1][3] * bf_hi(a1.w) + w0[1][3] * bf_hi(a2.w));
            *(u32x4*)(F.A2 + (size_t)t * K2 + 256 + 8 * ch) = pack8(r0, r1);
        }
    }
}
__device__ __forceinline__ void p2b_combine(Frame& F) {
    const int gt = F.vcu * NWAVES * 64 + F.tid, NT = F.G * NWAVES * 64;
    for (int idx = gt; idx < T_ * 32; idx += NT) {
        const int t = idx >> 5, c8 = idx & 31, j = c8 >> 3;
        const float l0 = F.LSE[(size_t)t * 4 + j], l1 = F.LSE[(size_t)T_ * 4 + t * 4 + j], l2 = F.LSE[(size_t)2 * T_ * 4 + t * 4 + j];
        const float mx = fmaxf(l0, fmaxf(l1, l2));
        float e0 = __builtin_amdgcn_exp2f(l0 - mx), e1 = __builtin_amdgcn_exp2f(l1 - mx), e2 = __builtin_amdgcn_exp2f(l2 - mx);
        const float inv = __builtin_amdgcn_rcpf(e0 + e1 + e2); e0 *= inv; e1 *= inv; e2 *= inv;
        const u32x4 a = *(const u32x4*)(F.OG + (size_t)t * 256 + 8 * c8), b = *(const u32x4*)(F.OG + (size_t)T_ * 256 + (size_t)t * 256 + 8 * c8), c = *(const u32x4*)(F.OG + (size_t)2 * T_ * 256 + (size_t)t * 256 + 8 * c8);
        u32x4 w;
        w.x = pk2(e0 * bf_lo(a.x) + e1 * bf_lo(b.x) + e2 * bf_lo(c.x), e0 * bf_hi(a.x) + e1 * bf_hi(b.x) + e2 * bf_hi(c.x));
        w.y = pk2(e0 * bf_lo(a.y) + e1 * bf_lo(b.y) + e2 * bf_lo(c.y), e0 * bf_hi(a.y) + e1 * bf_hi(b.y) + e2 * bf_hi(c.y));
        w.z = pk2(e0 * bf_lo(a.z) + e1 * bf_lo(b.z) + e2 * bf_lo(c.z), e0 * bf_hi(a.z) + e1 * bf_hi(b.z) + e2 * bf_hi(c.z));
        w.w = pk2(e0 * bf_lo(a.w) + e1 * bf_lo(b.w) + e2 * bf_lo(c.w), e0 * bf_hi(a.w) + e1 * bf_hi(b.w) + e2 * bf_hi(c.w));
        *(u32x4*)(F.A2 + (size_t)t * K2 + 8 * c8) = w;
    }
}
__device__ __forceinline__ void p5_router(Frame& F) {
    LAS float* wt = (LAS float*)(F.lds + RING_OFF);
    constexpr int WTS = 1028;
    LAS int* te = (LAS int*)(F.lds + LDS_TOK); LAS float* tw = (LAS float*)(F.lds + LDS_TOK + 1024); LAS int* rk = (LAS int*)(F.lds + LDS_TOK + 2048);
    LAS int* hist = (LAS int*)(F.lds + LDS_TOK + 3072); LAS int* base = hist + 32;
    for (int i = F.tid; i < 1024 * 32; i += NWAVES * 64) { const int k = i >> 5, e = i & 31; wt[e * WTS + k] = F.w_r[i]; }
    const int lane = F.lane;
    const int myexp = lane >> 1;
    const float mybias = F.b_r[myexp];
    for (int tile = F.vcu; tile < T_ / 64; tile += F.G) {
        if (F.tid < 32) hist[F.tid] = 0;
        __syncthreads();
        for (int i = 0; i < 8; ++i) {
            const int tl = F.wave * 8 + i, t = tile * 64 + tl;
            const GAS f32x4* xr = (const GAS f32x4*)(F.out + (size_t)t * D_) + lane; const GAS f32x4* gr = (const GAS f32x4*)F.n2g + lane;
            f32x4 v[4]; float s2 = 0.f;
#pragma unroll
            for (int j = 0; j < 4; ++j) { v[j] = xr[64 * j]; s2 += (v[j].x * v[j].x + v[j].y * v[j].y) + (v[j].z * v[j].z + v[j].w * v[j].w); }
            const float rstd = 1.f / sqrtf(wave_sum(s2) * (1.f / D_) + EPS);
            GAS unsigned long long* o8 = (GAS unsigned long long*)(F.H + (size_t)t * D_) + lane;
#pragma unroll
            for (int j = 0; j < 4; ++j) { const f32x4 gg = gr[64 * j]; v[j] = v[j] * rstd * gg;
                o8[64 * j] = (unsigned long long)pk2(v[j].x, v[j].y) | ((unsigned long long)pk2(v[j].z, v[j].w) << 32); }
            float lg[32];
#pragma unroll
            for (int e = 0; e < 32; ++e) {
                float a = 0.f;
#pragma unroll
                for (int j = 0; j < 4; ++j) { const f32x4 w = *(const LAS f32x4*)(wt + e * WTS + 256 * j + 4 * lane); a += (v[j].x * w.x + v[j].y * w.y) + (v[j].z * w.z + v[j].w * w.w); }
                lg[e] = a;
            }
            { const bool hi = (lane & 32) != 0;
#pragma unroll
              for (int k = 0; k < 16; ++k) { const float send = hi ? lg[k] : lg[k + 16], keep = hi ? lg[k + 16] : lg[k]; lg[k] = keep + __shfl_xor(send, 32); } }
            { const bool hi = (lane & 16) != 0;
#pragma unroll
              for (int k = 0; k < 8; ++k) { const float send = hi ? lg[k] : lg[k + 8], keep = hi ? lg[k + 8] : lg[k]; lg[k] = keep + __shfl_xor(send, 16); } }
            { const bool hi = (lane & 8) != 0;
#pragma unroll
              for (int k = 0; k < 4; ++k) { const float send = hi ? lg[k] : lg[k + 4], keep = hi ? lg[k + 4] : lg[k]; lg[k] = keep + __shfl_xor(send, 8); } }
            { const bool hi = (lane & 4) != 0;
#pragma unroll
              for (int k = 0; k < 2; ++k) { const float send = hi ? lg[k] : lg[k + 2], keep = hi ? lg[k + 2] : lg[k]; lg[k] = keep + __shfl_xor(send, 4); } }
            { const bool hi = (lane & 2) != 0; const float send = hi ? lg[0] : lg[1], keep = hi ? lg[1] : lg[0]; lg[0] = keep + __shfl_xor(send, 2); }
            float val = lg[0] + __shfl_xor(lg[0], 1) + mybias;
            float tv[4]; int ti[4];
#pragma unroll
            for (int k = 0; k < 4; ++k) {
                const float mx = wave_max(val);
                const unsigned long long bal = __ballot(val == mx);
                const int src = __ffsll((long long)bal) - 1;
                ti[k] = src >> 1; tv[k] = mx;
                if (myexp == ti[k]) val = -INFINITY;
            }
            if (lane == 0) {
                const float e1 = __expf(tv[1] - tv[0]), e2 = __expf(tv[2] - tv[0]), e3 = __expf(tv[3] - tv[0]);
                const float inv = 1.f / (1.f + e1 + e2 + e3);
                const float ww[4] = {inv, e1 * inv, e2 * inv, e3 * inv};
#pragma unroll
                for (int k = 0; k < 4; ++k) { te[tl * 4 + k] = ti[k]; tw[tl * 4 + k] = ww[k]; rk[tl * 4 + k] = atomicAdd((int*)&hist[ti[k]], 1); }
            }
        }
        __syncthreads();
        if (F.tid < 32) base[F.tid] = (int)__hip_atomic_fetch_add((unsigned*)F.CNT + F.tid, (unsigned)hist[F.tid], __ATOMIC_RELAXED, __HIP_MEMORY_SCOPE_AGENT);
        __syncthreads();
        if (F.tid < 256) {
            const int tl = F.tid >> 2, t = tile * 64 + tl, e = te[F.tid], slot = base[e] + rk[F.tid];
            F.LISTS[(size_t)e * T_ + slot] = t; F.TOKE[t * 4 + (F.tid & 3)] = e; F.TOKS[t * 4 + (F.tid & 3)] = slot; F.TOKW[t * 4 + (F.tid & 3)] = tw[F.tid];
        }
        __syncthreads();
    }
}

struct MoeTable { LAS int* cnt; LAS int* tstart; };
__device__ __forceinline__ MoeTable moe_table(Frame& F) {
    MoeTable M; M.cnt = (LAS int*)(F.lds + LDSCTL_OFF); M.tstart = M.cnt + 32;
    if (F.tid < 32) M.cnt[F.tid] = (int)__hip_atomic_load((unsigned*)F.CNT + F.tid, __ATOMIC_RELAXED, __HIP_MEMORY_SCOPE_AGENT);
    __syncthreads();
    if (F.tid == 0) { int a = 0; for (int e = 0; e < 32; ++e) { M.tstart[e] = a; a += (M.cnt[e] + 255) >> 8; } M.tstart[32] = a; }
    __syncthreads();
    return M;
}
template <int NN, bool GU>
struct MoeOrder {
    MoeTable M; const char* A; const char* Bt; const int* lists; int G, c, total;
    __device__ void init(const MoeTable& M_, const void* A_, const void* Bt_, const int* lists_, int G_, int c_) { M = M_; A = (const char*)A_; Bt = (const char*)Bt_; lists = lists_; G = G_; c = c_; total = M.tstart[32] * NN; }
    __device__ bool next(int i, pg8::Unit& u) const {
        const int L = i * G + c; if (L >= total) return false;
        const int mt = L / NN, pn = L % NN;
        int e = 0; while (M.tstart[e + 1] <= mt) ++e;
        u.pm = mt; u.pn = pn; u.e = e; u.rows = (mt - M.tstart[e]) * 256;
        u.b = Bt + ((size_t)e * (NN * 256) + (size_t)pn * 256) * 1024 * 2;
        u.a = GU ? A : A + (size_t)mt * 256 * 1024 * 2;
        return true;
    }
    __device__ __forceinline__ unsigned row_off(const pg8::Unit& u, int r) const {
        int lr = u.rows + r; const int ce = M.cnt[u.e]; if (lr >= ce) lr = 0;
        return (unsigned)lists[(size_t)u.e * T_ + lr] * 2048u;
    }
};

__device__ __forceinline__ void p8_final(Frame& F, const MoeTable& M) {
    const int gw = F.vcu * NWAVES + F.wave, NGW = F.G * NWAVES, lane = F.lane;
    for (int t = gw; t < T_; t += NGW) {
        int e4 = 0, s4 = 0; float w4 = 0.f;
        if (lane < 4) { e4 = F.TOKE[t * 4 + lane]; s4 = F.TOKS[t * 4 + lane]; w4 = F.TOKW[t * 4 + lane]; }
        f32x4 a[4];
        GAS f32x4* op = (GAS f32x4*)(F.out + (size_t)t * D_) + 2 * lane;
#pragma unroll
        for (int h = 0; h < 2; ++h) { a[2 * h] = op[128 * h]; a[2 * h + 1] = op[128 * h + 1]; }
#pragma unroll
        for (int k = 0; k < 4; ++k) {
            const int e = __shfl(e4, k), sl = __shfl(s4, k); const float w = __shfl(w4, k);
            const bf16* yr = F.YS + ((size_t)M.tstart[e] * 256 + sl) * 1024 + 8 * lane;
#pragma unroll
            for (int h = 0; h < 2; ++h) { const u32x4 y = *(const u32x4*)(yr + 512 * h);
                a[2 * h] += w * (f32x4){bf_lo(y.x), bf_hi(y.x), bf_lo(y.y), bf_hi(y.y)}; a[2 * h + 1] += w * (f32x4){bf_lo(y.z), bf_hi(y.z), bf_lo(y.w), bf_hi(y.w)}; }
        }
#pragma unroll
        for (int h = 0; h < 2; ++h) { op[128 * h] = a[2 * h]; op[128 * h + 1] = a[2 * h + 1]; }
    }
}
struct Args { const float* in[17]; float* out; unsigned char* ws; int ph_lo, ph_hi; };
constexpr int N_PHASES = 10;
__global__ void __launch_bounds__(NWAVES * 64, 2) mk_fwd(Args args) {
    extern __shared__ __attribute__((aligned(16))) unsigned char lds[];
    Frame F;
    F.lds = (LAS unsigned char*)lds;
    F.MISC = (volatile LAS unsigned*)(F.lds + MISC_OFF);
    F.tid = threadIdx.x; F.lane = F.tid & 63; F.wave = __builtin_amdgcn_readfirstlane(F.tid >> 6);
    F.G = gridDim.x; { const int bx = blockIdx.x; F.vcu = (F.G % 8 == 0) ? (bx % 8) * (F.G / 8) + bx / 8 : bx; }
    unsigned char* ws = args.ws;
    F.ctl = (gu32*)(ws + WS_CTL);
    F.x = args.in[0]; F.n1g = args.in[1]; F.w_in = args.in[2]; F.gq = args.in[3]; F.gk = args.in[4]; F.relb = args.in[5]; F.convw = args.in[6]; F.w_bc = args.in[7]; F.w_ba = args.in[8];
    F.w_out = args.in[9]; F.n2g = args.in[10]; F.w_r = args.in[11]; F.b_r = args.in[12]; F.w_gu = args.in[13]; F.b_gu = args.in[14]; F.w_d = args.in[15]; F.b_d = args.in[16]; F.out = args.out;
    F.WT1 = (bf16*)(ws + WS_WT1); F.WT2 = (bf16*)(ws + WS_WT2); F.WT3 = (bf16*)(ws + WS_WT3); F.WGU = (bf16*)(ws + WS_WGU); F.WD = (bf16*)(ws + WS_WD);
    F.H = (bf16*)(ws + WS_H); F.U = (bf16*)(ws + WS_U); F.CB = (bf16*)(ws + WS_CB); F.QG = (bf16*)(ws + WS_QG); F.KG = (bf16*)(ws + WS_KG); F.VG = (bf16*)(ws + WS_VG);
    F.SGC = (bf16*)(ws + WS_SGC); F.RAT = (bf16*)(ws + WS_RAT); F.OG = (bf16*)(ws + WS_OG); F.A2 = (bf16*)(ws + WS_A2); F.MERGED = (bf16*)(ws + WS_MERGED);
    F.ACT = (bf16*)(ws + WS_ACT); F.YS = (bf16*)(ws + WS_YS); F.LSE = (float*)(ws + WS_LSE); F.BIAS2 = (float*)(ws + WS_BIAS2); F.TOKW = (float*)(ws + WS_TOKW);
    F.LISTS = (int*)(ws + WS_LISTS); F.TOKE = (int*)(ws + WS_TOKE); F.TOKS = (int*)(ws + WS_TOKS); F.CNT = (int*)(ws + WS_CTL) + CW_CNT;
    for (int u = F.tid; u < (LDS_BYTES - LDSCTL_OFF) / 4; u += NWAVES * 64) ((LAS unsigned*)(F.lds + LDSCTL_OFF))[u] = 0u;
    __syncthreads();
    const int lo = args.ph_lo, hi = args.ph_hi;
    const bool multi = (hi - lo) > 1;
    XcdBarrier bar; bar.bar = (unsigned*)(F.ctl + CW_BAR); bar.x = 0; bar.st = nullptr;
    if (multi) bar = xcd_barrier_post((unsigned*)(F.ctl + CW_BAR), F.MISC + 8);
#ifndef PH_MASK
#define PH_MASK 0x3ff
#endif
#define IN(k) (((PH_MASK >> (k)) & 1) && lo <= (k) && (k) < hi)
#define SEAM(k) do { if (IN(k) && IN((k) + 1)) xcd_barrier(bar); } while (0)
    if (IN(0)) { p0_prologue(F); } SEAM(0);
    if (IN(1)) {
        pg8::DenseOrder S; S.init(F.H, F.WT1, T_, INW, 1024, F.G, (int)blockIdx.x);
        Epi1 E{F.U, F.CB, F.QG, F.KG, F.VG, F.SGC, F.RAT, F.gq, F.gk};
        pg8::gemm_phase<Epi1, pg8::DenseOrder, true, false>(F.lds + RING_OFF, 1024, S, E);
    } SEAM(1);
    if (IN(2)) { p2_attn_conv(F); } SEAM(2);
    if (IN(3)) { p2b_combine(F); } SEAM(3);
    if (IN(4)) {
        pg8::DenseOrder S; S.init(F.A2, F.WT2, T_, 1024, K2, F.G, (int)blockIdx.x);
        Epi2 E{F.SGC, F.RAT, F.MERGED};
        pg8::gemm_phase<Epi2, pg8::DenseOrder, true, false>(F.lds + RING_OFF, K2, S, E);
    } SEAM(4);
    if (IN(5)) {
        pg8::DenseOrder S; S.init(F.MERGED, F.WT3, T_, 1024, 1024, F.G, (int)blockIdx.x);
        Epi3 E{F.x, F.out};
        pg8::gemm_phase<Epi3, pg8::DenseOrder, true, false>(F.lds + RING_OFF, 1024, S, E);
    } SEAM(5);
    if (IN(6)) { p5_router(F); } SEAM(6);
    if (IN(7)) {
        const MoeTable M = moe_table(F);
        MoeOrder<8, true> S; S.init(M, F.H, F.WGU, F.LISTS, F.G, (int)blockIdx.x);
        EpiGU E{F.ACT, F.b_gu};
        pg8::gemm_phase<EpiGU, MoeOrder<8, true>, true, true>(F.lds + RING_OFF, 1024, S, E);
    } SEAM(7);
    if (IN(8)) {
        const MoeTable M = moe_table(F);
        MoeOrder<4, false> S; S.init(M, F.ACT, F.WD, F.LISTS, F.G, (int)blockIdx.x);
        EpiDN E{F.YS, F.b_d};
        pg8::gemm_phase<EpiDN, MoeOrder<4, false>, true, false>(F.lds + RING_OFF, 1024, S, E);
    } SEAM(8);
    if (IN(9)) { const MoeTable M = moe_table(F); p8_final(F, M); }
#undef IN
#undef SEAM
}

static int mk_grid = 0;
static int mk_setup() {
    if (mk_grid != 0) return mk_grid;
    int dev = 0, cus = 0, per_cu = 0;
    if (hipGetDevice(&dev) != hipSuccess || hipDeviceGetAttribute(&cus, hipDeviceAttributeMultiprocessorCount, dev) != hipSuccess) { mk_grid = -1; return mk_grid; }
    if (hipFuncSetAttribute((const void*)mk_fwd, hipFuncAttributeMaxDynamicSharedMemorySize, LDS_BYTES) != hipSuccess) { fprintf(stderr, "hipFuncSetAttribute failed\n"); mk_grid = -1; return mk_grid; }
    if (hipOccupancyMaxActiveBlocksPerMultiprocessor(&per_cu, (const void*)mk_fwd, NWAVES * 64, LDS_BYTES) != hipSuccess || per_cu < 1) { fprintf(stderr, "occupancy query: %d blocks/CU\n", per_cu); (void)hipGetLastError(); mk_grid = -1; return mk_grid; }
    mk_grid = cus;
    return mk_grid;
}
static void mk_launch(void* const* d_in, void* d_out, void* d_ws, hipStream_t stream, int lo, int hi) {
    const int grid = mk_setup(); if (grid <= 0) return;
    Args a{};
    for (int i = 0; i < 17; ++i) a.in[i] = (const float*)d_in[i];
    a.out = (float*)d_out; a.ws = (unsigned char*)d_ws; a.ph_lo = lo; a.ph_hi = hi;
    hipLaunchKernelGGL(mk_fwd, dim3(grid), dim3(NWAVES * 64), LDS_BYTES, stream, a);
}
extern "C" void kernel_launch(void* const* d_in, const int* in_sizes, int n_in, void* d_out, int out_size, void* d_ws, size_t ws_size, hipStream_t stream) {
    (void)hipMemsetAsync((char*)d_ws + WS_CTL, 0, CTL_ZERO_BYTES, stream);
    mk_launch(d_in, d_out, d_ws, stream, 0, N_PHASES);
}
```

```cpp
#include <hip/hip_runtime.h>
#include <stdint.h>
#include <cstdio>

constexpr int B_ = 8, S_ = 2048, D_ = 1024, T_ = B_ * S_;
constexpr int INW = 7424, NE = 32;
constexpr int OFF_CB = 0, OFF_CC = 1024, OFF_CX = 2048, OFF_Q = 3072, OFF_K = 3840, OFF_V = 4608, OFF_GC = 5376, OFF_GA = 6400;
constexpr float EPS = 1e-6f;
constexpr float LOG2E = 1.4426950408889634f, LN2 = 0.6931471805599453f;
constexpr float QSCALE = 0.125f * LOG2E;
constexpr int K2 = 1280;
constexpr int PMAX = 65536 + 32 * 256;

#define GAS __attribute__((address_space(1)))
#define LAS __attribute__((address_space(3)))
typedef unsigned short bf16;
typedef short bf16x8 __attribute__((ext_vector_type(8)));
typedef short s16x4 __attribute__((ext_vector_type(4)));
typedef float f32x4 __attribute__((ext_vector_type(4)));
typedef float f32x2 __attribute__((ext_vector_type(2)));
typedef unsigned u32x4 __attribute__((ext_vector_type(4)));
typedef unsigned u32x2 __attribute__((ext_vector_type(2)));
typedef __bf16 bf16x2_t __attribute__((ext_vector_type(2)));

__device__ __forceinline__ unsigned pk2(float lo, float hi) { f32x2 v = {lo, hi}; bf16x2_t b = __builtin_convertvector(v, bf16x2_t); return __builtin_bit_cast(unsigned, b); }
__device__ __forceinline__ float bf_lo(unsigned u) { return __uint_as_float(u << 16); }
__device__ __forceinline__ float bf_hi(unsigned u) { return __uint_as_float(u & 0xffff0000u); }
__device__ __forceinline__ float sigmoidf_(float x) { return __builtin_amdgcn_rcpf(1.f + __builtin_amdgcn_exp2f(-LOG2E * x)); }

namespace pg8 {
constexpr int BM = 256, BK = 64, HALF = 128, HTB = HALF * BK * 2, STAGE_BYTES = 8 * HTB, NXCD = 8, WGM = 8;
__host__ __device__ __forceinline__ int lds_byte(int r, int c) { const int st = (r >> 4) * 2 + (c >> 5), rr = r & 15, cc = c & 31, ob = rr * 64 + cc * 2; return st * 1024 + (ob ^ (((ob >> 9) & 1) << 5)); }
__host__ __device__ __forceinline__ void stage_rc(int b, int& R, int& C) { const int st = b / 1024, sb = b % 1024, swz = sb ^ (((sb >> 9) & 1) << 5); R = (st >> 1) * 16 + swz / 64; C = (st & 1) * 32 + (swz % 64) / 2; }
__host__ __device__ __forceinline__ int perm32(int rho) { const int n = rho >> 4, i = rho & 15; return 8 * (i >> 2) + 4 * n + (i & 3); }

struct Unit { const char* a; const char* b; int pm, pn, e, rows; };

struct DenseOrder {
    const char* A; const char* Bt; int K, nM, nN, nwg, G, c;
    __device__ void init(const void* A_, const void* Bt_, int M, int N, int K_, int G_, int c_) { A = (const char*)A_; Bt = (const char*)Bt_; K = K_; nM = M / BM; nN = N / BM; nwg = nM * nN; G = G_; c = c_; }
    __device__ bool next(int i, Unit& u) const {
        const long L = (long)i * G + c; if (L >= nwg) return false;
        int wgid = (int)L; { const int q = nwg / NXCD, r = nwg % NXCD, xcd = wgid % NXCD, off = wgid / NXCD; wgid = (xcd < r ? xcd * (q + 1) : r * (q + 1) + (xcd - r) * q) + off; }
        const int nig = WGM * nN, gid = wgid / nig, fm = gid * WGM, gsz = (nM - fm) < WGM ? (nM - fm) : WGM;
        u.pm = fm + ((wgid % nig) % gsz); u.pn = (wgid % nig) / gsz; u.e = 0; u.rows = 256;
        u.a = A + (size_t)u.pm * BM * K * 2; u.b = Bt + (size_t)u.pn * BM * K * 2; return true;
    }
    __device__ __forceinline__ unsigned row_off(const Unit&, int) const { return 0u; }
};

template <class Epi, class Sched, bool ALIGN_EPI, bool GATHER>
__device__ __forceinline__ void gemm_phase(LAS unsigned char* lds, const int K, const Sched& S, const Epi& E) {
    const int tid = threadIdx.x, wid = __builtin_amdgcn_readfirstlane(tid >> 6), lane = tid & 63, wr = wid >> 2, wc = wid & 3, fr = lane & 15, fq = lane >> 4;
    const int nt = K / BK;
    unsigned voffA[2], voffB[2]; int RA[2]; unsigned CA2[2];
#pragma unroll
    for (int i = 0; i < 2; ++i) { int R, C; stage_rc(tid * 16 + i * 8192, R, C); const int Rb = (R & ~31) + perm32(R & 31);
        voffA[i] = (unsigned)(R * K + C) * 2u; voffB[i] = (unsigned)(Rb * K + C) * 2u; RA[i] = R; CA2[i] = (unsigned)C * 2u; }
    const size_t kstep = (size_t)(BK * 2);
    const size_t hstep = (size_t)HALF * K * 2;
    const unsigned ldsw = (unsigned)wid * 1024u;
    const int aoff = lds_byte(wr * 64 + fr, fq * 8), boff = lds_byte(wc * 32 + fr, fq * 8);
#define PG8_SA(b, h) (((b) * 2 + (h)) * HTB)
#define PG8_SB(b, h) ((4 + (b) * 2 + (h)) * HTB)
#define PG8_STAGE2(bufoff, gbase, o0, o1) do { \
        __builtin_amdgcn_global_load_lds((const unsigned*)((const char*)(gbase) + (o0)), (LAS unsigned*)(lds + (bufoff) + ldsw), 16, 0, 0); \
        __builtin_amdgcn_global_load_lds((const unsigned*)((const char*)(gbase) + (o1)), (LAS unsigned*)(lds + (bufoff) + ldsw + 8192), 16, 0, 0); } while (0)
#define PG8_STB(bufoff, gbase) PG8_STAGE2(bufoff, gbase, voffB[0], voffB[1])
#define PG8_STA(bufoff, gbase, h, nx) do { if constexpr (GATHER) { const unsigned o0_ = (nx) ? gn[h][0] : gc[h][0], o1_ = (nx) ? gn[h][1] : gc[h][1]; PG8_STAGE2(bufoff, gbase, o0_, o1_); } \
        else { PG8_STAGE2(bufoff, (gbase) + (h) * hstep, voffA[0], voffA[1]); } } while (0)
#define PG8_LDA(dst, b, h) do { _Pragma("unroll") for (int m = 0; m < 4; ++m) _Pragma("unroll") for (int k = 0; k < 2; ++k) dst[m][k] = *(const LAS bf16x8*)(lds + PG8_SA(b, h) + aoff + m * 2048 + k * 1024); } while (0)
#define PG8_LDB(dst, b, h) do { _Pragma("unroll") for (int n = 0; n < 2; ++n) _Pragma("unroll") for (int k = 0; k < 2; ++k) dst[n][k] = *(const LAS bf16x8*)(lds + PG8_SB(b, h) + boff + n * 2048 + k * 1024); } while (0)
#define PG8_MMA(ai, bj, At, Bt) do { __builtin_amdgcn_s_setprio(1); _Pragma("unroll") for (int m = 0; m < 4; ++m) _Pragma("unroll") for (int n = 0; n < 2; ++n) _Pragma("unroll") for (int k = 0; k < 2; ++k) \
        acc[ai][bj][m][n] = __builtin_amdgcn_mfma_f32_16x16x32_bf16(Bt[n][k], At[m][k], acc[ai][bj][m][n], 0, 0, 0); __builtin_amdgcn_s_setprio(0); } while (0)
#define PG8_WAIT_V(n) asm volatile("s_waitcnt vmcnt(" #n ")" ::: "memory")
#define PG8_WAIT_L(n) asm volatile("s_waitcnt lgkmcnt(" #n ")" ::: "memory")
#define PG8_BAR __builtin_amdgcn_s_barrier()
#define PG8_SCHED __builtin_amdgcn_sched_barrier(0)
#define PG8_KBODY do { \
            const bool last = (t == nt - 2); \
            const char* a1 = cA + (size_t)(t + 1) * kstep; \
            const char* a2 = last ? nA : cA + (size_t)(t + 2) * kstep; const char* b2 = last ? nB : cB + (size_t)(t + 2) * kstep; \
            const char* a3 = a2 + kstep; const char* b3 = b2 + kstep; \
            PG8_LDB(B0, 0, 0); PG8_LDB(B1, 0, 1); PG8_SCHED; PG8_LDA(At, 0, 0); PG8_STA(PG8_SA(1, 1), a1, 1, false); \
            PG8_WAIT_V(8); PG8_WAIT_L(0); PG8_BAR; PG8_MMA(0, 0, At, B0); PG8_MMA(0, 1, At, B1); PG8_BAR; PG8_SCHED; \
            PG8_LDA(At, 0, 1); PG8_STB(PG8_SB(0, 0), b2); PG8_STB(PG8_SB(0, 1), b2 + hstep); PG8_STA(PG8_SA(0, 0), a2, 0, last); \
            PG8_WAIT_V(8); PG8_WAIT_L(0); PG8_BAR; PG8_MMA(1, 0, At, B0); PG8_MMA(1, 1, At, B1); PG8_BAR; PG8_SCHED; \
            PG8_LDB(B0, 1, 0); PG8_LDB(B1, 1, 1); PG8_SCHED; PG8_LDA(At, 1, 0); PG8_STA(PG8_SA(0, 1), a2, 1, last); \
            PG8_WAIT_V(8); PG8_WAIT_L(0); PG8_BAR; PG8_MMA(0, 0, At, B0); PG8_MMA(0, 1, At, B1); PG8_BAR; PG8_SCHED; \
            PG8_LDA(At, 1, 1); PG8_STB(PG8_SB(1, 0), b3); PG8_STB(PG8_SB(1, 1), b3 + hstep); PG8_STA(PG8_SA(1, 0), a3, 0, last); \
            PG8_WAIT_V(8); PG8_WAIT_L(0); PG8_BAR; PG8_MMA(1, 0, At, B0); PG8_MMA(1, 1, At, B1); PG8_BAR; PG8_SCHED; \
        } while (0)
    Unit cur, nxt; int ui = 0;
    if (!S.next(0, cur)) return;
    f32x4 acc[2][2][4][2];
#pragma unroll
    for (int a = 0; a < 2; ++a)
#pragma unroll
        for (int b = 0; b < 2; ++b)
#pragma unroll
            for (int m = 0; m < 4; ++m)
#pragma unroll
                for (int n = 0; n < 2; ++n) acc[a][b][m][n] = (f32x4){0.f, 0.f, 0.f, 0.f};
    bf16x8 At[4][2], B0[2][2], B1[2][2];
    unsigned gc[2][2], gn[2][2];
    if constexpr (GATHER) {
#pragma unroll
        for (int h = 0; h < 2; ++h)
#pragma unroll
            for (int i = 0; i < 2; ++i) { gc[h][i] = S.row_off(cur, h * HALF + RA[i]) + CA2[i]; gn[h][i] = gc[h][i]; }
    }
    const char* cA = cur.a; const char* cB = cur.b;
    PG8_STB(PG8_SB(0, 0), cB); PG8_STB(PG8_SB(0, 1), cB + hstep); PG8_STA(PG8_SA(0, 0), cA, 0, false); PG8_STA(PG8_SA(0, 1), cA, 1, false);
    if (wr == 1) PG8_BAR;
    PG8_WAIT_V(2); PG8_BAR;
    PG8_STB(PG8_SB(1, 0), cB + kstep); PG8_STA(PG8_SA(1, 0), cA + kstep, 0, false); PG8_STB(PG8_SB(1, 1), cB + hstep + kstep);
    PG8_WAIT_V(6); PG8_BAR;
    for (;;) {
        const bool has_next = S.next(ui + 1, nxt);
        if constexpr (GATHER) {
            if (has_next) {
#pragma unroll
                for (int h = 0; h < 2; ++h)
#pragma unroll
                    for (int i = 0; i < 2; ++i) gn[h][i] = S.row_off(nxt, h * HALF + RA[i]) + CA2[i];
            }
        }
        const char* nA = has_next ? nxt.a : cA; const char* nB = has_next ? nxt.b : cB;
        if constexpr (Epi::MID_T > 0) {
            for (int t = 0; t < Epi::MID_T; t += 2) PG8_KBODY;
            E.mid(acc, cur, wr, wc, fr, fq);
            for (int t = Epi::MID_T; t < nt; t += 2) PG8_KBODY;
        } else {
            for (int t = 0; t < nt; t += 2) PG8_KBODY;
        }
        if constexpr (ALIGN_EPI) { if (wr == 0) PG8_BAR; }
        E(acc, cur, wr, wc, fr, fq);
        if (!has_next) break;
#pragma unroll
        for (int a = 0; a < 2; ++a)
#pragma unroll
            for (int b = 0; b < 2; ++b)
#pragma unroll
                for (int m = 0; m < 4; ++m)
#pragma unroll
                    for (int n = 0; n < 2; ++n) acc[a][b][m][n] = (f32x4){0.f, 0.f, 0.f, 0.f};
        cur = nxt; cA = nA; cB = nB; ++ui;
        if constexpr (GATHER) {
#pragma unroll
            for (int h = 0; h < 2; ++h)
#pragma unroll
                for (int i = 0; i < 2; ++i) gc[h][i] = gn[h][i];
        }
        if constexpr (ALIGN_EPI) { if (wr == 1) PG8_BAR; }
    }
    PG8_WAIT_V(0);
    if constexpr (!ALIGN_EPI) { if (wr == 0) PG8_BAR; }
    PG8_BAR;
#undef PG8_KBODY
#undef PG8_SA
#undef PG8_SB
#undef PG8_STAGE2
#undef PG8_STB
#undef PG8_STA
#undef PG8_LDA
#undef PG8_LDB
#undef PG8_MMA
#undef PG8_WAIT_V
#undef PG8_WAIT_L
#undef PG8_BAR
#undef PG8_SCHED
}
}
__device__ __forceinline__ int deint_row(int g, int t) {
    const int b = t & ~2047, s = t & 2047;
    if (g == 0) return t;
    if (g == 1) return b + (s & 3) * 512 + (s >> 2);
    return b + (s & 15) * 128 + (s >> 4);
}
__device__ __forceinline__ int reint_row(int g, int R) {
    const int b = R & ~2047, s = R & 2047;
    if (g == 0) return R;
    if (g == 1) return b + (s & 511) * 4 + (s >> 9);
    return b + (s & 127) * 16 + (s >> 7);
}
__device__ __forceinline__ u32x4 pack8(const f32x4 a, const f32x4 b) { u32x4 w; w.x = pk2(a[0], a[1]); w.y = pk2(a[2], a[3]); w.z = pk2(b[0], b[1]); w.w = pk2(b[2], b[3]); return w; }

__host__ __device__ __forceinline__ int colmap1(int nphys) {
    const int pn = nphys >> 8, x = nphys & 255, bj = x >> 7, y = x & 127;
    if (pn < 8) return (bj ? OFF_CX : OFF_CC) + 128 * pn + y;
    if (pn < 12) return OFF_CB + 256 * (pn - 8) + x;
    if (pn < 18) { const int isk = pn >= 15, g = (pn - 12) % 3, wc = y >> 5, xx = y & 31; return (isk ? OFF_K : OFF_Q) + 256 * g + 64 * wc + 32 * bj + xx; }
    if (pn < 21) return OFF_V + 256 * (pn - 18) + x;
    return (bj ? OFF_GA : OFF_GC) + 128 * (pn - 21) + y;
}
struct Epi1 {
    static constexpr int MID_T = 0;
    bf16* U; bf16* CB; bf16* QG; bf16* KG; bf16* VG; bf16* SGC; bf16* RAT; const float* gq; const float* gk;
    __device__ __forceinline__ void mid(f32x4 (&)[2][2][4][2], const pg8::Unit&, int, int, int, int) const {}
    __device__ __forceinline__ void operator()(const f32x4 (&acc)[2][2][4][2], const pg8::Unit& u, int wr, int wc, int fr, int fq) const {
        const int pn = u.pn, row0 = u.pm * 256 + wr * 64 + fr;
        if (pn < 8) {
            const int col = 128 * pn + 32 * wc + 8 * fq;
#pragma unroll
            for (int ai = 0; ai < 2; ++ai)
#pragma unroll
                for (int m = 0; m < 4; ++m) { const int row = row0 + ai * 128 + m * 16;
                    *(u32x4*)(U + (size_t)row * 1024 + col) = pack8(acc[ai][0][m][0] * acc[ai][1][m][0], acc[ai][0][m][1] * acc[ai][1][m][1]); }
        } else if (pn < 12) {
            const int col = 256 * (pn - 8) + 32 * wc + 8 * fq;
#pragma unroll
            for (int ai = 0; ai < 2; ++ai)
#pragma unroll
                for (int m = 0; m < 4; ++m) { const int row = row0 + ai * 128 + m * 16;
#pragma unroll
                    for (int bj = 0; bj < 2; ++bj) *(u32x4*)(CB + (size_t)row * 1024 + col + 128 * bj) = pack8(acc[ai][bj][m][0], acc[ai][bj][m][1]); }
        } else if (pn < 18) {
            const bool isk = pn >= 15; const int g = (pn - 12) % 3;
            const float* gg = isk ? gk : gq; bf16* dst = (isk ? KG : QG) + (size_t)g * T_ * 256;
            f32x4 gv[2][2];
#pragma unroll
            for (int bj = 0; bj < 2; ++bj)
#pragma unroll
                for (int n = 0; n < 2; ++n) gv[bj][n] = *(const f32x4*)(gg + 32 * bj + 8 * fq + 4 * n);
            const float sc = isk ? 1.f : QSCALE;
#pragma unroll
            for (int ai = 0; ai < 2; ++ai)
#pragma unroll
                for (int m = 0; m < 4; ++m) {
                    float ss = 0.f;
#pragma unroll
                    for (int bj = 0; bj < 2; ++bj)
#pragma unroll
                        for (int n = 0; n < 2; ++n) { const f32x4 x = acc[ai][bj][m][n]; ss += (x[0] * x[0] + x[1] * x[1]) + (x[2] * x[2] + x[3] * x[3]); }
                    ss += __shfl_xor(ss, 16); ss += __shfl_xor(ss, 32);
                    const float rs = __builtin_amdgcn_rsqf(ss * (1.f / 64.f) + EPS) * sc;
                    const int drow = deint_row(g, row0 + ai * 128 + m * 16);
                    bf16* p = dst + ((size_t)drow * 4 + wc) * 64 + 8 * fq;
#pragma unroll
                    for (int bj = 0; bj < 2; ++bj) *(u32x4*)(p + 32 * bj) = pack8(acc[ai][bj][m][0] * gv[bj][0] * rs, acc[ai][bj][m][1] * gv[bj][1] * rs);
                }
        } else if (pn < 21) {
            const int g = pn - 18; bf16* dst = VG + (size_t)g * T_ * 256;
#pragma unroll
            for (int ai = 0; ai < 2; ++ai)
#pragma unroll
                for (int m = 0; m < 4; ++m) { const int drow = deint_row(g, row0 + ai * 128 + m * 16);
#pragma unroll
                    for (int bj = 0; bj < 2; ++bj) *(u32x4*)(dst + (size_t)drow * 256 + 128 * bj + 32 * wc + 8 * fq) = pack8(acc[ai][bj][m][0], acc[ai][bj][m][1]); }
        } else {
            const int col = 128 * (pn - 21) + 32 * wc + 8 * fq;
#pragma unroll
            for (int ai = 0; ai < 2; ++ai)
#pragma unroll
                for (int m = 0; m < 4; ++m) { const int row = row0 + ai * 128 + m * 16;
                    f32x4 sc[2], rt[2];
#pragma unroll
                    for (int n = 0; n < 2; ++n)
#pragma unroll
                        for (int i = 0; i < 4; ++i) { const float s0 = sigmoidf_(acc[ai][0][m][n][i]), s1 = sigmoidf_(acc[ai][1][m][n][i]); sc[n][i] = s0; rt[n][i] = s1 * __builtin_amdgcn_rcpf(s0); }
                    *(u32x4*)(SGC + (size_t)row * 1024 + col) = pack8(sc[0], sc[1]);
                    *(u32x4*)(RAT + (size_t)row * 1024 + col) = pack8(rt[0], rt[1]); }
        }
    }
};

struct Epi2 {
    static constexpr int MID_T = 4;
    const bf16* SGC; const bf16* RAT; bf16* MERGED;
    __device__ __forceinline__ void mid(f32x4 (&acc)[2][2][4][2], const pg8::Unit& u, int wr, int wc, int fr, int fq) const {
        const int row0 = u.pm * 256 + wr * 64 + fr, col0 = u.pn * 256 + 32 * wc + 8 * fq;
#pragma unroll
        for (int ai = 0; ai < 2; ++ai)
#pragma unroll
            for (int m = 0; m < 4; ++m) {
#pragma unroll
                for (int bj = 0; bj < 2; ++bj) { const u32x4 r = *(const u32x4*)(RAT + (size_t)(row0 + ai * 128 + m * 16) * 1024 + col0 + 128 * bj);
                    acc[ai][bj][m][0] *= (f32x4){bf_lo(r.x), bf_hi(r.x), bf_lo(r.y), bf_hi(r.y)}; acc[ai][bj][m][1] *= (f32x4){bf_lo(r.z), bf_hi(r.z), bf_lo(r.w), bf_hi(r.w)}; }
                asm volatile("" : "+v"(acc[ai][0][m][0]), "+v"(acc[ai][0][m][1]), "+v"(acc[ai][1][m][0]), "+v"(acc[ai][1][m][1]));
                if (m & 1) asm volatile("" ::: "memory"); }
    }
    __device__ __forceinline__ void operator()(const f32x4 (&acc)[2][2][4][2], const pg8::Unit& u, int wr, int wc, int fr, int fq) const {
        const int row0 = u.pm * 256 + wr * 64 + fr, col0 = u.pn * 256 + 32 * wc + 8 * fq;
#pragma unroll
        for (int ai = 0; ai < 2; ++ai)
#pragma unroll
            for (int m = 0; m < 4; ++m)
#pragma unroll
                for (int bj = 0; bj < 2; ++bj) { const size_t off = (size_t)(row0 + ai * 128 + m * 16) * 1024 + col0 + 128 * bj; const u32x4 r = *(const u32x4*)(SGC + off);
                    *(u32x4*)(MERGED + off) = pack8(acc[ai][bj][m][0] * (f32x4){bf_lo(r.x), bf_hi(r.x), bf_lo(r.y), bf_hi(r.y)}, acc[ai][bj][m][1] * (f32x4){bf_lo(r.z), bf_hi(r.z), bf_lo(r.w), bf_hi(r.w)}); }
    }
};

struct Epi3 {
    static constexpr int MID_T = 0;
    const float* X; float* OUT; const float* g2; bf16* XG;
    __device__ __forceinline__ void mid(f32x4 (&)[2][2][4][2], const pg8::Unit&, int, int, int, int) const {}
    __device__ __forceinline__ void operator()(const f32x4 (&acc)[2][2][4][2], const pg8::Unit& u, int wr, int wc, int fr, int fq) const {
        const int row0 = u.pm * 256 + wr * 64 + fr, col0 = u.pn * 256 + 32 * wc + 8 * fq;
        f32x4 gv[2][2];
#pragma unroll
        for (int bj = 0; bj < 2; ++bj)
#pragma unroll
            for (int n = 0; n < 2; ++n) gv[bj][n] = *(const f32x4*)(g2 + col0 + 128 * bj + 4 * n);
#pragma unroll
        for (int ai = 0; ai < 2; ++ai)
#pragma unroll
            for (int m = 0; m < 4; ++m)
#pragma unroll
                for (int bj = 0; bj < 2; ++bj) { const size_t off = (size_t)(row0 + ai * 128 + m * 16) * 1024 + col0 + 128 * bj;
                    const f32x4 x0 = *(const f32x4*)(X + off) + acc[ai][bj][m][0], x1 = *(const f32x4*)(X + off + 4) + acc[ai][bj][m][1];
                    *(f32x4*)(OUT + off) = x0; *(f32x4*)(OUT + off + 4) = x1;
                    *(u32x4*)(XG + off) = pack8(x0 * gv[bj][0], x1 * gv[bj][1]); }
    }
};

struct EpiGU {
    static constexpr int MID_T = 0;
    bf16* ACT; const float* bgu; const float* RS; const LAS int* cnt;
    __device__ __forceinline__ void mid(f32x4 (&)[2][2][4][2], const pg8::Unit&, int, int, int, int) const {}
    __device__ __forceinline__ void operator()(const f32x4 (&acc)[2][2][4][2], const pg8::Unit& u, int wr, int wc, int fr, int fq) const {
        const int row0 = u.pm * 256 + wr * 64 + fr, col = 128 * u.pn + 32 * wc + 8 * fq;
        const float* bg = bgu + (size_t)u.e * 2048 + col;
        f32x4 bgate[2], bup[2];
#pragma unroll
        for (int n = 0; n < 2; ++n) { bgate[n] = *(const f32x4*)(bg + 4 * n); bup[n] = *(const f32x4*)(bg + 1024 + 4 * n); }
        const int ce = cnt[u.e];
#pragma unroll
        for (int ai = 0; ai < 2; ++ai)
#pragma unroll
            for (int m = 0; m < 4; ++m) { f32x4 o[2];
                const int lr = u.rows + ai * 128 + wr * 64 + m * 16 + fr;
                const float rs = (lr < ce) ? RS[(size_t)u.e * T_ + lr] : 0.f;
#pragma unroll
                for (int n = 0; n < 2; ++n)
#pragma unroll
                    for (int i = 0; i < 4; ++i) { const float gt = fminf(acc[ai][0][m][n][i] * rs + bgate[n][i], 7.f); const float up = fminf(fmaxf(acc[ai][1][m][n][i] * rs + bup[n][i], -7.f), 7.f);
                        o[n][i] = (up + 1.f) * gt * __builtin_amdgcn_rcpf(1.f + __builtin_amdgcn_exp2f(-1.702f * LOG2E * gt)); }
                *(u32x4*)(ACT + (size_t)(row0 + ai * 128 + m * 16) * 1024 + col) = pack8(o[0], o[1]); }
    }
};
struct EpiDN {
    static constexpr int MID_T = 0;
    bf16* YS; const float* bd;
    __device__ __forceinline__ void mid(f32x4 (&)[2][2][4][2], const pg8::Unit&, int, int, int, int) const {}
    __device__ __forceinline__ void operator()(const f32x4 (&acc)[2][2][4][2], const pg8::Unit& u, int wr, int wc, int fr, int fq) const {
        const int row0 = u.pm * 256 + wr * 64 + fr, col0 = 256 * u.pn + 32 * wc + 8 * fq;
        const float* bb = bd + (size_t)u.e * 1024 + col0;
        f32x4 bv[2][2];
#pragma unroll
        for (int bj = 0; bj < 2; ++bj)
#pragma unroll
            for (int n = 0; n < 2; ++n) bv[bj][n] = *(const f32x4*)(bb + 128 * bj + 4 * n);
#pragma unroll
        for (int ai = 0; ai < 2; ++ai)
#pragma unroll
            for (int m = 0; m < 4; ++m)
#pragma unroll
                for (int bj = 0; bj < 2; ++bj)
                    *(u32x4*)(YS + (size_t)(row0 + ai * 128 + m * 16) * 1024 + col0 + 128 * bj) = pack8(acc[ai][bj][m][0] + bv[bj][0], acc[ai][bj][m][1] + bv[bj][1]);
    }
};
namespace attn {
constexpr int KROW = 144;
constexpr int LDS_K = 0, LDS_V = 256 * KROW, LDS_BIAS = 2 * 256 * KROW, BIAS_STRIDE = 132;
constexpr int LDS_END = LDS_BIAS + 12 * BIAS_STRIDE * 4;
typedef short v4i16_t __attribute__((ext_vector_type(4)));
__device__ __forceinline__ s16x4 vtr(const LAS unsigned char* p) { return __builtin_bit_cast(s16x4, __builtin_amdgcn_ds_read_tr16_b64_v4i16((LAS v4i16_t*)p)); }

__device__ __forceinline__ void item(LAS unsigned char* lds, int g, int q, int j, const bf16* QG, const bf16* KG, const bf16* VG, bf16* OG, float* LSE, int tid, int lane, int wave) {
    const int nbm1 = (g == 0) ? 15 : (g == 1 ? 3 : 0);
    const bool hasprev = (q & nbm1) != 0;
    const size_t gofs = (size_t)g * T_ * 256 + j * 64;
    const bf16* Kg = KG + gofs; const bf16* Vg = VG + gofs; const bf16* Qg = QG + gofs;
    const int R0 = 128 * (q - 1), klo = hasprev ? 0 : 128;
#pragma unroll
    for (int it = 0; it < 4; ++it) {
        const int c = tid + it * 512, r = c >> 3, ch = c & 7;
        if (r >= klo) {
            const u32x4 kv = *(const u32x4*)(Kg + (size_t)(R0 + r) * 256 + ch * 8);
            const u32x4 vv = *(const u32x4*)(Vg + (size_t)(R0 + r) * 256 + ch * 8);
            *(LAS u32x4*)(lds + LDS_K + r * KROW + ch * 16) = kv;
            *(LAS u32x4*)(lds + LDS_V + r * KROW + ch * 16) = vv;
        }
    }
    const int ql = lane & 15, quad = lane >> 4;
    const int qi = 16 * wave + ql;
    const bf16* qp = Qg + (size_t)(128 * q + qi) * 256 + 8 * quad;
    const bf16x8 qf0 = *(const bf16x8*)(qp), qf1 = *(const bf16x8*)(qp + 32);
    __syncthreads();
    const LAS float* bias = (const LAS float*)(lds + LDS_BIAS) + (g * 4 + j) * BIAS_STRIDE;
    float m = -1e30f, l = 0.f;
    f32x4 o[4];
#pragma unroll
    for (int dt = 0; dt < 4; ++dt) o[dt] = (f32x4){0.f, 0.f, 0.f, 0.f};
    const int s_lo = hasprev ? (wave >> 1) : 4, s_hi = (wave >> 1) + 4;
    const LAS unsigned char* kbase = lds + LDS_K + ql * KROW + quad * 16;
    const LAS unsigned char* vbase = lds + LDS_V + (4 * quad + (ql >> 2)) * KROW + (ql & 3) * 8;
    for (int s = s_lo; s <= s_hi; ++s) {
        const LAS unsigned char* kp = kbase + 32 * s * KROW;
        const bf16x8 k00 = *(const LAS bf16x8*)(kp), k01 = *(const LAS bf16x8*)(kp + 64);
        const bf16x8 k10 = *(const LAS bf16x8*)(kp + 16 * KROW), k11 = *(const LAS bf16x8*)(kp + 16 * KROW + 64);
        f32x4 c0 = (f32x4){0.f, 0.f, 0.f, 0.f}, c1 = (f32x4){0.f, 0.f, 0.f, 0.f};
        c0 = __builtin_amdgcn_mfma_f32_16x16x32_bf16(k00, qf0, c0, 0, 0, 0);
        c0 = __builtin_amdgcn_mfma_f32_16x16x32_bf16(k01, qf1, c0, 0, 0, 0);
        c1 = __builtin_amdgcn_mfma_f32_16x16x32_bf16(k10, qf0, c1, 0, 0, 0);
        c1 = __builtin_amdgcn_mfma_f32_16x16x32_bf16(k11, qf1, c1, 0, 0, 0);
        float mx = -INFINITY;
#pragma unroll
        for (int i = 0; i < 4; ++i) {
            const int kj0 = 32 * s + 4 * quad + i, d0 = qi + 128 - kj0, d1 = d0 - 16;
            const bool v0 = (d0 >= 0) && (d0 <= 128) && (hasprev || kj0 >= 128);
            const bool v1 = (d1 >= 0) && (d1 <= 128) && (hasprev || kj0 + 16 >= 128);
            const float b0 = bias[min(max(d0, 0), 128)], b1 = bias[min(max(d1, 0), 128)];
            c0[i] = v0 ? c0[i] + b0 : -INFINITY; c1[i] = v1 ? c1[i] + b1 : -INFINITY;
            mx = fmaxf(mx, fmaxf(c0[i], c1[i]));
        }
        mx = fmaxf(mx, __shfl_xor(mx, 16)); mx = fmaxf(mx, __shfl_xor(mx, 32));
        const float mn = fmaxf(m, mx), alpha = __builtin_amdgcn_exp2f(m - mn);
        m = mn;
        float ps = 0.f;
#pragma unroll
        for (int i = 0; i < 4; ++i) { c0[i] = __builtin_amdgcn_exp2f(c0[i] - mn); c1[i] = __builtin_amdgcn_exp2f(c1[i] - mn); ps += c0[i] + c1[i]; }
        l = l * alpha + ps;
        u32x4 pw; pw.x = pk2(c0[0], c0[1]); pw.y = pk2(c0[2], c0[3]); pw.z = pk2(c1[0], c1[1]); pw.w = pk2(c1[2], c1[3]);
        const bf16x8 pf = __builtin_bit_cast(bf16x8, pw);
        const LAS unsigned char* vp = vbase + 32 * s * KROW;
#pragma unroll
        for (int dt = 0; dt < 4; ++dt) {
            const s16x4 lo = vtr(vp + dt * 32), hi = vtr(vp + dt * 32 + 16 * KROW);
            const bf16x8 vf = (bf16x8){lo[0], lo[1], lo[2], lo[3], hi[0], hi[1], hi[2], hi[3]};
            o[dt] = o[dt] * alpha;
            o[dt] = __builtin_amdgcn_mfma_f32_16x16x32_bf16(vf, pf, o[dt], 0, 0, 0);
        }
    }
    l += __shfl_xor(l, 16); l += __shfl_xor(l, 32);
    const float inv = __builtin_amdgcn_rcpf(l);
    const int tok = reint_row(g, 128 * q + qi);
    bf16* op = OG + (size_t)g * T_ * 256 + (size_t)tok * 256 + j * 64 + 4 * quad;
#pragma unroll
    for (int dt = 0; dt < 4; ++dt) { u32x2 w; w.x = pk2(o[dt][0] * inv, o[dt][1] * inv); w.y = pk2(o[dt][2] * inv, o[dt][3] * inv); *(u32x2*)(op + 16 * dt) = w; }
    if (quad == 0) LSE[(size_t)g * T_ * 4 + tok * 4 + j] = m + __builtin_amdgcn_logf(l);
    __syncthreads();
}
}
constexpr int NWAVES = 8;
constexpr size_t MiB = 1u << 20;
constexpr size_t WS_CTL = 0, CTL_ZERO_BYTES = 256 * 1024;
constexpr size_t WS_WT1 = 2 * MiB;
constexpr size_t WS_WT2 = 17 * MiB;
constexpr size_t WS_WT3 = 20 * MiB;
constexpr size_t WS_WGU = 24 * MiB;
constexpr size_t WS_WD = 152 * MiB;
constexpr size_t WS_H = 216 * MiB;
constexpr size_t WS_U = 248 * MiB;
constexpr size_t WS_CB = 280 * MiB;
constexpr size_t WS_QG = 312 * MiB, WS_KG = 336 * MiB, WS_VG = 360 * MiB;
constexpr size_t WS_SGC = 384 * MiB, WS_RAT = 416 * MiB;
constexpr size_t WS_OG = 448 * MiB;
constexpr size_t WS_LSE = 472 * MiB;
constexpr size_t WS_A2 = 474 * MiB;
constexpr size_t WS_MERGED = 514 * MiB;
constexpr size_t WS_ACT = 546 * MiB;
constexpr size_t WS_YS = 690 * MiB;
constexpr size_t WS_LISTS = 834 * MiB;
constexpr size_t WS_TOKE = 836 * MiB, WS_TOKS = WS_TOKE + 256 * 1024, WS_TOKW = WS_TOKS + 256 * 1024;
constexpr size_t WS_BIAS2 = 837 * MiB;
constexpr size_t WS_WRI = 837 * MiB + 65536;
constexpr size_t WS_RS = 838 * MiB;
constexpr size_t WS_END = 840 * MiB;
constexpr int CW_TMO = 0, CW_BAR = 4096, CW_CNT = 8192;
constexpr int RING_OFF = 0, RING_BYTES = 131072;
constexpr int LDSCTL_OFF = 153600, MISC_OFF = LDSCTL_OFF + 320;
constexpr int LDS_TOK = MISC_OFF + 128;
constexpr int LDS_BYTES = 163840;
constexpr int WRS = 1032, WRI_BYTES = 2 * 32 * WRS * 2;
constexpr int LDS_RX = 135168;

typedef GAS unsigned gu32;
#define RLX_AGENT __ATOMIC_RELAXED, __HIP_MEMORY_SCOPE_AGENT
#define LDS_WAIT() asm volatile("s_waitcnt lgkmcnt(0)" ::: "memory")
#define VM_WAIT() asm volatile("s_waitcnt vmcnt(0)" ::: "memory")

#define XB_TMO      128
#define XB_XCNT(j)  (256  + 64 * (j))
#define XB_XSUB(j)  (1280 + 64 * (j))
#define XB_XGEN(j)  (2304 + 64 * (j))
#define XB_TOP      3328
#define XB_TOPGEN   3392
#define XCD_BAR_WORDS 3456
#define XB_SPIN_CAP (1u << 18)
__device__ __forceinline__ unsigned xb_ld(unsigned* p)              { return __hip_atomic_load(p, __ATOMIC_RELAXED, __HIP_MEMORY_SCOPE_AGENT); }
__device__ __forceinline__ unsigned xb_add(unsigned* p, unsigned v) { return __hip_atomic_fetch_add(p, v, __ATOMIC_RELAXED, __HIP_MEMORY_SCOPE_AGENT); }
__device__ __forceinline__ unsigned xb_xcc_id() { return (unsigned)__builtin_amdgcn_s_getreg((3 << 11) | 20) & 0xFu; }
#define XB_SPIN(cond, bar) do { unsigned _sp = 0; while (cond) { __builtin_amdgcn_s_sleep(1); \
    if ((++_sp & 255u) == 0u) { if (xb_ld(&(bar)[XB_TMO])) break; if (_sp > XB_SPIN_CAP) { atomicAdd(&(bar)[XB_TMO], 1u); break; } } } } while (0)
struct XcdBarrier { unsigned* bar; unsigned x; volatile LAS unsigned* st; };
__device__ __forceinline__ XcdBarrier xcd_barrier_post(unsigned* bar, volatile LAS unsigned* st) {
    XcdBarrier b; b.bar = bar; b.x = xb_xcc_id(); b.st = st;
    if (threadIdx.x == 0) (void)xb_add(&bar[XB_XCNT(b.x)], 1u);
    return b;
}
__device__ __forceinline__ void xcd_barrier_complete(unsigned* bar, unsigned x, unsigned& nloc, unsigned& nx) {
    const unsigned G = gridDim.x * gridDim.y * gridDim.z;
    unsigned sum, cnt, mine, sp = 0u;
    for (;;) {
        sum = 0u; cnt = 0u; mine = 0u;
#pragma unroll
        for (unsigned j = 0; j < 16; ++j) { const unsigned c = xb_ld(&bar[XB_XCNT(j)]); sum += c; cnt += (c > 0u) ? 1u : 0u; mine = (j == x) ? c : mine; }
        if (sum == G) break;
        __builtin_amdgcn_s_sleep(1);
        if ((++sp & 255u) == 0u) { if (xb_ld(&bar[XB_TMO])) break; if (sp > XB_SPIN_CAP) { atomicAdd(&bar[XB_TMO], 1u); break; } }
    }
    nloc = mine > 0u ? mine : 1u; nx = cnt > 0u ? cnt : 1u;
}
__device__ __forceinline__ void xcd_barrier(const XcdBarrier& b) {
    asm volatile("s_waitcnt vmcnt(0)" ::: "memory");
    __syncthreads();
    if (threadIdx.x == 0) {
        unsigned* bar = b.bar;
        __builtin_amdgcn_s_waitcnt(0);
        unsigned nloc = b.st[0], nx = b.st[1];
        if (nloc == 0u) { xcd_barrier_complete(bar, b.x, nloc, nx); b.st[0] = nloc; b.st[1] = nx; }
        const unsigned old = xb_add(&bar[XB_XSUB(b.x)], 1u);
        const unsigned gen = old / nloc;
        if (old + 1u == (gen + 1u) * nloc) {
            __builtin_amdgcn_fence(__ATOMIC_RELEASE, "agent");
            asm volatile("s_waitcnt vmcnt(0)" ::: "memory");
            const unsigned og = xb_add(&bar[XB_TOP], 1u);
            const unsigned tg = og / nx;
            if (og + 1u == (tg + 1u) * nx) xb_add(&bar[XB_TOPGEN], 1u);
            else XB_SPIN(xb_ld(&bar[XB_TOPGEN]) == tg, bar);
            __builtin_amdgcn_fence(__ATOMIC_ACQUIRE, "agent");
            xb_add(&bar[XB_XGEN(b.x)], 1u);
            asm volatile("s_waitcnt vmcnt(0)" ::: "memory");
        } else {
            XB_SPIN(xb_ld(&bar[XB_XGEN(b.x)]) == gen, bar);
            __builtin_amdgcn_fence(__ATOMIC_ACQUIRE, "agent");
            asm volatile("s_waitcnt vmcnt(0)" ::: "memory");
        }
    }
    __syncthreads();
}

struct Frame {
    LAS unsigned char* lds; volatile LAS unsigned* MISC; gu32* ctl;
    int tid, lane, wave, vcu, G;
    const float *x, *n1g, *w_in, *gq, *gk, *relb, *convw, *w_bc, *w_ba, *w_out, *n2g, *w_r, *b_r, *w_gu, *b_gu, *w_d, *b_d; float* out;
    bf16 *WT1, *WT2, *WT3, *WGU, *WD, *H, *U, *CB, *QG, *KG, *VG, *SGC, *RAT, *OG, *A2, *MERGED, *ACT, *YS;
    float *LSE, *BIAS2, *TOKW, *RS; int *LISTS, *TOKE, *TOKS; int* CNT; bf16* WRI;
};
__device__ __forceinline__ float wave_sum(float v) {
#pragma unroll
    for (int o = 1; o < 64; o <<= 1) v += __shfl_xor(v, o);
    return v;
}
__device__ __forceinline__ float wave_max(float v) {
#pragma unroll
    for (int o = 1; o < 64; o <<= 1) v = fmaxf(v, __shfl_xor(v, o));
    return v;
}

__device__ __forceinline__ void p0_transpose_item(const float* W, int ldw, int k0, int nsrc0, bf16* WT, int ldt, int ndst0, int kdst0, LAS float* scr, int lane) {
#pragma unroll 8
    for (int i = 0; i < 32; ++i) { const int kk = 2 * i + (lane >> 5); scr[kk * 33 + (lane & 31)] = W[(size_t)(k0 + kk) * ldw + nsrc0 + (lane & 31)]; }
    LDS_WAIT(); asm volatile("" ::: "memory");
    const int c = lane & 7;
#pragma unroll
    for (int j = 0; j < 4; ++j) { const int n = (lane >> 3) + 8 * j; const LAS float* s = scr + (8 * c) * 33 + n;
        u32x4 o; o.x = pk2(s[0 * 33], s[1 * 33]); o.y = pk2(s[2 * 33], s[3 * 33]); o.z = pk2(s[4 * 33], s[5 * 33]); o.w = pk2(s[6 * 33], s[7 * 33]);
        *(GAS u32x4*)(WT + (size_t)(ndst0 + n) * ldt + kdst0 + 8 * c) = o; }
    LDS_WAIT(); asm volatile("" ::: "memory");
}
__device__ __forceinline__ void rms_row_to_bf16(const float* xrow, const float* g, bf16* orow, int lane) {
    const GAS f32x4* xr = (const GAS f32x4*)xrow + lane; const GAS f32x4* gr = (const GAS f32x4*)g + lane;
    f32x4 v[4]; float s2 = 0.f;
#pragma unroll
    for (int j = 0; j < 4; ++j) { v[j] = xr[64 * j]; s2 += (v[j].x * v[j].x + v[j].y * v[j].y) + (v[j].z * v[j].z + v[j].w * v[j].w); }
    const float rstd = 1.f / sqrtf(wave_sum(s2) * (1.f / D_) + EPS);
    GAS unsigned long long* o8 = (GAS unsigned long long*)orow + lane;
#pragma unroll
    for (int j = 0; j < 4; ++j) { const f32x4 gg = gr[64 * j]; o8[64 * j] = (unsigned long long)pk2(v[j].x * rstd * gg.x, v[j].y * rstd * gg.y) | ((unsigned long long)pk2(v[j].z * rstd * gg.z, v[j].w * rstd * gg.w) << 32); }
}
__device__ __forceinline__ void p0_prologue(Frame& F) {
    LAS float* scr = (LAS float*)(F.lds + RING_OFF + F.wave * 16384);
    const int gw = F.vcu * NWAVES + F.wave, NGW = F.G * NWAVES;
    constexpr int I1 = (INW / 32) * 16, I2A = 32 * 4, I2B = 32 * 16, I3 = 32 * 16, I4 = NE * 64 * 16, I5 = NE * 32 * 16;
    constexpr int NITEMS = I1 + I2A + I2B + I3 + I4 + I5;
    for (int it = gw; it < NITEMS; it += NGW) {
        int r = it;
        if (r < I1) { const int gb = r >> 4, kb = r & 15; p0_transpose_item(F.w_in, INW, 64 * kb, colmap1(32 * gb), F.WT1, 1024, 32 * gb, 64 * kb, scr, F.lane); continue; } r -= I1;
        if (r < I2A) { const int gb = r >> 2, kb = r & 3; p0_transpose_item(F.w_ba, 1024, 64 * kb, 32 * gb, F.WT2, K2, 32 * gb, 64 * kb, scr, F.lane); continue; } r -= I2A;
        if (r < I2B) { const int gb = r >> 4, kb = r & 15; p0_transpose_item(F.w_bc, 1024, 64 * kb, 32 * gb, F.WT2, K2, 32 * gb, 256 + 64 * kb, scr, F.lane); continue; } r -= I2B;
        if (r < I3) { const int gb = r >> 4, kb = r & 15; p0_transpose_item(F.w_out, 1024, 64 * kb, 32 * gb, F.WT3, 1024, 32 * gb, 64 * kb, scr, F.lane); continue; } r -= I3;
        if (r < I4) { const int e = r >> 10, gb = (r >> 4) & 63, kb = r & 15; const int nphys = 32 * gb, pn = nphys >> 8, bj = (nphys >> 7) & 1, y = nphys & 127;
            p0_transpose_item(F.w_gu + (size_t)e * 1024 * 2048, 2048, 64 * kb, (bj ? 1024 : 0) + 128 * pn + y, F.WGU + (size_t)e * 2048 * 1024, 1024, nphys, 64 * kb, scr, F.lane); continue; } r -= I4;
        { const int e = r >> 9, gb = (r >> 4) & 31, kb = r & 15;
            p0_transpose_item(F.w_d + (size_t)e * 1024 * 1024, 1024, 64 * kb, 32 * gb, F.WD + (size_t)e * 1024 * 1024, 1024, 32 * gb, 64 * kb, scr, F.lane); }
    }
    for (int m = gw; m < T_; m += NGW) rms_row_to_bf16(F.x + (size_t)m * D_, F.n1g, F.H + (size_t)m * D_, F.lane);
    for (int i = gw * 64 + F.lane; i < 32 * 1024; i += NGW * 64) {
        const int k = i >> 5, e = i & 31; const float w = F.n2g[k] * F.w_r[i];
        const unsigned h = pk2(w, 0.f) & 0xffffu; const float r = w - bf_lo(h);
        F.WRI[e * WRS + k] = (bf16)h; F.WRI[32 * WRS + e * WRS + k] = (bf16)(pk2(r, 0.f) & 0xffffu);
    }
    if (blockIdx.x == 0) {
        for (int i = F.tid; i < 12 * 129; i += NWAVES * 64) {
            const int hh = i / 129, dl = i % 129, g = hh >> 2, dil = (g == 0) ? 1 : (g == 1 ? 4 : 16), dist = dl * dil;
            int b;
            if (dist < 16) b = dist; else { const double xx = log((double)dist / 16.0) / log(128.0) * 16.0; b = 16 + (int)xx; if (b > 31) b = 31; }
            F.BIAS2[hh * attn::BIAS_STRIDE + dl] = F.relb[b * 12 + hh] * LOG2E;
        }
    }
}

__device__ __forceinline__ void p2_attn_conv(Frame& F) {
    LAS unsigned char* lds = F.lds + RING_OFF;
    for (int i = F.tid; i < 12 * attn::BIAS_STRIDE; i += NWAVES * 64) ((LAS float*)(lds + attn::LDS_BIAS))[i] = F.BIAS2[i];
    __syncthreads();
    for (int it = F.vcu; it < 3 * 128 * 4; it += F.G) {
        const int j = it & 3, q = (it >> 2) & 127, g = it >> 9;
        attn::item(lds, g, q, j, F.QG, F.KG, F.VG, F.OG, F.LSE, F.tid, F.lane, F.wave);
    }
    const int ch = F.tid & 127;
    f32x4 w0[2], w1[2], w2[2];
#pragma unroll
    for (int h = 0; h < 2; ++h) { w0[h] = *(const f32x4*)(F.convw + 8 * ch + 4 * h); w1[h] = *(const f32x4*)(F.convw + 1024 + 8 * ch + 4 * h); w2[h] = *(const f32x4*)(F.convw + 2048 + 8 * ch + 4 * h); }
    for (int tile = F.vcu; tile < T_ / 64; tile += F.G) {
#pragma unroll 4
        for (int i = 0; i < 16; ++i) {
            const int t = tile * 64 + (F.tid >> 7) + 4 * i, s = t & 2047;
            const u32x4 z = (u32x4){0u, 0u, 0u, 0u};
            const u32x4 a0 = *(const u32x4*)(F.U + (size_t)t * 1024 + 8 * ch);
            const u32x4 a1 = (s >= 1) ? *(const u32x4*)(F.U + (size_t)(t - 1) * 1024 + 8 * ch) : z;
            const u32x4 a2 = (s >= 2) ? *(const u32x4*)(F.U + (size_t)(t - 2) * 1024 + 8 * ch) : z;
            const u32x4 cb = *(const u32x4*)(F.CB + (size_t)t * 1024 + 8 * ch);
            f32x4 r0, r1;
            r0[0] = bf_lo(cb.x) * (w2[0][0] * bf_lo(a0.x) + w1[0][0] * bf_lo(a1.x) + w0[0][0] * bf_lo(a2.x));
            r0[1] = bf_hi(cb.x) * (w2[0][1] * bf_hi(a0.x) + w1[0][1] * bf_hi(a1.x) + w0[0][1] * bf_hi(a2.x));
            r0[2] = bf_lo(cb.y) * (w2[0][2] * bf_lo(a0.y) + w1[0][2] * bf_lo(a1.y) + w0[0][2] * bf_lo(a2.y));
            r0[3] = bf_hi(cb.y) * (w2[0][3] * bf_hi(a0.y) + w1[0][3] * bf_hi(a1.y) + w0[0][3] * bf_hi(a2.y));
            r1[0] = bf_lo(cb.z) * (w2[1][0] * bf_lo(a0.z) + w1[1][0] * bf_lo(a1.z) + w0[1][0] * bf_lo(a2.z));
            r1[1] = bf_hi(cb.z) * (w2[1][1] * bf_hi(a0.z) + w1[1][1] * bf_hi(a1.z) + w0[1][1] * bf_hi(a2.z));
            r1[2] = bf_lo(cb.w) * (w2[1][2] * bf_lo(a0.w) + w1[1][2] * bf_lo(a1.w) + w0[1][2] * bf_lo(a2.w));
            r1[3] = bf_hi(cb.w) * (w2[1][3] * bf_hi(a0.w) + w1[1][3] * bf_hi(a1.w) + w0[1][3] * bf_hi(a2.w));
            *(u32x4*)(F.A2 + (size_t)t * K2 + 256 + 8 * ch) = pack8(r0, r1);
        }
    }
}
__device__ __forceinline__ void p2b_combine(Frame& F) {
    const int gt = F.vcu * NWAVES * 64 + F.tid, NT = F.G * NWAVES * 64;
    for (int idx = gt; idx < T_ * 32; idx += NT) {
        const int t = idx >> 5, c8 = idx & 31, j = c8 >> 3;
        const float l0 = F.LSE[(size_t)t * 4 + j], l1 = F.LSE[(size_t)T_ * 4 + t * 4 + j], l2 = F.LSE[(size_t)2 * T_ * 4 + t * 4 + j];
        const float mx = fmaxf(l0, fmaxf(l1, l2));
        float e0 = __builtin_amdgcn_exp2f(l0 - mx), e1 = __builtin_amdgcn_exp2f(l1 - mx), e2 = __builtin_amdgcn_exp2f(l2 - mx);
        const float inv = __builtin_amdgcn_rcpf(e0 + e1 + e2); e0 *= inv; e1 *= inv; e2 *= inv;
        const u32x4 a = *(const u32x4*)(F.OG + (size_t)t * 256 + 8 * c8), b = *(const u32x4*)(F.OG + (size_t)T_ * 256 + (size_t)t * 256 + 8 * c8), c = *(const u32x4*)(F.OG + (size_t)2 * T_ * 256 + (size_t)t * 256 + 8 * c8);
        u32x4 w;
        w.x = pk2(e0 * bf_lo(a.x) + e1 * bf_lo(b.x) + e2 * bf_lo(c.x), e0 * bf_hi(a.x) + e1 * bf_hi(b.x) + e2 * bf_hi(c.x));
        w.y = pk2(e0 * bf_lo(a.y) + e1 * bf_lo(b.y) + e2 * bf_lo(c.y), e0 * bf_hi(a.y) + e1 * bf_hi(b.y) + e2 * bf_hi(c.y));
        w.z = pk2(e0 * bf_lo(a.z) + e1 * bf_lo(b.z) + e2 * bf_lo(c.z), e0 * bf_hi(a.z) + e1 * bf_hi(b.z) + e2 * bf_hi(c.z));
        w.w = pk2(e0 * bf_lo(a.w) + e1 * bf_lo(b.w) + e2 * bf_lo(c.w), e0 * bf_hi(a.w) + e1 * bf_hi(b.w) + e2 * bf_hi(c.w));
        *(u32x4*)(F.A2 + (size_t)t * K2 + 8 * c8) = w;
    }
}
__device__ __forceinline__ void p5_router(Frame& F) {
    LAS unsigned char* lds = F.lds;
    LAS int* te = (LAS int*)(F.lds + LDS_TOK); LAS float* tw = (LAS float*)(F.lds + LDS_TOK + 1024); LAS int* rk = (LAS int*)(F.lds + LDS_TOK + 2048);
    LAS int* hist = (LAS int*)(F.lds + LDS_TOK + 3072); LAS int* base = hist + 32;
    LAS float* xch = (LAS float*)(F.lds + LDS_RX); LAS float* lgt = (LAS float*)(F.lds + LDS_RX + 9216); LAS float* rsl = lgt + 64 * 33;
    for (int i = F.tid * 16; i < WRI_BYTES; i += NWAVES * 64 * 16) *(LAS u32x4*)(lds + i) = *(const u32x4*)((const unsigned char*)F.WRI + i);
    const int lane = F.lane, tl = lane & 15, quad = lane >> 4, tt = F.wave >> 1, kh = F.wave & 1;
    for (int tile = F.vcu; tile < T_ / 64; tile += F.G) {
        if (F.tid < 32) hist[F.tid] = 0;
        const int t = tile * 64 + 16 * tt + tl;
        const float* xrow = F.out + (size_t)t * D_ + 512 * kh + 8 * quad;
        const LAS unsigned char* wh = lds + (size_t)tl * (WRS * 2) + (512 * kh + 8 * quad) * 2;
        f32x4 c0 = (f32x4){0.f, 0.f, 0.f, 0.f}, c1 = (f32x4){0.f, 0.f, 0.f, 0.f}; float ss = 0.f;
        __syncthreads();
#pragma unroll 4
        for (int s = 0; s < 16; ++s) {
            const f32x4 a = *(const f32x4*)(xrow + 32 * s), b = *(const f32x4*)(xrow + 32 * s + 4);
            ss += (a[0] * a[0] + a[1] * a[1]) + (a[2] * a[2] + a[3] * a[3]) + (b[0] * b[0] + b[1] * b[1]) + (b[2] * b[2] + b[3] * b[3]);
            u32x4 hw; hw.x = pk2(a[0], a[1]); hw.y = pk2(a[2], a[3]); hw.z = pk2(b[0], b[1]); hw.w = pk2(b[2], b[3]);
            u32x4 lw; lw.x = pk2(a[0] - bf_lo(hw.x), a[1] - bf_hi(hw.x)); lw.y = pk2(a[2] - bf_lo(hw.y), a[3] - bf_hi(hw.y)); lw.z = pk2(b[0] - bf_lo(hw.z), b[1] - bf_hi(hw.z)); lw.w = pk2(b[2] - bf_lo(hw.w), b[3] - bf_hi(hw.w));
            const bf16x8 xh = __builtin_bit_cast(bf16x8, hw), xl = __builtin_bit_cast(bf16x8, lw);
            const bf16x8 wh0 = *(const LAS bf16x8*)(wh + 64 * s), wh1 = *(const LAS bf16x8*)(wh + 64 * s + 16 * WRS * 2);
            const bf16x8 wl0 = *(const LAS bf16x8*)(wh + 64 * s + 32 * WRS * 2), wl1 = *(const LAS bf16x8*)(wh + 64 * s + 48 * WRS * 2);
            c0 = __builtin_amdgcn_mfma_f32_16x16x32_bf16(wh0, xh, c0, 0, 0, 0); c1 = __builtin_amdgcn_mfma_f32_16x16x32_bf16(wh1, xh, c1, 0, 0, 0);
            c0 = __builtin_amdgcn_mfma_f32_16x16x32_bf16(wh0, xl, c0, 0, 0, 0); c1 = __builtin_amdgcn_mfma_f32_16x16x32_bf16(wh1, xl, c1, 0, 0, 0);
            c0 = __builtin_amdgcn_mfma_f32_16x16x32_bf16(wl0, xh, c0, 0, 0, 0); c1 = __builtin_amdgcn_mfma_f32_16x16x32_bf16(wl1, xh, c1, 0, 0, 0);
        }
        LAS float* xp = xch + (tt * 64 + lane) * 9;
        if (kh == 1) {
#pragma unroll
            for (int i = 0; i < 4; ++i) { xp[i] = c0[i]; xp[4 + i] = c1[i]; }
            xp[8] = ss;
        }
        __syncthreads();
        if (kh == 0) {
#pragma unroll
            for (int i = 0; i < 4; ++i) { c0[i] += xp[i]; c1[i] += xp[4 + i]; }
            ss += xp[8];
            ss += __shfl_xor(ss, 16); ss += __shfl_xor(ss, 32);
            const float rstd = 1.f / sqrtf(ss * (1.f / D_) + EPS);
            LAS float* lp = lgt + (16 * tt + tl) * 33;
#pragma unroll
            for (int i = 0; i < 4; ++i) { lp[4 * quad + i] = c0[i] * rstd + F.b_r[4 * quad + i]; lp[16 + 4 * quad + i] = c1[i] * rstd + F.b_r[16 + 4 * quad + i]; }
            if (quad == 0) rsl[16 * tt + tl] = rstd;
        }
        __syncthreads();
        if (F.tid < 64) {
            const LAS float* lp = lgt + F.tid * 33;
            float bv0 = -INFINITY, bv1 = -INFINITY, bv2 = -INFINITY, bv3 = -INFINITY; int bi0 = 0, bi1 = 0, bi2 = 0, bi3 = 0;
#pragma unroll 8
            for (int e = 0; e < 32; ++e) { const float d = lp[e];
                if (d > bv0) { bv3 = bv2; bi3 = bi2; bv2 = bv1; bi2 = bi1; bv1 = bv0; bi1 = bi0; bv0 = d; bi0 = e; }
                else if (d > bv1) { bv3 = bv2; bi3 = bi2; bv2 = bv1; bi2 = bi1; bv1 = d; bi1 = e; }
                else if (d > bv2) { bv3 = bv2; bi3 = bi2; bv2 = d; bi2 = e; }
                else if (d > bv3) { bv3 = d; bi3 = e; } }
            const float e1 = __expf(bv1 - bv0), e2 = __expf(bv2 - bv0), e3 = __expf(bv3 - bv0), inv = 1.f / (1.f + e1 + e2 + e3);
            te[F.tid * 4 + 0] = bi0; te[F.tid * 4 + 1] = bi1; te[F.tid * 4 + 2] = bi2; te[F.tid * 4 + 3] = bi3;
            tw[F.tid * 4 + 0] = inv; tw[F.tid * 4 + 1] = e1 * inv; tw[F.tid * 4 + 2] = e2 * inv; tw[F.tid * 4 + 3] = e3 * inv;
            rk[F.tid * 4 + 0] = atomicAdd((int*)&hist[bi0], 1); rk[F.tid * 4 + 1] = atomicAdd((int*)&hist[bi1], 1); rk[F.tid * 4 + 2] = atomicAdd((int*)&hist[bi2], 1); rk[F.tid * 4 + 3] = atomicAdd((int*)&hist[bi3], 1);
        }
        __syncthreads();
        if (F.tid < 32) base[F.tid] = (int)__hip_atomic_fetch_add((unsigned*)F.CNT + F.tid, (unsigned)hist[F.tid], __ATOMIC_RELAXED, __HIP_MEMORY_SCOPE_AGENT);
        __syncthreads();
        if (F.tid < 256) {
            const int tq = F.tid >> 2, tk = tile * 64 + tq, e = te[F.tid], slot = base[e] + rk[F.tid];
            F.LISTS[(size_t)e * T_ + slot] = tk; F.RS[(size_t)e * T_ + slot] = rsl[tq];
            F.TOKE[tk * 4 + (F.tid & 3)] = e; F.TOKS[tk * 4 + (F.tid & 3)] = slot; F.TOKW[tk * 4 + (F.tid & 3)] = tw[F.tid];
        }
        __syncthreads();
    }
}

struct MoeTable { LAS int* cnt; LAS int* tstart; };
__device__ __forceinline__ MoeTable moe_table(Frame& F) {
    MoeTable M; M.cnt = (LAS int*)(F.lds + LDSCTL_OFF); M.tstart = M.cnt + 32;
    if (F.tid < 32) M.cnt[F.tid] = (int)__hip_atomic_load((unsigned*)F.CNT + F.tid, __ATOMIC_RELAXED, __HIP_MEMORY_SCOPE_AGENT);
    __syncthreads();
    if (F.tid == 0) { int a = 0; for (int e = 0; e < 32; ++e) { M.tstart[e] = a; a += (M.cnt[e] + 255) >> 8; } M.tstart[32] = a; }
    __syncthreads();
    return M;
}
template <int NN, bool GU>
struct MoeOrder {
    MoeTable M; const char* A; const char* Bt; const int* lists; int G, c, total;
    __device__ void init(const MoeTable& M_, const void* A_, const void* Bt_, const int* lists_, int G_, int c_) { M = M_; A = (const char*)A_; Bt = (const char*)Bt_; lists = lists_; G = G_; c = c_; total = M.tstart[32] * NN; }
    __device__ bool next(int i, pg8::Unit& u) const {
        const int L = i * G + c; if (L >= total) return false;
        const int mt = L / NN, pn = L % NN;
        int e = 0; while (M.tstart[e + 1] <= mt) ++e;
        u.pm = mt; u.pn = pn; u.e = e; u.rows = (mt - M.tstart[e]) * 256;
        u.b = Bt + ((size_t)e * (NN * 256) + (size_t)pn * 256) * 1024 * 2;
        u.a = GU ? A : A + (size_t)mt * 256 * 1024 * 2;
        return true;
    }
    __device__ __forceinline__ unsigned row_off(const pg8::Unit& u, int r) const {
        int lr = u.rows + r; const int ce = M.cnt[u.e]; if (lr >= ce) lr = 0;
        return (unsigned)lists[(size_t)u.e * T_ + lr] * 2048u;
    }
};

__device__ __forceinline__ void p8_final(Frame& F, const MoeTable& M) {
    const int gw = F.vcu * NWAVES + F.wave, NGW = F.G * NWAVES, lane = F.lane;
    for (int t = gw; t < T_; t += NGW) {
        int e4 = 0, s4 = 0; float w4 = 0.f;
        if (lane < 4) { e4 = F.TOKE[t * 4 + lane]; s4 = F.TOKS[t * 4 + lane]; w4 = F.TOKW[t * 4 + lane]; }
        f32x4 a[4];
        GAS f32x4* op = (GAS f32x4*)(F.out + (size_t)t * D_) + 2 * lane;
#pragma unroll
        for (int h = 0; h < 2; ++h) { a[2 * h] = op[128 * h]; a[2 * h + 1] = op[128 * h + 1]; }
#pragma unroll
        for (int k = 0; k < 4; ++k) {
            const int e = __shfl(e4, k), sl = __shfl(s4, k); const float w = __shfl(w4, k);
            const bf16* yr = F.YS + ((size_t)M.tstart[e] * 256 + sl) * 1024 + 8 * lane;
#pragma unroll
            for (int h = 0; h < 2; ++h) { const u32x4 y = *(const u32x4*)(yr + 512 * h);
                a[2 * h] += w * (f32x4){bf_lo(y.x), bf_hi(y.x), bf_lo(y.y), bf_hi(y.y)}; a[2 * h + 1] += w * (f32x4){bf_lo(y.z), bf_hi(y.z), bf_lo(y.w), bf_hi(y.w)}; }
        }
#pragma unroll
        for (int h = 0; h < 2; ++h) { op[128 * h] = a[2 * h]; op[128 * h + 1] = a[2 * h + 1]; }
    }
}
struct Args { const float* in[17]; float* out; unsigned char* ws; int ph_lo, ph_hi; };
constexpr int N_PHASES = 10;
__global__ void __launch_bounds__(NWAVES * 64, 2) mk_fwd(Args args) {
    extern __shared__ __attribute__((aligned(16))) unsigned char lds[];
    Frame F;
    F.lds = (LAS unsigned char*)lds;
    F.MISC = (volatile LAS unsigned*)(F.lds + MISC_OFF);
    F.tid = threadIdx.x; F.lane = F.tid & 63; F.wave = __builtin_amdgcn_readfirstlane(F.tid >> 6);
    F.G = gridDim.x; { const int bx = blockIdx.x; F.vcu = (F.G % 8 == 0) ? (bx % 8) * (F.G / 8) + bx / 8 : bx; }
    unsigned char* ws = args.ws;
    F.ctl = (gu32*)(ws + WS_CTL);
    F.x = args.in[0]; F.n1g = args.in[1]; F.w_in = args.in[2]; F.gq = args.in[3]; F.gk = args.in[4]; F.relb = args.in[5]; F.convw = args.in[6]; F.w_bc = args.in[7]; F.w_ba = args.in[8];
    F.w_out = args.in[9]; F.n2g = args.in[10]; F.w_r = args.in[11]; F.b_r = args.in[12]; F.w_gu = args.in[13]; F.b_gu = args.in[14]; F.w_d = args.in[15]; F.b_d = args.in[16]; F.out = args.out;
    F.WT1 = (bf16*)(ws + WS_WT1); F.WT2 = (bf16*)(ws + WS_WT2); F.WT3 = (bf16*)(ws + WS_WT3); F.WGU = (bf16*)(ws + WS_WGU); F.WD = (bf16*)(ws + WS_WD);
    F.H = (bf16*)(ws + WS_H); F.U = (bf16*)(ws + WS_U); F.CB = (bf16*)(ws + WS_CB); F.QG = (bf16*)(ws + WS_QG); F.KG = (bf16*)(ws + WS_KG); F.VG = (bf16*)(ws + WS_VG);
    F.SGC = (bf16*)(ws + WS_SGC); F.RAT = (bf16*)(ws + WS_RAT); F.OG = (bf16*)(ws + WS_OG); F.A2 = (bf16*)(ws + WS_A2); F.MERGED = (bf16*)(ws + WS_MERGED);
    F.ACT = (bf16*)(ws + WS_ACT); F.YS = (bf16*)(ws + WS_YS); F.LSE = (float*)(ws + WS_LSE); F.BIAS2 = (float*)(ws + WS_BIAS2); F.TOKW = (float*)(ws + WS_TOKW);
    F.LISTS = (int*)(ws + WS_LISTS); F.TOKE = (int*)(ws + WS_TOKE); F.TOKS = (int*)(ws + WS_TOKS); F.CNT = (int*)(ws + WS_CTL) + CW_CNT; F.RS = (float*)(ws + WS_RS); F.WRI = (bf16*)(ws + WS_WRI);
    for (int u = F.tid; u < (LDS_BYTES - LDSCTL_OFF) / 4; u += NWAVES * 64) ((LAS unsigned*)(F.lds + LDSCTL_OFF))[u] = 0u;
    __syncthreads();
    const int lo = args.ph_lo, hi = args.ph_hi;
    const bool multi = (hi - lo) > 1;
    XcdBarrier bar; bar.bar = (unsigned*)(F.ctl + CW_BAR); bar.x = 0; bar.st = nullptr;
    if (multi) bar = xcd_barrier_post((unsigned*)(F.ctl + CW_BAR), F.MISC + 8);
#ifndef PH_MASK
#define PH_MASK 0x3ff
#endif
#define IN(k) (((PH_MASK >> (k)) & 1) && lo <= (k) && (k) < hi)
#define SEAM(k) do { if (IN(k) && IN((k) + 1)) xcd_barrier(bar); } while (0)
    if (IN(0)) { p0_prologue(F); } SEAM(0);
    if (IN(1)) {
        pg8::DenseOrder S; S.init(F.H, F.WT1, T_, INW, 1024, F.G, (int)blockIdx.x);
        Epi1 E{F.U, F.CB, F.QG, F.KG, F.VG, F.SGC, F.RAT, F.gq, F.gk};
        pg8::gemm_phase<Epi1, pg8::DenseOrder, true, false>(F.lds + RING_OFF, 1024, S, E);
    } SEAM(1);
    if (IN(2)) { p2_attn_conv(F); } SEAM(2);
    if (IN(3)) { p2b_combine(F); } SEAM(3);
    if (IN(4)) {
        pg8::DenseOrder S; S.init(F.A2, F.WT2, T_, 1024, K2, F.G, (int)blockIdx.x);
        Epi2 E{F.SGC, F.RAT, F.MERGED};
        pg8::gemm_phase<Epi2, pg8::DenseOrder, true, false>(F.lds + RING_OFF, K2, S, E);
    } SEAM(4);
    if (IN(5)) {
        pg8::DenseOrder S; S.init(F.MERGED, F.WT3, T_, 1024, 1024, F.G, (int)blockIdx.x);
        Epi3 E{F.x, F.out, F.n2g, F.H};
        pg8::gemm_phase<Epi3, pg8::DenseOrder, true, false>(F.lds + RING_OFF, 1024, S, E);
    } SEAM(5);
    if (IN(6)) { p5_router(F); } SEAM(6);
    if (IN(7)) {
        const MoeTable M = moe_table(F);
        MoeOrder<8, true> S; S.init(M, F.H, F.WGU, F.LISTS, F.G, (int)blockIdx.x);
        EpiGU E{F.ACT, F.b_gu, F.RS, M.cnt};
        pg8::gemm_phase<EpiGU, MoeOrder<8, true>, true, true>(F.lds + RING_OFF, 1024, S, E);
    } SEAM(7);
    if (IN(8)) {
        const MoeTable M = moe_table(F);
        MoeOrder<4, false> S; S.init(M, F.ACT, F.WD, F.LISTS, F.G, (int)blockIdx.x);
        EpiDN E{F.YS, F.b_d};
        pg8::gemm_phase<EpiDN, MoeOrder<4, false>, true, false>(F.lds + RING_OFF, 1024, S, E);
    } SEAM(8);
    if (IN(9)) { const MoeTable M = moe_table(F); p8_final(F, M); }
#undef IN
#undef SEAM
}

static int mk_grid = 0;
static int mk_setup() {
    if (mk_grid != 0) return mk_grid;
    int dev = 0, cus = 0, per_cu = 0;
    if (hipGetDevice(&dev) != hipSuccess || hipDeviceGetAttribute(&cus, hipDeviceAttributeMultiprocessorCount, dev) != hipSuccess) { mk_grid = -1; return mk_grid; }
    if (hipFuncSetAttribute((const void*)mk_fwd, hipFuncAttributeMaxDynamicSharedMemorySize, LDS_BYTES) != hipSuccess) { fprintf(stderr, "hipFuncSetAttribute failed\n"); mk_grid = -1; return mk_grid; }
    if (hipOccupancyMaxActiveBlocksPerMultiprocessor(&per_cu, (const void*)mk_fwd, NWAVES * 64, LDS_BYTES) != hipSuccess || per_cu < 1) { fprintf(stderr, "occupancy query: %d blocks/CU\n", per_cu); (void)hipGetLastError(); mk_grid = -1; return mk_grid; }
    mk_grid = cus;
    return mk_grid;
}
static void mk_launch(void* const* d_in, void* d_out, void* d_ws, hipStream_t stream, int lo, int hi) {
    const int grid = mk_setup(); if (grid <= 0) return;
    Args a{};
    for (int i = 0; i < 17; ++i) a.in[i] = (const float*)d_in[i];
    a.out = (float*)d_out; a.ws = (unsigned char*)d_ws; a.ph_lo = lo; a.ph_hi = hi;
    hipLaunchKernelGGL(mk_fwd, dim3(grid), dim3(NWAVES * 64), LDS_BYTES, stream, a);
}
extern "C" void kernel_launch(void* const* d_in, const int* in_sizes, int n_in, void* d_out, int out_size, void* d_ws, size_t ws_size, hipStream_t stream) {
    (void)hipMemsetAsync((char*)d_ws + WS_CTL, 0, CTL_ZERO_BYTES, stream);
    mk_launch(d_in, d_out, d_ws, stream, 0, N_PHASES);
}
```

```cpp
#include <hip/hip_runtime.h>
#include <stdint.h>
#include <cstdio>

constexpr int B_ = 8, S_ = 2048, D_ = 1024, T_ = B_ * S_;
constexpr int INW = 7424, NE = 32;
constexpr int OFF_CB = 0, OFF_CC = 1024, OFF_CX = 2048, OFF_Q = 3072, OFF_K = 3840, OFF_V = 4608, OFF_GC = 5376, OFF_GA = 6400;
constexpr float EPS = 1e-6f;
constexpr float LOG2E = 1.4426950408889634f, LN2 = 0.6931471805599453f;
constexpr float QSCALE = 0.125f * LOG2E;
constexpr int K2 = 1280;
constexpr int PMAX = 65536 + 32 * 256;

#define GAS __attribute__((address_space(1)))
#define LAS __attribute__((address_space(3)))
typedef unsigned short bf16;
typedef short bf16x8 __attribute__((ext_vector_type(8)));
typedef short s16x4 __attribute__((ext_vector_type(4)));
typedef float f32x4 __attribute__((ext_vector_type(4)));
typedef float f32x2 __attribute__((ext_vector_type(2)));
typedef unsigned u32x4 __attribute__((ext_vector_type(4)));
typedef unsigned u32x2 __attribute__((ext_vector_type(2)));
typedef __bf16 bf16x2_t __attribute__((ext_vector_type(2)));
typedef int v8i __attribute__((ext_vector_type(8)));
typedef int v4i __attribute__((ext_vector_type(4)));

__device__ __forceinline__ unsigned pk2(float lo, float hi) { f32x2 v = {lo, hi}; bf16x2_t b = __builtin_convertvector(v, bf16x2_t); return __builtin_bit_cast(unsigned, b); }
__device__ __forceinline__ float clamp_fp8(float x) { return __builtin_amdgcn_fmed3f(x, -448.f, 448.f); }
__device__ __forceinline__ unsigned pk4_fp8(float a, float b, float c, float d) { int w = __builtin_amdgcn_cvt_pk_fp8_f32(a, b, 0, false); w = __builtin_amdgcn_cvt_pk_fp8_f32(c, d, w, true); return (unsigned)w; }
__device__ __forceinline__ float bf_lo(unsigned u) { return __uint_as_float(u << 16); }
__device__ __forceinline__ float bf_hi(unsigned u) { return __uint_as_float(u & 0xffff0000u); }
__device__ __forceinline__ float sigmoidf_(float x) { return __builtin_amdgcn_rcpf(1.f + __builtin_amdgcn_exp2f(-LOG2E * x)); }

namespace pg8 {
constexpr int BM = 256, BK = 64, HALF = 128, HTB = HALF * BK * 2, STAGE_BYTES = 8 * HTB, NXCD = 8, WGM = 8;
__host__ __device__ __forceinline__ int lds_byte(int r, int c) { const int st = (r >> 4) * 2 + (c >> 5), rr = r & 15, cc = c & 31, ob = rr * 64 + cc * 2; return st * 1024 + (ob ^ (((ob >> 9) & 1) << 5)); }
__host__ __device__ __forceinline__ void stage_rc(int b, int& R, int& C) { const int st = b / 1024, sb = b % 1024, swz = sb ^ (((sb >> 9) & 1) << 5); R = (st >> 1) * 16 + swz / 64; C = (st & 1) * 32 + (swz % 64) / 2; }
__host__ __device__ __forceinline__ int perm32(int rho) { const int n = rho >> 4, i = rho & 15; return 8 * (i >> 2) + 4 * n + (i & 3); }

struct Unit { const char* a; const char* b; int pm, pn, e, rows; };

template <int NM, int NN>
struct DenseOrder {
    static_assert(NM % WGM == 0, "row tiles in groups of 8");
    const char* A; const char* Bt; int KB, G, c;
    __device__ void init(const void* A_, const void* Bt_, int KB_, int G_, int c_) { A = (const char*)A_; Bt = (const char*)Bt_; KB = KB_; G = G_; c = c_; }
    __device__ bool next(int i, Unit& u) const {
        constexpr int nwg = NM * NN, q = nwg / NXCD, r = nwg % NXCD, nig = WGM * NN;
        const int L = i * G + c; if (L >= nwg) return false;
        const int xcd = L % NXCD, off = L / NXCD; const int wgid = (xcd < r ? xcd * (q + 1) : r * (q + 1) + (xcd - r) * q) + off;
        const int gid = wgid / nig, rem = wgid % nig;
        u.pm = gid * WGM + (rem % WGM); u.pn = rem / WGM; u.e = 0; u.rows = 256;
        u.a = A + (size_t)u.pm * BM * KB; u.b = Bt + (size_t)u.pn * BM * KB; return true;
    }
    __device__ __forceinline__ unsigned row_off(const Unit&, int) const { return 0u; }
};

#ifndef TPROBE
#define TPROBE (-2)
#endif
template <class Epi, class Sched, bool ALIGN_EPI, bool GATHER, bool FP8, int PID = -1>
__device__ __forceinline__ void gemm_phase(LAS unsigned char* lds, const int KB, const Sched& S, const Epi& E) {
    constexpr bool TP = (PID == TPROBE);
    unsigned long long tp_t1 = 0; bool tp_pend = false; LAS unsigned* tpw = (LAS unsigned*)(lds + 163840 - 64);
    if constexpr (TP) { if (threadIdx.x == 0) { tpw[0] = 0; tpw[1] = 0; tpw[2] = 0; tpw[3] = 0; } }
    const int tid = threadIdx.x, wid = __builtin_amdgcn_readfirstlane(tid >> 6), lane = tid & 63, wr = wid >> 2, wc = wid & 3, fr = lane & 15, fq = lane >> 4;
    const int nt = KB / 128;
    unsigned voffA[2], voffB[2]; int RA[2]; unsigned CA2[2];
#pragma unroll
    for (int i = 0; i < 2; ++i) { int R, C; stage_rc(tid * 16 + i * 8192, R, C); const int Rb = (R & ~31) + perm32(R & 31);
        voffA[i] = (unsigned)(R * KB + C * 2); voffB[i] = (unsigned)(Rb * KB + C * 2); RA[i] = R; CA2[i] = (unsigned)C * 2u; }
    const size_t kstep = (size_t)(BK * 2);
    const size_t hstep = (size_t)HALF * KB;
    const unsigned ldsw = (unsigned)wid * 1024u;
    const int aoff = lds_byte(wr * 64 + fr, fq * 8), boff = lds_byte(wc * 32 + fr, fq * 8);
#define PG8_SA(b, h) (((b) * 2 + (h)) * HTB)
#define PG8_SB(b, h) ((4 + (b) * 2 + (h)) * HTB)
#define PG8_STAGE2(bufoff, gbase, o0, o1) do { \
        __builtin_amdgcn_global_load_lds((const unsigned*)((const char*)(gbase) + (o0)), (LAS unsigned*)(lds + (bufoff) + ldsw), 16, 0, 0); \
        __builtin_amdgcn_global_load_lds((const unsigned*)((const char*)(gbase) + (o1)), (LAS unsigned*)(lds + (bufoff) + ldsw + 8192), 16, 0, 0); } while (0)
#define PG8_STB(bufoff, gbase) PG8_STAGE2(bufoff, gbase, voffB[0], voffB[1])
#define PG8_STA(bufoff, gbase, h, nx) do { if constexpr (GATHER) { const unsigned o0_ = (nx) ? gn[h][0] : gc[h][0], o1_ = (nx) ? gn[h][1] : gc[h][1]; PG8_STAGE2(bufoff, gbase, o0_, o1_); } \
        else { PG8_STAGE2(bufoff, (gbase) + (h) * hstep, voffA[0], voffA[1]); } } while (0)
#define PG8_RD8(p_) __builtin_shufflevector(__builtin_bit_cast(v4i, *(const LAS bf16x8*)(p_)), __builtin_bit_cast(v4i, *(const LAS bf16x8*)((p_) + 1024)), 0, 1, 2, 3, 4, 5, 6, 7)
#define PG8_LDA(dst, b, h) do { _Pragma("unroll") for (int m = 0; m < 4; ++m) { if constexpr (FP8) { dst##8[m] = PG8_RD8(lds + PG8_SA(b, h) + aoff + m * 2048); } else { _Pragma("unroll") for (int k = 0; k < 2; ++k) dst[m][k] = *(const LAS bf16x8*)(lds + PG8_SA(b, h) + aoff + m * 2048 + k * 1024); } } } while (0)
#define PG8_LDB(dst, b, h) do { _Pragma("unroll") for (int n = 0; n < 2; ++n) { if constexpr (FP8) { dst##8[n] = PG8_RD8(lds + PG8_SB(b, h) + boff + n * 2048); } else { _Pragma("unroll") for (int k = 0; k < 2; ++k) dst[n][k] = *(const LAS bf16x8*)(lds + PG8_SB(b, h) + boff + n * 2048 + k * 1024); } } } while (0)
#define PG8_MMA(ai, bj, At, Bt) do { __builtin_amdgcn_s_setprio(1); _Pragma("unroll") for (int m = 0; m < 4; ++m) _Pragma("unroll") for (int n = 0; n < 2; ++n) { \
        if constexpr (FP8) { asm volatile("v_mfma_scale_f32_16x16x128_f8f6f4 %0, %1, %2, %0, %3, %3 op_sel_hi:[0,0,0]" : "+v"(acc[ai][bj][m][n]) : "v"(Bt##8[n]), "v"(At##8[m]), "v"(sc1_)); } \
        else { _Pragma("unroll") for (int k = 0; k < 2; ++k) acc[ai][bj][m][n] = __builtin_amdgcn_mfma_f32_16x16x32_bf16(Bt[n][k], At[m][k], acc[ai][bj][m][n], 0, 0, 0); } } \
        if constexpr (FP8) asm volatile("s_nop 4"); \
        __builtin_amdgcn_s_setprio(0); } while (0)
#define PG8_WAIT_V(n) asm volatile("s_waitcnt vmcnt(" #n ")" ::: "memory")
#define PG8_WAIT_L(n) asm volatile("s_waitcnt lgkmcnt(" #n ")" ::: "memory")
#define PG8_BAR __builtin_amdgcn_s_barrier()
#define PG8_SCHED __builtin_amdgcn_sched_barrier(0)
#define PG8_TPH(w) do { if constexpr (TP) { if (tp_pend) { const unsigned long long tn_ = __builtin_amdgcn_s_memrealtime(); if (blockIdx.x == 0 && tid == 0 && (w) < 2) tpw[1 + (w)] += (unsigned)(tn_ - tp_t1); tp_t1 = tn_; if ((w) == 2) tp_pend = false; } } } while (0)
#define PG8_KBODY do { \
            const bool last = (t == nt - 2); \
            const char* a1 = cA + (size_t)(t + 1) * kstep; \
            const char* a2 = last ? nA : cA + (size_t)(t + 2) * kstep; const char* b2 = last ? nB : cB + (size_t)(t + 2) * kstep; \
            const char* a3 = a2 + kstep; const char* b3 = b2 + kstep; \
            PG8_LDB(B0, 0, 0); PG8_LDB(B1, 0, 1); PG8_SCHED; PG8_LDA(At, 0, 0); PG8_STA(PG8_SA(1, 1), a1, 1, false); \
            PG8_TPH(0); PG8_WAIT_V(8); PG8_TPH(1); PG8_WAIT_L(0); PG8_BAR; PG8_TPH(2); PG8_MMA(0, 0, At, B0); PG8_MMA(0, 1, At, B1); PG8_BAR; PG8_SCHED; \
            PG8_LDA(At, 0, 1); PG8_STB(PG8_SB(0, 0), b2); PG8_STB(PG8_SB(0, 1), b2 + hstep); PG8_STA(PG8_SA(0, 0), a2, 0, last); \
            PG8_WAIT_V(8); PG8_WAIT_L(0); PG8_BAR; PG8_MMA(1, 0, At, B0); PG8_MMA(1, 1, At, B1); PG8_BAR; PG8_SCHED; \
            PG8_LDB(B0, 1, 0); PG8_LDB(B1, 1, 1); PG8_SCHED; PG8_LDA(At, 1, 0); PG8_STA(PG8_SA(0, 1), a2, 1, last); \
            PG8_WAIT_V(8); PG8_WAIT_L(0); PG8_BAR; PG8_MMA(0, 0, At, B0); PG8_MMA(0, 1, At, B1); PG8_BAR; PG8_SCHED; \
            PG8_LDA(At, 1, 1); PG8_STB(PG8_SB(1, 0), b3); PG8_STB(PG8_SB(1, 1), b3 + hstep); PG8_STA(PG8_SA(1, 0), a3, 0, last); \
            PG8_WAIT_V(8); PG8_WAIT_L(0); PG8_BAR; PG8_MMA(1, 0, At, B0); PG8_MMA(1, 1, At, B1); PG8_BAR; PG8_SCHED; \
        } while (0)
    Unit cur, nxt; int ui = 0;
    if (!S.next(0, cur)) return;
    f32x4 acc[2][2][4][2];
#pragma unroll
    for (int a = 0; a < 2; ++a)
#pragma unroll
        for (int b = 0; b < 2; ++b)
#pragma unroll
            for (int m = 0; m < 4; ++m)
#pragma unroll
                for (int n = 0; n < 2; ++n) acc[a][b][m][n] = (f32x4){0.f, 0.f, 0.f, 0.f};
#define PG8_OPAQ() do { if constexpr (FP8) { _Pragma("unroll") for (int a = 0; a < 2; ++a) _Pragma("unroll") for (int b = 0; b < 2; ++b) \
        asm volatile("" : "+v"(acc[a][b][0][0]), "+v"(acc[a][b][0][1]), "+v"(acc[a][b][1][0]), "+v"(acc[a][b][1][1]), "+v"(acc[a][b][2][0]), "+v"(acc[a][b][2][1]), "+v"(acc[a][b][3][0]), "+v"(acc[a][b][3][1])); } } while (0)
    bf16x8 At[4][2], B0[2][2], B1[2][2]; v8i At8[4], B08[2], B18[2]; int sc1_ = 0x7f7f7f7f; asm volatile("" : "+v"(sc1_));
    unsigned gc[2][2], gn[2][2];
    if constexpr (GATHER) {
#pragma unroll
        for (int h = 0; h < 2; ++h)
#pragma unroll
            for (int i = 0; i < 2; ++i) { gc[h][i] = S.row_off(cur, h * HALF + RA[i]) + CA2[i]; gn[h][i] = gc[h][i]; }
    }
    const char* cA = cur.a; const char* cB = cur.b;
    PG8_STB(PG8_SB(0, 0), cB); PG8_STB(PG8_SB(0, 1), cB + hstep); PG8_STA(PG8_SA(0, 0), cA, 0, false); PG8_STA(PG8_SA(0, 1), cA, 1, false);
    if (wr == 1) PG8_BAR;
    PG8_WAIT_V(2); PG8_BAR;
    PG8_STB(PG8_SB(1, 0), cB + kstep); PG8_STA(PG8_SA(1, 0), cA + kstep, 0, false); PG8_STB(PG8_SB(1, 1), cB + hstep + kstep);
    PG8_WAIT_V(6); PG8_BAR;
    LAS unsigned char* const pfbase = lds + 133120;
    for (;;) {
        if constexpr (Epi::PF) E.prefetch(cur, pfbase + (ui & 1) * 4096, wid, lane);
        const bool has_next = S.next(ui + 1, nxt);
        if constexpr (GATHER) {
            if (has_next) {
#pragma unroll
                for (int h = 0; h < 2; ++h)
#pragma unroll
                    for (int i = 0; i < 2; ++i) gn[h][i] = S.row_off(nxt, h * HALF + RA[i]) + CA2[i];
            }
        }
        const char* nA = has_next ? nxt.a : cA; const char* nB = has_next ? nxt.b : cB;
        if constexpr (Epi::MID_T > 0) {
            for (int t = 0; t < Epi::MID_T; t += 2) PG8_KBODY;
            E.mid(acc, cur, wr, wc, fr, fq);
            for (int t = Epi::MID_T; t < nt; t += 2) PG8_KBODY;
        } else {
            for (int t = 0; t < nt; t += 2) PG8_KBODY;
        }
        if constexpr (FP8) asm volatile("s_nop 15\n\ts_nop 15");
        if constexpr (ALIGN_EPI) { if (wr == 0) PG8_BAR; }
        unsigned long long tp_t0 = 0; if constexpr (TP) tp_t0 = __builtin_amdgcn_s_memrealtime();
        E(acc, cur, wr, wc, fr, fq, pfbase + (ui & 1) * 4096);
        if constexpr (TP) { tp_t1 = __builtin_amdgcn_s_memrealtime(); if (blockIdx.x == 0 && tid == 0) { tpw[0] += (unsigned)(tp_t1 - tp_t0); tpw[3] += 1u; } tp_pend = true; }
        if (!has_next) break;
#pragma unroll
        for (int a = 0; a < 2; ++a)
#pragma unroll
            for (int b = 0; b < 2; ++b)
#pragma unroll
                for (int m = 0; m < 4; ++m)
#pragma unroll
                    for (int n = 0; n < 2; ++n) acc[a][b][m][n] = (f32x4){0.f, 0.f, 0.f, 0.f};
            cur = nxt; cA = nA; cB = nB; ++ui;
        if constexpr (GATHER) {
#pragma unroll
            for (int h = 0; h < 2; ++h)
#pragma unroll
                for (int i = 0; i < 2; ++i) gc[h][i] = gn[h][i];
        }
        if constexpr (ALIGN_EPI) { if (wr == 1) PG8_BAR; }
    }
    PG8_WAIT_V(0);
    if constexpr (!ALIGN_EPI) { if (wr == 0) PG8_BAR; }
    PG8_BAR;

#undef PG8_KBODY
#undef PG8_TPH
#undef PG8_OPAQ
#undef PG8_SA
#undef PG8_SB
#undef PG8_STAGE2
#undef PG8_STB
#undef PG8_STA
#undef PG8_LDA
#undef PG8_LDB
#undef PG8_MMA
#undef PG8_WAIT_V
#undef PG8_WAIT_L
#undef PG8_BAR
#undef PG8_SCHED
}
}
__device__ __forceinline__ int deint_row(int g, int t) {
    const int b = t & ~2047, s = t & 2047;
    if (g == 0) return t;
    if (g == 1) return b + (s & 3) * 512 + (s >> 2);
    return b + (s & 15) * 128 + (s >> 4);
}
__device__ __forceinline__ int reint_row(int g, int R) {
    const int b = R & ~2047, s = R & 2047;
    if (g == 0) return R;
    if (g == 1) return b + (s & 511) * 4 + (s >> 9);
    return b + (s & 127) * 16 + (s >> 7);
}
#ifdef USE_NT
#define NTST(p, v) __builtin_nontemporal_store((v), (u32x4*)(p))
#else
#define NTST(p, v) (*(u32x4*)(p) = (v))
#endif
__device__ __forceinline__ u32x4 pack8(const f32x4 a, const f32x4 b) { u32x4 w; w.x = pk2(a[0], a[1]); w.y = pk2(a[2], a[3]); w.z = pk2(b[0], b[1]); w.w = pk2(b[2], b[3]); return w; }

__device__ __forceinline__ u32x4 fp8_pair16(const u32x2 pa, const u32x2 pb, const bool odd) {
    const u32x2 snd = odd ? pa : pb;
    u32x2 rcv; rcv.x = (unsigned)__shfl_xor((int)snd.x, 16); rcv.y = (unsigned)__shfl_xor((int)snd.y, 16);
    return odd ? (u32x4){rcv.x, rcv.y, pb.x, pb.y} : (u32x4){pa.x, pa.y, rcv.x, rcv.y};
}
__host__ __device__ __forceinline__ int colmap1(int nphys) {
    const int pn = nphys >> 8, x = nphys & 255, bj = x >> 7, y = x & 127;
    if (pn < 8) return (bj ? OFF_CX : OFF_CC) + 128 * pn + y;
    if (pn < 12) return OFF_CB + 256 * (pn - 8) + x;
    if (pn < 18) { const int isk = pn >= 15, g = (pn - 12) % 3, wc = y >> 5, xx = y & 31; return (isk ? OFF_K : OFF_Q) + 256 * g + 64 * wc + 32 * bj + xx; }
    if (pn < 21) return OFF_V + 256 * (pn - 18) + x;
    return (bj ? OFF_GA : OFF_GC) + 128 * (pn - 21) + y;
}
struct Epi1 {
    static constexpr int MID_T = 0; static constexpr bool PF = false;
    bf16* U; bf16* CB; bf16* QG; bf16* KG; bf16* VG; bf16* SGC; bf16* RAT; const float* gq; const float* gk;
    __device__ __forceinline__ void mid(f32x4 (&)[2][2][4][2], const pg8::Unit&, int, int, int, int) const {}
    __device__ __forceinline__ void operator()(const f32x4 (&acc)[2][2][4][2], const pg8::Unit& u, int wr, int wc, int fr, int fq, LAS unsigned char* pf) const {
        const int pn = u.pn, row0 = u.pm * 256 + wr * 64 + fr;
        if (pn < 8) {
            const int col = 128 * pn + 32 * wc + 8 * fq;
#pragma unroll
            for (int ai = 0; ai < 2; ++ai)
#pragma unroll
                for (int m = 0; m < 4; ++m) { const int row = row0 + ai * 128 + m * 16;
                    NTST(U + (size_t)row * 1024 + col, pack8(acc[ai][0][m][0] * acc[ai][1][m][0], acc[ai][0][m][1] * acc[ai][1][m][1])); }
        } else if (pn < 12) {
            const int col = 256 * (pn - 8) + 32 * wc + 8 * fq;
#pragma unroll
            for (int ai = 0; ai < 2; ++ai)
#pragma unroll
                for (int m = 0; m < 4; ++m) { const int row = row0 + ai * 128 + m * 16;
#pragma unroll
                    for (int bj = 0; bj < 2; ++bj) NTST(CB + (size_t)row * 1024 + col + 128 * bj, pack8(acc[ai][bj][m][0], acc[ai][bj][m][1])); }
        } else if (pn < 18) {
            const bool isk = pn >= 15; const int g = (pn - 12) % 3;
            const float* gg = isk ? gk : gq; bf16* dst = (isk ? KG : QG) + (size_t)g * T_ * 256;
            f32x4 gv[2][2];
#pragma unroll
            for (int bj = 0; bj < 2; ++bj)
#pragma unroll
                for (int n = 0; n < 2; ++n) gv[bj][n] = *(const f32x4*)(gg + 32 * bj + 8 * fq + 4 * n);
            const float sc = isk ? 1.f : QSCALE;
#pragma unroll
            for (int ai = 0; ai < 2; ++ai)
#pragma unroll
                for (int m = 0; m < 4; ++m) {
                    float ss = 0.f;
#pragma unroll
                    for (int bj = 0; bj < 2; ++bj)
#pragma unroll
                        for (int n = 0; n < 2; ++n) { const f32x4 x = acc[ai][bj][m][n]; ss += (x[0] * x[0] + x[1] * x[1]) + (x[2] * x[2] + x[3] * x[3]); }
                    ss += __shfl_xor(ss, 16); ss += __shfl_xor(ss, 32);
                    const float rs = __builtin_amdgcn_rsqf(ss * (1.f / 64.f) + EPS) * sc;
                    const int drow = deint_row(g, row0 + ai * 128 + m * 16);
                    bf16* p = dst + ((size_t)wc * T_ + drow) * 64 + 8 * fq;
#pragma unroll
                    for (int bj = 0; bj < 2; ++bj) NTST(p + 32 * bj, pack8(acc[ai][bj][m][0] * gv[bj][0] * rs, acc[ai][bj][m][1] * gv[bj][1] * rs));
                }
        } else if (pn < 21) {
            const int g = pn - 18; bf16* dst = VG + (size_t)g * T_ * 256;
#pragma unroll
            for (int ai = 0; ai < 2; ++ai)
#pragma unroll
                for (int m = 0; m < 4; ++m) { const int drow = deint_row(g, row0 + ai * 128 + m * 16);
#pragma unroll
                    for (int bj = 0; bj < 2; ++bj) NTST(dst + ((size_t)(2 * bj + (wc >> 1)) * T_ + drow) * 64 + 32 * (wc & 1) + 8 * fq, pack8(acc[ai][bj][m][0], acc[ai][bj][m][1])); }
        } else {
            const int col = 128 * (pn - 21) + 32 * wc + 8 * fq;
#pragma unroll
            for (int ai = 0; ai < 2; ++ai)
#pragma unroll
                for (int m = 0; m < 4; ++m) { const int row = row0 + ai * 128 + m * 16;
                    f32x4 sc[2], rt[2];
                    const f32x2 one2 = {1.f, 1.f}, nl2 = {-LOG2E, -LOG2E};
#pragma unroll
                    for (int n = 0; n < 2; ++n)
#pragma unroll
                        for (int h = 0; h < 2; ++h) {
                            const f32x2 gc = {acc[ai][0][m][n][2 * h], acc[ai][0][m][n][2 * h + 1]}, ga = {acc[ai][1][m][n][2 * h], acc[ai][1][m][n][2 * h + 1]};
                            const f32x2 tc = gc * nl2, ta = ga * nl2; f32x2 ec, ea; ec.x = __builtin_amdgcn_exp2f(tc.x); ec.y = __builtin_amdgcn_exp2f(tc.y); ea.x = __builtin_amdgcn_exp2f(ta.x); ea.y = __builtin_amdgcn_exp2f(ta.y);
                            const f32x2 dc = ec + one2, da = ea + one2; f32x2 rc, ra; rc.x = __builtin_amdgcn_rcpf(dc.x); rc.y = __builtin_amdgcn_rcpf(dc.y); ra.x = __builtin_amdgcn_rcpf(da.x); ra.y = __builtin_amdgcn_rcpf(da.y);
                            const f32x2 rr = dc * ra;
                            sc[n][2 * h] = rc.x; sc[n][2 * h + 1] = rc.y; rt[n][2 * h] = rr.x; rt[n][2 * h + 1] = rr.y; }
                    NTST(SGC + (size_t)row * 1024 + col, pack8(sc[0], sc[1]));
                    NTST(RAT + (size_t)row * 1024 + col, pack8(rt[0], rt[1])); }
        }
    }
};

struct Epi2 {
    static constexpr int MID_T = 4; static constexpr bool PF = false;
    const bf16* SGC; const bf16* RAT; bf16* MERGED;
    __device__ __forceinline__ void mid(f32x4 (&acc)[2][2][4][2], const pg8::Unit& u, int wr, int wc, int fr, int fq) const {
        const int row0 = u.pm * 256 + wr * 64 + fr, col0 = u.pn * 256 + 32 * wc + 8 * fq;
        u32x4 rr[2][4][2];
#pragma unroll
        for (int ai = 0; ai < 2; ++ai)
#pragma unroll
            for (int m = 0; m < 4; ++m)
#pragma unroll
                for (int bj = 0; bj < 2; ++bj) rr[ai][m][bj] = *(const u32x4*)(RAT + (size_t)(row0 + ai * 128 + m * 16) * 1024 + col0 + 128 * bj);
#pragma unroll
        for (int ai = 0; ai < 2; ++ai)
#pragma unroll
            for (int m = 0; m < 4; ++m)
#pragma unroll
                for (int bj = 0; bj < 2; ++bj) { const u32x4 r = rr[ai][m][bj];
                    acc[ai][bj][m][0] *= (f32x4){bf_lo(r.x), bf_hi(r.x), bf_lo(r.y), bf_hi(r.y)}; acc[ai][bj][m][1] *= (f32x4){bf_lo(r.z), bf_hi(r.z), bf_lo(r.w), bf_hi(r.w)}; }
    }
    __device__ __forceinline__ void operator()(const f32x4 (&acc)[2][2][4][2], const pg8::Unit& u, int wr, int wc, int fr, int fq, LAS unsigned char* pf) const {
        const int row0 = u.pm * 256 + wr * 64 + fr, col0 = u.pn * 256 + 32 * wc + 8 * fq;
        u32x4 ss[2][4][2];
#pragma unroll
        for (int ai = 0; ai < 2; ++ai)
#pragma unroll
            for (int m = 0; m < 4; ++m)
#pragma unroll
                for (int bj = 0; bj < 2; ++bj) ss[ai][m][bj] = *(const u32x4*)(SGC + (size_t)(row0 + ai * 128 + m * 16) * 1024 + col0 + 128 * bj);
#pragma unroll
        for (int ai = 0; ai < 2; ++ai)
#pragma unroll
            for (int m = 0; m < 4; ++m)
#pragma unroll
                for (int bj = 0; bj < 2; ++bj) { const size_t off = (size_t)(row0 + ai * 128 + m * 16) * 1024 + col0 + 128 * bj; const u32x4 r = ss[ai][m][bj];
                    NTST(MERGED + off, pack8(acc[ai][bj][m][0] * (f32x4){bf_lo(r.x), bf_hi(r.x), bf_lo(r.y), bf_hi(r.y)}, acc[ai][bj][m][1] * (f32x4){bf_lo(r.z), bf_hi(r.z), bf_lo(r.w), bf_hi(r.w)})); }
    }
};

struct Epi3 {
    static constexpr int MID_T = 0; static constexpr bool PF = false;
    const float* X; bf16* X1B; const float* g2; unsigned char* XG;
    __device__ __forceinline__ void mid(f32x4 (&)[2][2][4][2], const pg8::Unit&, int, int, int, int) const {}
    __device__ __forceinline__ void operator()(const f32x4 (&acc)[2][2][4][2], const pg8::Unit& u, int wr, int wc, int fr, int fq, LAS unsigned char* pf) const {
        const int row0 = u.pm * 256 + wr * 64 + fr, col0 = u.pn * 256 + 32 * wc + 8 * fq;
        f32x4 gv[2][2];
#pragma unroll
        for (int bj = 0; bj < 2; ++bj)
#pragma unroll
            for (int n = 0; n < 2; ++n) gv[bj][n] = *(const f32x4*)(g2 + col0 + 128 * bj + 4 * n);
        const bool odd = (fq & 1) != 0; const int colw = u.pn * 256 + 32 * wc + 16 * (fq >> 1);
#pragma unroll
        for (int ai = 0; ai < 2; ++ai) {
            f32x4 xv[4][2][2];
#pragma unroll
            for (int m = 0; m < 4; ++m)
#pragma unroll
                for (int bj = 0; bj < 2; ++bj) { const size_t off = (size_t)(row0 + ai * 128 + m * 16) * 1024 + col0 + 128 * bj; xv[m][bj][0] = *(const f32x4*)(X + off); xv[m][bj][1] = *(const f32x4*)(X + off + 4); }
#pragma unroll
            for (int mp = 0; mp < 2; ++mp)
#pragma unroll
                for (int bj = 0; bj < 2; ++bj) { u32x2 pc[2];
#pragma unroll
                    for (int mm = 0; mm < 2; ++mm) { const int m = 2 * mp + mm; const size_t off = (size_t)(row0 + ai * 128 + m * 16) * 1024 + col0 + 128 * bj;
                        const f32x4 x0 = xv[m][bj][0] + acc[ai][bj][m][0], x1 = xv[m][bj][1] + acc[ai][bj][m][1];
                        NTST(X1B + off, pack8(x0, x1));
                        const f32x4 y0 = x0 * gv[bj][0], y1 = x1 * gv[bj][1]; pc[mm].x = pk4_fp8(clamp_fp8(y0[0]), clamp_fp8(y0[1]), clamp_fp8(y0[2]), clamp_fp8(y0[3])); pc[mm].y = pk4_fp8(clamp_fp8(y1[0]), clamp_fp8(y1[1]), clamp_fp8(y1[2]), clamp_fp8(y1[3])); }
                    const u32x4 w16 = fp8_pair16(pc[0], pc[1], odd);
                    NTST(XG + (size_t)(row0 + ai * 128 + (2 * mp + (odd ? 1 : 0)) * 16) * 1024 + colw + 128 * bj, w16); }
        }
    }
};

struct EpiGU {
    static constexpr int MID_T = 0; static constexpr bool PF = true;
    __device__ __forceinline__ void prefetch(const pg8::Unit& u, LAS unsigned char* pf, int wid, int lane) const {
        if (wid == 0) { const float* src = bgu + (size_t)u.e * 2048 + 128 * u.pn + (lane < 32 ? 4 * lane : 1024 + 4 * (lane - 32)); __builtin_amdgcn_global_load_lds((const unsigned*)src, (LAS unsigned*)pf, 16, 0, 0); }
        else if (wid == 1) { const float* src = RS + (size_t)u.e * T_ + u.rows + 4 * lane; __builtin_amdgcn_global_load_lds((const unsigned*)src, (LAS unsigned*)(pf + 1024), 16, 0, 0); }
    }
    unsigned char* ACT; const float* bgu; const float* RS; const LAS int* cnt;
    __device__ __forceinline__ void mid(f32x4 (&)[2][2][4][2], const pg8::Unit&, int, int, int, int) const {}
    __device__ __forceinline__ void operator()(const f32x4 (&acc)[2][2][4][2], const pg8::Unit& u, int wr, int wc, int fr, int fq, LAS unsigned char* pf) const {
        const int row0 = u.pm * 256 + wr * 64 + fr, col = 128 * u.pn + 32 * wc + 8 * fq;
        const LAS float* pb = (const LAS float*)pf + 32 * wc + 8 * fq;
        f32x4 bgate[2], bup[2];
#pragma unroll
        for (int n = 0; n < 2; ++n) { bgate[n] = *(const LAS f32x4*)(pb + 4 * n); bup[n] = *(const LAS f32x4*)(pb + 128 + 4 * n); }
        const int ce = cnt[u.e]; const bool odd = (fq & 1) != 0; const int colw = 128 * u.pn + 32 * wc + 16 * (fq >> 1);
        float rsv[2][4];
#pragma unroll
        for (int ai = 0; ai < 2; ++ai)
#pragma unroll
            for (int m = 0; m < 4; ++m) { const int tr = ai * 128 + wr * 64 + m * 16 + fr; const float v = ((const LAS float*)(pf + 1024))[tr]; rsv[ai][m] = (u.rows + tr < ce) ? v * (1.f / 32.f) : 0.f; }
        const f32x2 one2 = {1.f, 1.f}, k2 = {-1.702f * LOG2E, -1.702f * LOG2E};
#pragma unroll
        for (int ai = 0; ai < 2; ++ai)
#pragma unroll
            for (int mp = 0; mp < 2; ++mp) { u32x2 pc[2];
#pragma unroll
                for (int mm = 0; mm < 2; ++mm) { const int m = 2 * mp + mm; f32x2 o[2][2];
                    const f32x2 rs2 = {rsv[ai][m], rsv[ai][m]};
#pragma unroll
                    for (int n = 0; n < 2; ++n)
#pragma unroll
                        for (int h = 0; h < 2; ++h) {
                            const f32x2 ga = {acc[ai][0][m][n][2 * h], acc[ai][0][m][n][2 * h + 1]}, ua = {acc[ai][1][m][n][2 * h], acc[ai][1][m][n][2 * h + 1]};
                            const f32x2 bg = {bgate[n][2 * h], bgate[n][2 * h + 1]}, bu = {bup[n][2 * h], bup[n][2 * h + 1]};
                            f32x2 gt = ga * rs2 + bg; gt.x = fminf(gt.x, 7.f); gt.y = fminf(gt.y, 7.f);
                            f32x2 up = ua * rs2 + bu; up.x = __builtin_amdgcn_fmed3f(up.x, -7.f, 7.f); up.y = __builtin_amdgcn_fmed3f(up.y, -7.f, 7.f);
                            const f32x2 t = gt * k2; f32x2 ex; ex.x = __builtin_amdgcn_exp2f(t.x); ex.y = __builtin_amdgcn_exp2f(t.y);
                            const f32x2 d = ex + one2; f32x2 r; r.x = __builtin_amdgcn_rcpf(d.x); r.y = __builtin_amdgcn_rcpf(d.y);
                            o[n][h] = ((up + one2) * gt) * r; }
                    pc[mm].x = pk4_fp8(o[0][0].x, o[0][0].y, o[0][1].x, o[0][1].y); pc[mm].y = pk4_fp8(o[1][0].x, o[1][0].y, o[1][1].x, o[1][1].y); }
                const u32x4 w16 = fp8_pair16(pc[0], pc[1], odd);
                NTST(ACT + (size_t)(row0 + ai * 128 + (2 * mp + (odd ? 1 : 0)) * 16) * 1024 + colw, w16); }
    }
};
struct EpiDN {
    static constexpr int MID_T = 0; static constexpr bool PF = true;
    __device__ __forceinline__ void prefetch(const pg8::Unit& u, LAS unsigned char* pf, int wid, int lane) const {
        if (wid == 0) { const float* src = bd + (size_t)u.e * 1024 + 256 * u.pn + 4 * lane; __builtin_amdgcn_global_load_lds((const unsigned*)src, (LAS unsigned*)pf, 16, 0, 0); }
    }
    unsigned char* YS; const float* bd;
    __device__ __forceinline__ void mid(f32x4 (&)[2][2][4][2], const pg8::Unit&, int, int, int, int) const {}
    __device__ __forceinline__ void operator()(const f32x4 (&acc)[2][2][4][2], const pg8::Unit& u, int wr, int wc, int fr, int fq, LAS unsigned char* pf) const {
        const int row0 = u.pm * 256 + wr * 64 + fr, col0 = 256 * u.pn + 32 * wc + 8 * fq;
        const LAS float* bb = (const LAS float*)pf + 32 * wc + 8 * fq;
        f32x4 bv[2][2];
#pragma unroll
        for (int bj = 0; bj < 2; ++bj)
#pragma unroll
            for (int n = 0; n < 2; ++n) bv[bj][n] = *(const LAS f32x4*)(bb + 128 * bj + 4 * n);
        const bool odd = (fq & 1) != 0; const int colw = 256 * u.pn + 32 * wc + 16 * (fq >> 1);
#pragma unroll
        for (int ai = 0; ai < 2; ++ai)
#pragma unroll
            for (int mp = 0; mp < 2; ++mp)
#pragma unroll
                for (int bj = 0; bj < 2; ++bj) { u32x2 pc[2];
#pragma unroll
                    for (int mm = 0; mm < 2; ++mm) { const int m = 2 * mp + mm; const f32x4 y0 = acc[ai][bj][m][0] * (1.f / 32.f) + bv[bj][0], y1 = acc[ai][bj][m][1] * (1.f / 32.f) + bv[bj][1];
                        pc[mm].x = pk4_fp8(clamp_fp8(y0[0]), clamp_fp8(y0[1]), clamp_fp8(y0[2]), clamp_fp8(y0[3])); pc[mm].y = pk4_fp8(clamp_fp8(y1[0]), clamp_fp8(y1[1]), clamp_fp8(y1[2]), clamp_fp8(y1[3])); }
                    const u32x4 w16 = fp8_pair16(pc[0], pc[1], odd);
                    NTST(YS + (size_t)(row0 + ai * 128 + (2 * mp + (odd ? 1 : 0)) * 16) * 1024 + colw + 128 * bj, w16); }
    }
};
namespace attn {
constexpr int KROW = 144;
constexpr int LDS_K = 0, LDS_V = 256 * KROW, LDS_BIAS = 2 * 256 * KROW, BIAS_STRIDE = 132;
constexpr int LDS_END = LDS_BIAS + 12 * BIAS_STRIDE * 4;
typedef short v4i16_t __attribute__((ext_vector_type(4)));
__device__ __forceinline__ s16x4 vtr(const LAS unsigned char* p) { return __builtin_bit_cast(s16x4, __builtin_amdgcn_ds_read_tr16_b64_v4i16((LAS v4i16_t*)p)); }

struct Pre { u32x4 k[4], v[4]; bf16x8 q0, q1; };
struct ItemP { int g, q, j; bool hasprev; };
__device__ __forceinline__ ItemP decode(int it) { ItemP p; p.j = it & 3; p.q = (it >> 2) & 127; p.g = it >> 9; const int nbm1 = (p.g == 0) ? 15 : (p.g == 1 ? 3 : 0); p.hasprev = (p.q & nbm1) != 0; return p; }
__device__ __forceinline__ void issue(Pre& P, const ItemP& I, const bf16* QG, const bf16* KG, const bf16* VG, int tid, int lane, int wave) {
    const size_t gofs = (size_t)I.g * T_ * 256 + (size_t)I.j * T_ * 64;
    const bf16* Kg = KG + gofs; const bf16* Vg = VG + gofs; const bf16* Qg = QG + gofs;
    const int R0 = 128 * (I.q - 1), klo = I.hasprev ? 0 : 128;
#pragma unroll
    for (int it = 0; it < 4; ++it) {
        const int c = tid + it * 512, r = c >> 3, ch = c & 7;
        if (r >= klo) { P.k[it] = *(const u32x4*)(Kg + (size_t)(R0 + r) * 64 + ch * 8); P.v[it] = *(const u32x4*)(Vg + (size_t)(R0 + r) * 64 + ch * 8); }
    }
    const int ql = lane & 15, quad = lane >> 4, qi = 16 * wave + ql;
    const bf16* qp = Qg + (size_t)(128 * I.q + qi) * 64 + 8 * quad;
    P.q0 = *(const bf16x8*)(qp); P.q1 = *(const bf16x8*)(qp + 32);
}
__device__ __forceinline__ void commit(const Pre& P, const ItemP& I, LAS unsigned char* lds, int tid) {
    const int klo = I.hasprev ? 0 : 128;
#pragma unroll
    for (int it = 0; it < 4; ++it) {
        const int c = tid + it * 512, r = c >> 3, ch = c & 7;
        if (r >= klo) { *(LAS u32x4*)(lds + LDS_K + r * KROW + ch * 16) = P.k[it]; *(LAS u32x4*)(lds + LDS_V + r * KROW + ch * 16) = P.v[it]; }
    }
}
__device__ __forceinline__ void compute(LAS unsigned char* lds, const ItemP& I, const bf16x8 qf0, const bf16x8 qf1, bf16* OG, float* LSE, int lane, int wave) {
    const int g = I.g, q = I.q, j = I.j; const bool hasprev = I.hasprev;
    const int ql = lane & 15, quad = lane >> 4;
    const int qi = 16 * wave + ql;
    const LAS float* bias = (const LAS float*)(lds + LDS_BIAS) + (g * 4 + j) * BIAS_STRIDE;
    float m = -1e30f, l = 0.f;
    f32x4 o[4];
#pragma unroll
    for (int dt = 0; dt < 4; ++dt) o[dt] = (f32x4){0.f, 0.f, 0.f, 0.f};
    const int s_lo = hasprev ? (wave >> 1) : 4, s_hi = (wave >> 1) + 4;
    const LAS unsigned char* kbase = lds + LDS_K + ql * KROW + quad * 16;
    const LAS unsigned char* vbase = lds + LDS_V + (4 * quad + (ql >> 2)) * KROW + (ql & 3) * 8;
    for (int s = s_lo; s <= s_hi; ++s) {
        const LAS unsigned char* kp = kbase + 32 * s * KROW;
        const bf16x8 k00 = *(const LAS bf16x8*)(kp), k01 = *(const LAS bf16x8*)(kp + 64);
        const bf16x8 k10 = *(const LAS bf16x8*)(kp + 16 * KROW), k11 = *(const LAS bf16x8*)(kp + 16 * KROW + 64);
        f32x4 c0 = (f32x4){0.f, 0.f, 0.f, 0.f}, c1 = (f32x4){0.f, 0.f, 0.f, 0.f};
        c0 = __builtin_amdgcn_mfma_f32_16x16x32_bf16(k00, qf0, c0, 0, 0, 0);
        c0 = __builtin_amdgcn_mfma_f32_16x16x32_bf16(k01, qf1, c0, 0, 0, 0);
        c1 = __builtin_amdgcn_mfma_f32_16x16x32_bf16(k10, qf0, c1, 0, 0, 0);
        c1 = __builtin_amdgcn_mfma_f32_16x16x32_bf16(k11, qf1, c1, 0, 0, 0);
        float mx = -INFINITY;
#pragma unroll
        for (int i = 0; i < 4; ++i) {
            const int kj0 = 32 * s + 4 * quad + i, d0 = qi + 128 - kj0, d1 = d0 - 16;
            const bool v0 = (d0 >= 0) && (d0 <= 128) && (hasprev || kj0 >= 128);
            const bool v1 = (d1 >= 0) && (d1 <= 128) && (hasprev || kj0 + 16 >= 128);
            const float b0 = bias[min(max(d0, 0), 128)], b1 = bias[min(max(d1, 0), 128)];
            c0[i] = v0 ? c0[i] + b0 : -INFINITY; c1[i] = v1 ? c1[i] + b1 : -INFINITY;
            mx = fmaxf(mx, fmaxf(c0[i], c1[i]));
        }
        mx = fmaxf(mx, __shfl_xor(mx, 16)); mx = fmaxf(mx, __shfl_xor(mx, 32));
        const float mn = fmaxf(m, mx), alpha = __builtin_amdgcn_exp2f(m - mn);
        m = mn;
        float ps = 0.f;
#pragma unroll
        for (int i = 0; i < 4; ++i) { c0[i] = __builtin_amdgcn_exp2f(c0[i] - mn); c1[i] = __builtin_amdgcn_exp2f(c1[i] - mn); ps += c0[i] + c1[i]; }
        l = l * alpha + ps;
        u32x4 pw; pw.x = pk2(c0[0], c0[1]); pw.y = pk2(c0[2], c0[3]); pw.z = pk2(c1[0], c1[1]); pw.w = pk2(c1[2], c1[3]);
        const bf16x8 pf = __builtin_bit_cast(bf16x8, pw);
        const LAS unsigned char* vp = vbase + 32 * s * KROW;
#pragma unroll
        for (int dt = 0; dt < 4; ++dt) {
            const s16x4 lo = vtr(vp + dt * 32), hi = vtr(vp + dt * 32 + 16 * KROW);
            const bf16x8 vf = (bf16x8){lo[0], lo[1], lo[2], lo[3], hi[0], hi[1], hi[2], hi[3]};
            o[dt] = o[dt] * alpha;
            o[dt] = __builtin_amdgcn_mfma_f32_16x16x32_bf16(vf, pf, o[dt], 0, 0, 0);
        }
    }
    l += __shfl_xor(l, 16); l += __shfl_xor(l, 32);
    const float inv = __builtin_amdgcn_rcpf(l);
    const int tok = reint_row(g, 128 * q + qi);
    bf16* op = OG + (size_t)g * T_ * 256 + (size_t)tok * 256 + j * 64 + 4 * quad;
#pragma unroll
    for (int dt = 0; dt < 4; ++dt) { u32x2 w; w.x = pk2(o[dt][0] * inv, o[dt][1] * inv); w.y = pk2(o[dt][2] * inv, o[dt][3] * inv); *(u32x2*)(op + 16 * dt) = w; }
    if (quad == 0) LSE[(size_t)g * T_ * 4 + tok * 4 + j] = m + __builtin_amdgcn_logf(l);
}
__device__ __forceinline__ void run(LAS unsigned char* lds, int first, int stride, int nitems, const bf16* QG, const bf16* KG, const bf16* VG, bf16* OG, float* LSE, int tid, int lane, int wave) {
    if (first >= nitems) return;
    Pre P; ItemP I = decode(first);
    issue(P, I, QG, KG, VG, tid, lane, wave);
    for (int it = first; it < nitems; it += stride) {
        commit(P, I, lds, tid);
        const bf16x8 q0 = P.q0, q1 = P.q1; const ItemP C = I;
        __syncthreads();
        if (it + stride < nitems) { I = decode(it + stride); issue(P, I, QG, KG, VG, tid, lane, wave); }
        compute(lds, C, q0, q1, OG, LSE, lane, wave);
        __syncthreads();
    }
}
}
constexpr int NWAVES = 8;
constexpr size_t MiB = 1u << 20;
constexpr size_t WS_CTL = 0, CTL_ZERO_BYTES = 256 * 1024;
constexpr size_t WS_WT1 = 2 * MiB;
constexpr size_t WS_WT2 = 17 * MiB;
constexpr size_t WS_WT3 = 20 * MiB;
constexpr size_t WS_WGU = 24 * MiB;
constexpr size_t WS_WD = 152 * MiB;
constexpr size_t WS_H = 216 * MiB;
constexpr size_t WS_U = 248 * MiB;
constexpr size_t WS_CB = 280 * MiB;
constexpr size_t WS_QG = 312 * MiB, WS_KG = 336 * MiB, WS_VG = 360 * MiB;
constexpr size_t WS_SGC = 384 * MiB, WS_RAT = 416 * MiB;
constexpr size_t WS_OG = 448 * MiB;
constexpr size_t WS_LSE = 472 * MiB;
constexpr size_t WS_A2 = 474 * MiB;
constexpr size_t WS_MERGED = 514 * MiB;
constexpr size_t WS_ACT = 546 * MiB;
constexpr size_t WS_YS = 690 * MiB;
constexpr size_t WS_LISTS = 834 * MiB;
constexpr size_t WS_TOKE = 836 * MiB, WS_TOKS = WS_TOKE + 256 * 1024, WS_TOKW = WS_TOKS + 256 * 1024;
constexpr size_t WS_BIAS2 = 837 * MiB;
constexpr size_t WS_WRI = 837 * MiB + 65536;
constexpr size_t WS_RS = 838 * MiB;
constexpr size_t WS_END = 840 * MiB;
constexpr int CW_TMO = 0, CW_BAR = 4096, CW_CNT = 8192;
constexpr int RING_OFF = 0, RING_BYTES = 131072;
constexpr int LDSCTL_OFF = 153600, MISC_OFF = LDSCTL_OFF + 320;
constexpr int LDS_TOK = MISC_OFF + 128;
constexpr int LDS_BYTES = 163840;
constexpr int WRS = 1032, WRI_BYTES = 2 * 32 * WRS * 2;
constexpr int LDS_RX = 135168;

__device__ unsigned g_ctl[16384];
constexpr int CW_DONE = 12288;
typedef GAS unsigned gu32;
#define RLX_AGENT __ATOMIC_RELAXED, __HIP_MEMORY_SCOPE_AGENT
#define LDS_WAIT() asm volatile("s_waitcnt lgkmcnt(0)" ::: "memory")
#define VM_WAIT() asm volatile("s_waitcnt vmcnt(0)" ::: "memory")

#define XB_TMO      128
#define XB_XCNT(j)  (256  + 64 * (j))
#define XB_XSUB(j)  (1280 + 64 * (j))
#define XB_XGEN(j)  (2304 + 64 * (j))
#define XB_TOP      3328
#define XB_TOPGEN   3392
#define XCD_BAR_WORDS 3456
#define XB_SPIN_CAP (1u << 18)
__device__ __forceinline__ unsigned xb_ld(unsigned* p)              { return __hip_atomic_load(p, __ATOMIC_RELAXED, __HIP_MEMORY_SCOPE_AGENT); }
__device__ __forceinline__ unsigned xb_add(unsigned* p, unsigned v) { return __hip_atomic_fetch_add(p, v, __ATOMIC_RELAXED, __HIP_MEMORY_SCOPE_AGENT); }
__device__ __forceinline__ unsigned xb_xcc_id() { return (unsigned)__builtin_amdgcn_s_getreg((3 << 11) | 20) & 0xFu; }
#define XB_SPIN(cond, bar) do { unsigned _sp = 0; while (cond) { __builtin_amdgcn_s_sleep(1); \
    if ((++_sp & 255u) == 0u) { if (xb_ld(&(bar)[XB_TMO])) break; if (_sp > XB_SPIN_CAP) { atomicAdd(&(bar)[XB_TMO], 1u); break; } } } } while (0)
struct XcdBarrier { unsigned* bar; unsigned x; volatile LAS unsigned* st; };
__device__ __forceinline__ XcdBarrier xcd_barrier_post(unsigned* bar, volatile LAS unsigned* st) {
    XcdBarrier b; b.bar = bar; b.x = xb_xcc_id(); b.st = st;
    if (threadIdx.x == 0) (void)xb_add(&bar[XB_XCNT(b.x)], 1u);
    return b;
}
__device__ __forceinline__ void xcd_barrier_complete(unsigned* bar, unsigned x, unsigned& nloc, unsigned& nx) {
    const unsigned G = gridDim.x * gridDim.y * gridDim.z;
    unsigned sum, cnt, mine, sp = 0u;
    for (;;) {
        sum = 0u; cnt = 0u; mine = 0u;
#pragma unroll
        for (unsigned j = 0; j < 16; ++j) { const unsigned c = xb_ld(&bar[XB_XCNT(j)]); sum += c; cnt += (c > 0u) ? 1u : 0u; mine = (j == x) ? c : mine; }
        if (sum == G) break;
        __builtin_amdgcn_s_sleep(1);
        if ((++sp & 255u) == 0u) { if (xb_ld(&bar[XB_TMO])) break; if (sp > XB_SPIN_CAP) { atomicAdd(&bar[XB_TMO], 1u); break; } }
    }
    nloc = mine > 0u ? mine : 1u; nx = cnt > 0u ? cnt : 1u;
}
__device__ __forceinline__ void xcd_barrier(const XcdBarrier& b) {
    asm volatile("s_waitcnt vmcnt(0)" ::: "memory");
    __syncthreads();
    if (threadIdx.x == 0) {
        unsigned* bar = b.bar;
        __builtin_amdgcn_s_waitcnt(0);
        unsigned nloc = b.st[0], nx = b.st[1];
        if (nloc == 0u) { xcd_barrier_complete(bar, b.x, nloc, nx); b.st[0] = nloc; b.st[1] = nx; }
        const unsigned old = xb_add(&bar[XB_XSUB(b.x)], 1u);
        const unsigned gen = old / nloc;
        if (old + 1u == (gen + 1u) * nloc) {
            __builtin_amdgcn_fence(__ATOMIC_RELEASE, "agent");
            asm volatile("s_waitcnt vmcnt(0)" ::: "memory");
            const unsigned og = xb_add(&bar[XB_TOP], 1u);
            const unsigned tg = og / nx;
            if (og + 1u == (tg + 1u) * nx) xb_add(&bar[XB_TOPGEN], 1u);
            else XB_SPIN(xb_ld(&bar[XB_TOPGEN]) == tg, bar);
            __builtin_amdgcn_fence(__ATOMIC_ACQUIRE, "agent");
            xb_add(&bar[XB_XGEN(b.x)], 1u);
            asm volatile("s_waitcnt vmcnt(0)" ::: "memory");
        } else {
            XB_SPIN(xb_ld(&bar[XB_XGEN(b.x)]) == gen, bar);
            __builtin_amdgcn_fence(__ATOMIC_ACQUIRE, "agent");
            asm volatile("s_waitcnt vmcnt(0)" ::: "memory");
        }
    }
    __syncthreads();
}

struct Frame {
    LAS unsigned char* lds; volatile LAS unsigned* MISC; gu32* ctl;
    int tid, lane, wave, vcu, G;
    const float *x, *n1g, *w_in, *gq, *gk, *relb, *convw, *w_bc, *w_ba, *w_out, *n2g, *w_r, *b_r, *w_gu, *b_gu, *w_d, *b_d; float* out;
    GAS unsigned char* ws;
#define FP(name, type, off) __device__ __forceinline__ type* name() const { return (type*)(ws + (off)); }
    FP(WT1, bf16, WS_WT1) FP(WT2, bf16, WS_WT2) FP(WT3, bf16, WS_WT3) FP(WGU, bf16, WS_WGU) FP(WD, bf16, WS_WD) FP(H, bf16, WS_H) FP(U, bf16, WS_U) FP(CB, bf16, WS_CB)
    FP(QG, bf16, WS_QG) FP(KG, bf16, WS_KG) FP(VG, bf16, WS_VG) FP(SGC, bf16, WS_SGC) FP(RAT, bf16, WS_RAT) FP(OG, bf16, WS_OG) FP(A2, bf16, WS_A2) FP(MERGED, bf16, WS_MERGED)
    FP(ACT, bf16, WS_ACT) FP(YS, bf16, WS_YS) FP(LSE, float, WS_LSE) FP(BIAS2, float, WS_BIAS2) FP(TOKW, float, WS_TOKW) FP(RS, float, WS_RS) FP(LISTS, int, WS_LISTS) FP(TOKE, int, WS_TOKE)
    FP(TOKS, int, WS_TOKS) FP(WRI, bf16, WS_WRI) FP(X1B, bf16, WS_U)
    __device__ __forceinline__ int* CNT() const { return (int*)g_ctl + CW_CNT; }
#undef FP
};
__device__ __forceinline__ float wave_sum(float v) {
#pragma unroll
    for (int o = 1; o < 64; o <<= 1) v += __shfl_xor(v, o);
    return v;
}
__device__ __forceinline__ float wave_max(float v) {
#pragma unroll
    for (int o = 1; o < 64; o <<= 1) v = fmaxf(v, __shfl_xor(v, o));
    return v;
}

struct P0Item { const float* src; int ldw; unsigned char* dst; int ldt; bool fp8; };
__device__ __forceinline__ void p0_load(const P0Item& I, f32x4 (&v)[8], int lane) {
    const float* s = I.src + (size_t)(lane >> 3) * I.ldw + 4 * (lane & 7);
#pragma unroll
    for (int i = 0; i < 8; ++i) v[i] = __builtin_nontemporal_load((const f32x4*)(s + (size_t)(8 * i) * I.ldw));
}
__device__ __forceinline__ void p0_finish(const P0Item& I, const f32x4 (&v)[8], LAS float* scr, int lane) {
    const float sc = I.fp8 ? 32.f : 1.f;
    { LAS float* w = scr + (4 * (lane & 7)) * 65 + (lane >> 3);
#pragma unroll
      for (int i = 0; i < 8; ++i) { const f32x4 x = v[i] * sc; w[0 * 65 + 8 * i] = x[0]; w[1 * 65 + 8 * i] = x[1]; w[2 * 65 + 8 * i] = x[2]; w[3 * 65 + 8 * i] = x[3]; } }
    LDS_WAIT(); asm volatile("" ::: "memory");
    const int c = lane & 7;
#pragma unroll
    for (int j = 0; j < 4; ++j) { const int n = (lane >> 3) + 8 * j; const LAS float* s = scr + n * 65 + 8 * c;
        if (I.fp8) { u32x2 o; o.x = pk4_fp8(clamp_fp8(s[0]), clamp_fp8(s[1]), clamp_fp8(s[2]), clamp_fp8(s[3])); o.y = pk4_fp8(clamp_fp8(s[4]), clamp_fp8(s[5]), clamp_fp8(s[6]), clamp_fp8(s[7]));
            *(GAS u32x2*)(I.dst + (size_t)n * I.ldt + 8 * c) = o; }
        else { u32x4 o; o.x = pk2(s[0], s[1]); o.y = pk2(s[2], s[3]); o.z = pk2(s[4], s[5]); o.w = pk2(s[6], s[7]);
            *(GAS u32x4*)(I.dst + ((size_t)n * I.ldt + 8 * c) * 2) = o; } }
    LDS_WAIT(); asm volatile("" ::: "memory");
}
__device__ __forceinline__ void rms_row_to_bf16(const float* xrow, const float* g, bf16* orow, int lane) {
    const GAS f32x4* xr = (const GAS f32x4*)xrow + lane; const GAS f32x4* gr = (const GAS f32x4*)g + lane;
    f32x4 v[4]; float s2 = 0.f;
#pragma unroll
    for (int j = 0; j < 4; ++j) { v[j] = xr[64 * j]; s2 += (v[j].x * v[j].x + v[j].y * v[j].y) + (v[j].z * v[j].z + v[j].w * v[j].w); }
    const float rstd = 1.f / sqrtf(wave_sum(s2) * (1.f / D_) + EPS);
    GAS unsigned long long* o8 = (GAS unsigned long long*)orow + lane;
#pragma unroll
    for (int j = 0; j < 4; ++j) { const f32x4 gg = gr[64 * j]; o8[64 * j] = (unsigned long long)pk2(v[j].x * rstd * gg.x, v[j].y * rstd * gg.y) | ((unsigned long long)pk2(v[j].z * rstd * gg.z, v[j].w * rstd * gg.w) << 32); }
}
constexpr int P0_I1 = (INW / 32) * 16, P0_I2A = 32 * 4, P0_I2B = 32 * 16, P0_I3 = 32 * 16, P0_I4 = NE * 64 * 16, P0_I5 = NE * 32 * 16;
constexpr int P0_NITEMS = P0_I1 + P0_I2A + P0_I2B + P0_I3 + P0_I4 + P0_I5;
#ifndef P0_D7
#define P0_D7 4500
#endif
constexpr int P0_DEFER7 = P0_D7;
#ifndef P1_ROUNDS
#define P1_ROUNDS 10
#endif
#ifndef P0_D1
#define P0_D1 45804
#endif
constexpr int P0_DEFER1 = P0_D1;
constexpr int P0_N0 = P0_NITEMS - P0_DEFER1 - P0_DEFER7;
static_assert(P0_DEFER7 <= P0_I5 && P0_N0 >= P0_I1, "P0 itself converts at least w_in (needed by GEMM1); W_down items only for the gate_up phase's idle CUs");
__device__ __forceinline__ P0Item p0_decode(Frame& F, int it) {
    P0Item I; int r = it;
    if (r < P0_I1) { const int gb = r >> 4, kb = r & 15; I.src = F.w_in + (size_t)(64 * kb) * INW + colmap1(32 * gb); I.ldw = INW; I.dst = (unsigned char*)(F.WT1() + (size_t)(32 * gb) * 1024 + 64 * kb); I.ldt = 1024; I.fp8 = false; return I; } r -= P0_I1;
    if (r < P0_I2A) { const int gb = r >> 2, kb = r & 3; I.src = F.w_ba + (size_t)(64 * kb) * 1024 + 32 * gb; I.ldw = 1024; I.dst = (unsigned char*)(F.WT2() + (size_t)(32 * gb) * K2 + 64 * kb); I.ldt = K2; I.fp8 = false; return I; } r -= P0_I2A;
    if (r < P0_I2B) { const int gb = r >> 4, kb = r & 15; I.src = F.w_bc + (size_t)(64 * kb) * 1024 + 32 * gb; I.ldw = 1024; I.dst = (unsigned char*)(F.WT2() + (size_t)(32 * gb) * K2 + 256 + 64 * kb); I.ldt = K2; I.fp8 = false; return I; } r -= P0_I2B;
    if (r < P0_I3) { const int gb = r >> 4, kb = r & 15; I.src = F.w_out + (size_t)(64 * kb) * 1024 + 32 * gb; I.ldw = 1024; I.dst = (unsigned char*)(F.WT3() + (size_t)(32 * gb) * 1024 + 64 * kb); I.ldt = 1024; I.fp8 = false; return I; } r -= P0_I3;
    if (r < P0_I4) { const int e = r >> 10, gb = (r >> 4) & 63, kb = r & 15; const int nphys = 32 * gb, pn = nphys >> 8, bj = (nphys >> 7) & 1, y = nphys & 127;
        I.src = F.w_gu + (size_t)e * 1024 * 2048 + (size_t)(64 * kb) * 2048 + (bj ? 1024 : 0) + 128 * pn + y; I.ldw = 2048;
        I.dst = (unsigned char*)F.WGU() + (size_t)e * 2048 * 1024 + (size_t)nphys * 1024 + 64 * kb; I.ldt = 1024; I.fp8 = true; return I; } r -= P0_I4;
    { const int e = r >> 9, gb = (r >> 4) & 31, kb = r & 15;
        I.src = F.w_d + (size_t)e * 1024 * 1024 + (size_t)(64 * kb) * 1024 + 32 * gb; I.ldw = 1024;
        I.dst = (unsigned char*)F.WD() + (size_t)e * 1024 * 1024 + (size_t)(32 * gb) * 1024 + 64 * kb; I.ldt = 1024; I.fp8 = true; return I; }
}
__device__ __forceinline__ void p0_items(Frame& F, int lo, int hi, int w, int nw) {
    LAS float* scr = (LAS float*)(F.lds + RING_OFF + F.wave * 16384);
    int it = lo + w; if (it >= hi) return;
    f32x4 va[8], vb[8];
    P0Item Ia = p0_decode(F, it), Ib = Ia;
    p0_load(Ia, va, F.lane);
    for (;;) {
        const bool hb = (it + nw) < hi;
        if (hb) { Ib = p0_decode(F, it + nw); p0_load(Ib, vb, F.lane); }
        p0_finish(Ia, va, scr, F.lane);
        if (!hb) break;
        it += nw;
        const bool ha = (it + nw) < hi;
        if (ha) { Ia = p0_decode(F, it + nw); p0_load(Ia, va, F.lane); }
        p0_finish(Ib, vb, scr, F.lane);
        if (!ha) break;
        it += nw;
    }
}
__device__ __forceinline__ void p0_prologue(Frame& F) {
    const int gw = F.vcu * NWAVES + F.wave, NGW = F.G * NWAVES;
    p0_items(F, 0, P0_N0, gw, NGW);
    for (int m = gw; m < T_; m += NGW) rms_row_to_bf16(F.x + (size_t)m * D_, F.n1g, F.H() + (size_t)m * D_, F.lane);
    for (int i = gw * 64 + F.lane; i < 32 * 1024; i += NGW * 64) {
        const int k = i >> 5, e = i & 31; const float w = F.n2g[k] * F.w_r[i];
        const unsigned h = pk2(w, 0.f) & 0xffffu; const float r = w - bf_lo(h);
        F.WRI()[e * WRS + k] = (bf16)h; F.WRI()[32 * WRS + e * WRS + k] = (bf16)(pk2(r, 0.f) & 0xffffu);
    }
    if (blockIdx.x == 0) {
        for (int i = F.tid; i < 12 * 129; i += NWAVES * 64) {
            const int hh = i / 129, dl = i % 129, g = hh >> 2, dil = (g == 0) ? 1 : (g == 1 ? 4 : 16), dist = dl * dil;
            int b;
            if (dist < 16) b = dist; else { const double xx = log((double)dist / 16.0) / log(128.0) * 16.0; b = 16 + (int)xx; if (b > 31) b = 31; }
            F.BIAS2()[hh * attn::BIAS_STRIDE + dl] = F.relb[b * 12 + hh] * LOG2E;
        }
    }
}

__device__ __forceinline__ void p2_attn_conv(Frame& F) {
    LAS unsigned char* lds = F.lds + RING_OFF;
    for (int i = F.tid; i < 12 * attn::BIAS_STRIDE; i += NWAVES * 64) ((LAS float*)(lds + attn::LDS_BIAS))[i] = F.BIAS2()[i];
    __syncthreads();
    attn::run(lds, F.vcu, F.G, 3 * 128 * 4, F.QG(), F.KG(), F.VG(), F.OG(), F.LSE(), F.tid, F.lane, F.wave);
    const int ch = F.tid & 127;
    f32x4 w0[2], w1[2], w2[2];
#pragma unroll
    for (int h = 0; h < 2; ++h) { w0[h] = *(const f32x4*)(F.convw + 8 * ch + 4 * h); w1[h] = *(const f32x4*)(F.convw + 1024 + 8 * ch + 4 * h); w2[h] = *(const f32x4*)(F.convw + 2048 + 8 * ch + 4 * h); }
    for (int tile = F.vcu; tile < T_ / 64; tile += F.G) {
#pragma unroll 4
        for (int i = 0; i < 16; ++i) {
            const int t = tile * 64 + (F.tid >> 7) + 4 * i, s = t & 2047;
            const u32x4 z = (u32x4){0u, 0u, 0u, 0u};
            const u32x4 a0 = *(const u32x4*)(F.U() + (size_t)t * 1024 + 8 * ch);
            const u32x4 a1 = (s >= 1) ? *(const u32x4*)(F.U() + (size_t)(t - 1) * 1024 + 8 * ch) : z;
            const u32x4 a2 = (s >= 2) ? *(const u32x4*)(F.U() + (size_t)(t - 2) * 1024 + 8 * ch) : z;
            const u32x4 cb = *(const u32x4*)(F.CB() + (size_t)t * 1024 + 8 * ch);
            f32x4 r0, r1;
            r0[0] = bf_lo(cb.x) * (w2[0][0] * bf_lo(a0.x) + w1[0][0] * bf_lo(a1.x) + w0[0][0] * bf_lo(a2.x));
            r0[1] = bf_hi(cb.x) * (w2[0][1] * bf_hi(a0.x) + w1[0][1] * bf_hi(a1.x) + w0[0][1] * bf_hi(a2.x));
            r0[2] = bf_lo(cb.y) * (w2[0][2] * bf_lo(a0.y) + w1[0][2] * bf_lo(a1.y) + w0[0][2] * bf_lo(a2.y));
            r0[3] = bf_hi(cb.y) * (w2[0][3] * bf_hi(a0.y) + w1[0][3] * bf_hi(a1.y) + w0[0][3] * bf_hi(a2.y));
            r1[0] = bf_lo(cb.z) * (w2[1][0] * bf_lo(a0.z) + w1[1][0] * bf_lo(a1.z) + w0[1][0] * bf_lo(a2.z));
            r1[1] = bf_hi(cb.z) * (w2[1][1] * bf_hi(a0.z) + w1[1][1] * bf_hi(a1.z) + w0[1][1] * bf_hi(a2.z));
            r1[2] = bf_lo(cb.w) * (w2[1][2] * bf_lo(a0.w) + w1[1][2] * bf_lo(a1.w) + w0[1][2] * bf_lo(a2.w));
            r1[3] = bf_hi(cb.w) * (w2[1][3] * bf_hi(a0.w) + w1[1][3] * bf_hi(a1.w) + w0[1][3] * bf_hi(a2.w));
            *(u32x4*)(F.A2() + (size_t)t * K2 + 256 + 8 * ch) = pack8(r0, r1);
        }
    }
}
__device__ __forceinline__ void p2b_combine(Frame& F) {
    const int gt = F.vcu * NWAVES * 64 + F.tid, NT = F.G * NWAVES * 64;
    for (int idx = gt; idx < T_ * 32; idx += NT) {
        const int t = idx >> 5, c8 = idx & 31, j = c8 >> 3;
        const float l0 = F.LSE()[(size_t)t * 4 + j], l1 = F.LSE()[(size_t)T_ * 4 + t * 4 + j], l2 = F.LSE()[(size_t)2 * T_ * 4 + t * 4 + j];
        const float mx = fmaxf(l0, fmaxf(l1, l2));
        float e0 = __builtin_amdgcn_exp2f(l0 - mx), e1 = __builtin_amdgcn_exp2f(l1 - mx), e2 = __builtin_amdgcn_exp2f(l2 - mx);
        const float inv = __builtin_amdgcn_rcpf(e0 + e1 + e2); e0 *= inv; e1 *= inv; e2 *= inv;
        const u32x4 a = *(const u32x4*)(F.OG() + (size_t)t * 256 + 8 * c8), b = *(const u32x4*)(F.OG() + (size_t)T_ * 256 + (size_t)t * 256 + 8 * c8), c = *(const u32x4*)(F.OG() + (size_t)2 * T_ * 256 + (size_t)t * 256 + 8 * c8);
        u32x4 w;
        w.x = pk2(e0 * bf_lo(a.x) + e1 * bf_lo(b.x) + e2 * bf_lo(c.x), e0 * bf_hi(a.x) + e1 * bf_hi(b.x) + e2 * bf_hi(c.x));
        w.y = pk2(e0 * bf_lo(a.y) + e1 * bf_lo(b.y) + e2 * bf_lo(c.y), e0 * bf_hi(a.y) + e1 * bf_hi(b.y) + e2 * bf_hi(c.y));
        w.z = pk2(e0 * bf_lo(a.z) + e1 * bf_lo(b.z) + e2 * bf_lo(c.z), e0 * bf_hi(a.z) + e1 * bf_hi(b.z) + e2 * bf_hi(c.z));
        w.w = pk2(e0 * bf_lo(a.w) + e1 * bf_lo(b.w) + e2 * bf_lo(c.w), e0 * bf_hi(a.w) + e1 * bf_hi(b.w) + e2 * bf_hi(c.w));
        *(u32x4*)(F.A2() + (size_t)t * K2 + 8 * c8) = w;
    }
}
__device__ __forceinline__ void p5_router(Frame& F) {
    LAS unsigned char* lds = F.lds;
    LAS int* te = (LAS int*)(F.lds + LDS_TOK); LAS float* tw = (LAS float*)(F.lds + LDS_TOK + 1024); LAS int* rk = (LAS int*)(F.lds + LDS_TOK + 2048);
    LAS int* hist = (LAS int*)(F.lds + LDS_TOK + 3072); LAS int* base = hist + 32;
    LAS float* xch = (LAS float*)(F.lds + LDS_RX); LAS float* lgt = (LAS float*)(F.lds + LDS_RX + 9216); LAS float* rsl = lgt + 64 * 33;
    for (int i = F.tid * 16; i < WRI_BYTES; i += NWAVES * 64 * 16) *(LAS u32x4*)(lds + i) = *(const u32x4*)((const unsigned char*)F.WRI() + i);
    const int lane = F.lane, tl = lane & 15, quad = lane >> 4, tt = F.wave >> 1, kh = F.wave & 1;
    for (int tile = F.vcu; tile < T_ / 64; tile += F.G) {
        if (F.tid < 32) hist[F.tid] = 0;
        const int t = tile * 64 + 16 * tt + tl;
        const bf16* xrow = F.X1B() + (size_t)t * D_ + 512 * kh + 8 * quad;
        const LAS unsigned char* wh = lds + (size_t)tl * (WRS * 2) + (512 * kh + 8 * quad) * 2;
        f32x4 c0 = (f32x4){0.f, 0.f, 0.f, 0.f}, c1 = (f32x4){0.f, 0.f, 0.f, 0.f}; float ss = 0.f;
        __syncthreads();
#pragma unroll 8
        for (int s = 0; s < 16; ++s) {
            const u32x4 hw = *(const u32x4*)(xrow + 32 * s);
            { const float a0 = bf_lo(hw.x), a1 = bf_hi(hw.x), a2 = bf_lo(hw.y), a3 = bf_hi(hw.y), b0 = bf_lo(hw.z), b1 = bf_hi(hw.z), b2 = bf_lo(hw.w), b3 = bf_hi(hw.w);
              ss += (a0 * a0 + a1 * a1) + (a2 * a2 + a3 * a3) + (b0 * b0 + b1 * b1) + (b2 * b2 + b3 * b3); }
            const bf16x8 xh = __builtin_bit_cast(bf16x8, hw);
            const bf16x8 wh0 = *(const LAS bf16x8*)(wh + 64 * s), wh1 = *(const LAS bf16x8*)(wh + 64 * s + 16 * WRS * 2);
            const bf16x8 wl0 = *(const LAS bf16x8*)(wh + 64 * s + 32 * WRS * 2), wl1 = *(const LAS bf16x8*)(wh + 64 * s + 48 * WRS * 2);
            c0 = __builtin_amdgcn_mfma_f32_16x16x32_bf16(wh0, xh, c0, 0, 0, 0); c1 = __builtin_amdgcn_mfma_f32_16x16x32_bf16(wh1, xh, c1, 0, 0, 0);
            c0 = __builtin_amdgcn_mfma_f32_16x16x32_bf16(wl0, xh, c0, 0, 0, 0); c1 = __builtin_amdgcn_mfma_f32_16x16x32_bf16(wl1, xh, c1, 0, 0, 0);
        }
        LAS float* xp = xch + (tt * 64 + lane) * 9;
        if (kh == 1) {
#pragma unroll
            for (int i = 0; i < 4; ++i) { xp[i] = c0[i]; xp[4 + i] = c1[i]; }
            xp[8] = ss;
        }
        __syncthreads();
        if (kh == 0) {
#pragma unroll
            for (int i = 0; i < 4; ++i) { c0[i] += xp[i]; c1[i] += xp[4 + i]; }
            ss += xp[8];
            ss += __shfl_xor(ss, 16); ss += __shfl_xor(ss, 32);
            const float rstd = 1.f / sqrtf(ss * (1.f / D_) + EPS);
            LAS float* lp = lgt + (16 * tt + tl) * 33;
#pragma unroll
            for (int i = 0; i < 4; ++i) { lp[4 * quad + i] = c0[i] * rstd + F.b_r[4 * quad + i]; lp[16 + 4 * quad + i] = c1[i] * rstd + F.b_r[16 + 4 * quad + i]; }
            if (quad == 0) rsl[16 * tt + tl] = rstd;
        }
        __syncthreads();
        if (F.tid < 64) {
            const LAS float* lp = lgt + F.tid * 33;
            float bv0 = -INFINITY, bv1 = -INFINITY, bv2 = -INFINITY, bv3 = -INFINITY; int bi0 = 0, bi1 = 0, bi2 = 0, bi3 = 0;
#pragma unroll 8
            for (int e = 0; e < 32; ++e) { const float d = lp[e];
                if (d > bv0) { bv3 = bv2; bi3 = bi2; bv2 = bv1; bi2 = bi1; bv1 = bv0; bi1 = bi0; bv0 = d; bi0 = e; }
                else if (d > bv1) { bv3 = bv2; bi3 = bi2; bv2 = bv1; bi2 = bi1; bv1 = d; bi1 = e; }
                else if (d > bv2) { bv3 = bv2; bi3 = bi2; bv2 = d; bi2 = e; }
                else if (d > bv3) { bv3 = d; bi3 = e; } }
            const float e1 = __expf(bv1 - bv0), e2 = __expf(bv2 - bv0), e3 = __expf(bv3 - bv0), inv = 1.f / (1.f + e1 + e2 + e3);
            te[F.tid * 4 + 0] = bi0; te[F.tid * 4 + 1] = bi1; te[F.tid * 4 + 2] = bi2; te[F.tid * 4 + 3] = bi3;
            tw[F.tid * 4 + 0] = inv; tw[F.tid * 4 + 1] = e1 * inv; tw[F.tid * 4 + 2] = e2 * inv; tw[F.tid * 4 + 3] = e3 * inv;
            rk[F.tid * 4 + 0] = atomicAdd((int*)&hist[bi0], 1); rk[F.tid * 4 + 1] = atomicAdd((int*)&hist[bi1], 1); rk[F.tid * 4 + 2] = atomicAdd((int*)&hist[bi2], 1); rk[F.tid * 4 + 3] = atomicAdd((int*)&hist[bi3], 1);
        }
        __syncthreads();
        if (F.tid < 32) base[F.tid] = (int)__hip_atomic_fetch_add((unsigned*)F.CNT() + F.tid, (unsigned)hist[F.tid], __ATOMIC_RELAXED, __HIP_MEMORY_SCOPE_AGENT);
        __syncthreads();
        if (F.tid < 256) {
            const int tq = F.tid >> 2, tk = tile * 64 + tq, e = te[F.tid], slot = base[e] + rk[F.tid];
            F.LISTS()[(size_t)e * T_ + slot] = tk; F.RS()[(size_t)e * T_ + slot] = rsl[tq];
            F.TOKE()[tk * 4 + (F.tid & 3)] = e; F.TOKS()[tk * 4 + (F.tid & 3)] = slot; F.TOKW()[tk * 4 + (F.tid & 3)] = tw[F.tid];
        }
        __syncthreads();
    }
}

struct MoeTable { LAS int* cnt; LAS int* tstart; LAS int* texp; };
__device__ __forceinline__ MoeTable moe_table(Frame& F) {
    MoeTable M; M.cnt = (LAS int*)(F.lds + LDSCTL_OFF); M.tstart = M.cnt + 32; M.texp = (LAS int*)(F.lds + LDS_TOK);
    if (F.tid < 32) M.cnt[F.tid] = (int)__hip_atomic_load((unsigned*)F.CNT() + F.tid, __ATOMIC_RELAXED, __HIP_MEMORY_SCOPE_AGENT);
    __syncthreads();
    if (F.tid == 0) { int a = 0; for (int e = 0; e < 32; ++e) { M.tstart[e] = a; a += (M.cnt[e] + 255) >> 8; } M.tstart[32] = a; }
    __syncthreads();
    if (F.tid < 288) { int e = 0; while (e < 31 && M.tstart[e + 1] <= F.tid) ++e; M.texp[F.tid] = e; }
    __syncthreads();
    return M;
}
template <int NN, bool GU>
struct MoeOrder {
    MoeTable M; const char* A; const char* Bt; const int* lists; int G, c, total;
    __device__ void init(const MoeTable& M_, const void* A_, const void* Bt_, const int* lists_, int G_, int c_) { M = M_; A = (const char*)A_; Bt = (const char*)Bt_; lists = lists_; G = G_; c = c_; total = M.tstart[32] * NN; }
    __device__ bool next(int i, pg8::Unit& u) const {
        const int L = i * G + c; if (L >= total) return false;
        const int mt = L / NN, pn = L % NN;
        const int e = M.texp[mt];
        u.pm = mt; u.pn = pn; u.e = e; u.rows = (mt - M.tstart[e]) * 256;
        u.b = Bt + ((size_t)e * (NN * 256) + (size_t)pn * 256) * 1024;
        u.a = GU ? A : A + (size_t)mt * 256 * 1024;
        return true;
    }
    __device__ __forceinline__ unsigned row_off(const pg8::Unit& u, int r) const {
        int lr = u.rows + r; const int ce = M.cnt[u.e]; if (lr >= ce) lr = 0;
        return (unsigned)lists[(size_t)u.e * T_ + lr] * 1024u;
    }
};

__device__ __forceinline__ void p8_final(Frame& F, const MoeTable& M) {
    const int gw = F.vcu * NWAVES + F.wave, NGW = F.G * NWAVES, lane = F.lane;
    for (int t = gw; t < T_; t += NGW) {
        int e4 = 0, s4 = 0; float w4 = 0.f;
        if (lane < 4) { e4 = F.TOKE()[t * 4 + lane]; s4 = F.TOKS()[t * 4 + lane]; w4 = F.TOKW()[t * 4 + lane]; }
        f32x4 a[4];
        GAS f32x4* op = (GAS f32x4*)(F.out + (size_t)t * D_) + 2 * lane;
        const bf16* xb = F.X1B() + (size_t)t * D_ + 8 * lane;
#pragma unroll
        for (int h = 0; h < 2; ++h) { const u32x4 xv = *(const u32x4*)(xb + 512 * h); a[2 * h] = (f32x4){bf_lo(xv.x), bf_hi(xv.x), bf_lo(xv.y), bf_hi(xv.y)}; a[2 * h + 1] = (f32x4){bf_lo(xv.z), bf_hi(xv.z), bf_lo(xv.w), bf_hi(xv.w)}; }
#pragma unroll
        for (int k = 0; k < 4; ++k) {
            const int e = __shfl(e4, k), sl = __shfl(s4, k); const float w = __shfl(w4, k);
            const unsigned char* yr = (const unsigned char*)F.YS() + ((size_t)M.tstart[e] * 256 + sl) * 1024 + 8 * lane;
#pragma unroll
            for (int h = 0; h < 2; ++h) { const u32x2 y = *(const u32x2*)(yr + 512 * h);
                const f32x2 p0 = __builtin_amdgcn_cvt_pk_f32_fp8((int)y.x, false), p1 = __builtin_amdgcn_cvt_pk_f32_fp8((int)y.x, true), p2 = __builtin_amdgcn_cvt_pk_f32_fp8((int)y.y, false), p3 = __builtin_amdgcn_cvt_pk_f32_fp8((int)y.y, true);
                a[2 * h] += w * (f32x4){p0[0], p0[1], p1[0], p1[1]}; a[2 * h + 1] += w * (f32x4){p2[0], p2[1], p3[0], p3[1]}; }
        }
#pragma unroll
        for (int h = 0; h < 2; ++h) { op[128 * h] = a[2 * h]; op[128 * h + 1] = a[2 * h + 1]; }
    }
}
struct Args { const float* in[17]; float* out; unsigned char* ws; int ph_lo, ph_hi; };
constexpr int N_PHASES = 10;
__global__ void __launch_bounds__(NWAVES * 64, 2) mk_fwd(Args args) {
    extern __shared__ __attribute__((aligned(16))) unsigned char lds[];
    Frame F;
    F.lds = (LAS unsigned char*)lds;
    F.MISC = (volatile LAS unsigned*)(F.lds + MISC_OFF);
    F.tid = threadIdx.x; F.lane = F.tid & 63; F.wave = __builtin_amdgcn_readfirstlane(F.tid >> 6);
    F.G = gridDim.x; { const int bx = blockIdx.x; F.vcu = (F.G % 8 == 0) ? (bx % 8) * (F.G / 8) + bx / 8 : bx; }
    unsigned char* ws = args.ws;
    F.ctl = (gu32*)g_ctl;
    F.x = args.in[0]; F.n1g = args.in[1]; F.w_in = args.in[2]; F.gq = args.in[3]; F.gk = args.in[4]; F.relb = args.in[5]; F.convw = args.in[6]; F.w_bc = args.in[7]; F.w_ba = args.in[8];
    F.w_out = args.in[9]; F.n2g = args.in[10]; F.w_r = args.in[11]; F.b_r = args.in[12]; F.w_gu = args.in[13]; F.b_gu = args.in[14]; F.w_d = args.in[15]; F.b_d = args.in[16]; F.out = args.out;
    F.ws = (GAS unsigned char*)ws;
    for (int u = F.tid; u < (LDS_BYTES - LDSCTL_OFF) / 4; u += NWAVES * 64) ((LAS unsigned*)(F.lds + LDSCTL_OFF))[u] = 0u;
    __syncthreads();
    const int lo = args.ph_lo, hi = args.ph_hi;
    const bool multi = (hi - lo) > 1;
    XcdBarrier bar; bar.bar = (unsigned*)(F.ctl + CW_BAR); bar.x = 0; bar.st = nullptr;
    if (multi) bar = xcd_barrier_post((unsigned*)(F.ctl + CW_BAR), F.MISC + 8);
#ifndef PH_MASK
#define PH_MASK 0x3ff
#endif
#define IN(k) (((PH_MASK >> (k)) & 1) && lo <= (k) && (k) < hi)
#ifdef TSEL
#define TSG ((GAS unsigned long long*)((GAS unsigned char*)args.ws + 65536))
#define TS_BEGIN(k) do { if ((k) == TSEL && threadIdx.x == 0 && blockIdx.x == 0) TSG[0] = __builtin_amdgcn_s_memrealtime(); } while (0)
#define SEAM(k) do { if (IN(k) && IN((k) + 1)) xcd_barrier(bar); if ((k) == TSEL && threadIdx.x == 0 && blockIdx.x == 0) TSG[1] = __builtin_amdgcn_s_memrealtime(); TS_BEGIN((k) + 1); } while (0)
#else
#define SEAM(k) do { if (IN(k) && IN((k) + 1)) xcd_barrier(bar); } while (0)
#endif
#ifdef TSEL
    TS_BEGIN(0);
#endif
#ifndef STAG1
#define STAG1 0
#endif
#ifndef STAG7
#define STAG7 0
#endif
#ifndef STAG8
#define STAG8 0
#endif
#define STAGGER(ticks_per_level) do { if ((ticks_per_level) > 0) { const unsigned long long t0_ = __builtin_amdgcn_s_memrealtime(); const unsigned long long w_ = (unsigned long long)(((unsigned)blockIdx.x >> 3) & 7u) * (unsigned)(ticks_per_level); \
        while (__builtin_amdgcn_s_memrealtime() - t0_ < w_) __builtin_amdgcn_s_sleep(8); } } while (0)
    if (IN(0)) { { GAS unsigned char* w_ = (GAS unsigned char*)args.ws; asm volatile("" : "+s"(w_)); F.ws = w_; int t_ = threadIdx.x; asm volatile("" : "+v"(t_)); F.tid = t_; F.lane = t_ & 63; } p0_prologue(F); } SEAM(0);
    if (IN(1)) { { GAS unsigned char* w_ = (GAS unsigned char*)args.ws; asm volatile("" : "+s"(w_)); F.ws = w_; int t_ = threadIdx.x; asm volatile("" : "+v"(t_)); F.tid = t_; F.lane = t_ & 63; }
        constexpr int NU1 = (T_ / 256) * (INW / 256), R1 = P1_ROUNDS, G1 = (NU1 + R1 - 1) / R1;
        const int g1 = (F.G == 256) ? G1 : F.G;
        if ((int)blockIdx.x < g1) {
            STAGGER(STAG1);
            pg8::DenseOrder<T_ / 256, INW / 256> S; S.init(F.H(), F.WT1(), 2048, g1, (int)blockIdx.x);
            Epi1 E{F.U(), F.CB(), F.QG(), F.KG(), F.VG(), F.SGC(), F.RAT(), F.gq, F.gk};
            pg8::gemm_phase<Epi1, pg8::DenseOrder<T_ / 256, INW / 256>, true, false, false, 1>(F.lds + RING_OFF, 2048, S, E);
        } else p0_items(F, P0_N0, P0_N0 + P0_DEFER1, ((int)blockIdx.x - g1) * NWAVES + F.wave, (F.G - g1) * NWAVES);
        if (g1 == F.G && F.G != 256) p0_items(F, P0_N0, P0_N0 + P0_DEFER1, (int)blockIdx.x * NWAVES + F.wave, F.G * NWAVES);
    } SEAM(1);
    if (IN(2)) { { GAS unsigned char* w_ = (GAS unsigned char*)args.ws; asm volatile("" : "+s"(w_)); F.ws = w_; int t_ = threadIdx.x; asm volatile("" : "+v"(t_)); F.tid = t_; F.lane = t_ & 63; } p2_attn_conv(F); } SEAM(2);
    if (IN(3)) { { GAS unsigned char* w_ = (GAS unsigned char*)args.ws; asm volatile("" : "+s"(w_)); F.ws = w_; int t_ = threadIdx.x; asm volatile("" : "+v"(t_)); F.tid = t_; F.lane = t_ & 63; } p2b_combine(F); } SEAM(3);
    if (IN(4)) { { GAS unsigned char* w_ = (GAS unsigned char*)args.ws; asm volatile("" : "+s"(w_)); F.ws = w_; int t_ = threadIdx.x; asm volatile("" : "+v"(t_)); F.tid = t_; F.lane = t_ & 63; }
        pg8::DenseOrder<T_ / 256, 4> S; S.init(F.A2(), F.WT2(), K2 * 2, F.G, (int)blockIdx.x);
        Epi2 E{F.SGC(), F.RAT(), F.MERGED()};
        pg8::gemm_phase<Epi2, pg8::DenseOrder<T_ / 256, 4>, true, false, false>(F.lds + RING_OFF, K2 * 2, S, E);
    } SEAM(4);
    if (IN(5)) { { GAS unsigned char* w_ = (GAS unsigned char*)args.ws; asm volatile("" : "+s"(w_)); F.ws = w_; int t_ = threadIdx.x; asm volatile("" : "+v"(t_)); F.tid = t_; F.lane = t_ & 63; }
        pg8::DenseOrder<T_ / 256, 4> S; S.init(F.MERGED(), F.WT3(), 2048, F.G, (int)blockIdx.x);
        Epi3 E{F.x, F.X1B(), F.n2g, (unsigned char*)F.H()};
        pg8::gemm_phase<Epi3, pg8::DenseOrder<T_ / 256, 4>, true, false, false>(F.lds + RING_OFF, 2048, S, E);
    } SEAM(5);
    if (IN(6)) { { GAS unsigned char* w_ = (GAS unsigned char*)args.ws; asm volatile("" : "+s"(w_)); F.ws = w_; int t_ = threadIdx.x; asm volatile("" : "+v"(t_)); F.tid = t_; F.lane = t_ & 63; } p5_router(F); } SEAM(6);
    if (IN(7)) { { GAS unsigned char* w_ = (GAS unsigned char*)args.ws; asm volatile("" : "+s"(w_)); F.ws = w_; int t_ = threadIdx.x; asm volatile("" : "+v"(t_)); F.tid = t_; F.lane = t_ & 63; }
        const MoeTable M = moe_table(F);
        const int tot7 = M.tstart[32] * 8, r7 = (tot7 + F.G - 1) / F.G, g7 = (tot7 + r7 - 1) / (r7 > 0 ? r7 : 1);
        if (F.vcu < g7) {
            STAGGER(STAG7);
            MoeOrder<8, true> S; S.init(M, F.H(), F.WGU(), F.LISTS(), g7, F.vcu);
            EpiGU E{(unsigned char*)F.ACT(), F.b_gu, F.RS(), M.cnt};
            pg8::gemm_phase<EpiGU, MoeOrder<8, true>, true, true, true, 7>(F.lds + RING_OFF, 1024, S, E);
        } else p0_items(F, P0_N0 + P0_DEFER1, P0_NITEMS, (F.vcu - g7) * NWAVES + F.wave, (F.G - g7) * NWAVES);
        if (g7 >= F.G) p0_items(F, P0_N0 + P0_DEFER1, P0_NITEMS, F.vcu * NWAVES + F.wave, F.G * NWAVES);
    } SEAM(7);
    if (IN(8)) { { GAS unsigned char* w_ = (GAS unsigned char*)args.ws; asm volatile("" : "+s"(w_)); F.ws = w_; int t_ = threadIdx.x; asm volatile("" : "+v"(t_)); F.tid = t_; F.lane = t_ & 63; }
        const MoeTable M = moe_table(F);
        STAGGER(STAG8);
        MoeOrder<4, false> S; S.init(M, F.ACT(), F.WD(), F.LISTS(), F.G, F.vcu);
        EpiDN E{(unsigned char*)F.YS(), F.b_d};
        pg8::gemm_phase<EpiDN, MoeOrder<4, false>, true, false, true, 8>(F.lds + RING_OFF, 1024, S, E);
    } SEAM(8);
    if (IN(9)) { { GAS unsigned char* w_ = (GAS unsigned char*)args.ws; asm volatile("" : "+s"(w_)); F.ws = w_; int t_ = threadIdx.x; asm volatile("" : "+v"(t_)); F.tid = t_; F.lane = t_ & 63; } const MoeTable M = moe_table(F); p8_final(F, M); }
#ifdef TSEL
    xcd_barrier(bar);
    if (TSEL == 9 && threadIdx.x == 0 && blockIdx.x == 0) TSG[1] = __builtin_amdgcn_s_memrealtime();
    if (blockIdx.x == 0 && threadIdx.x == 0) { float dt_us = (float)(TSG[1] - TSG[0]) * 0.01f; if (TSEL < 0) dt_us = 100.f;
#ifdef TPW
        { const LAS unsigned* tpw = (const LAS unsigned*)(F.lds + 163840 - 64); dt_us = (float)tpw[TPW] * 0.01f / (float)(tpw[3] ? tpw[3] : 1u) * 10.f; }
#endif
        F.out[0] += dt_us * 0.1f; }
#endif
    if (multi) {
        __syncthreads();
        volatile LAS unsigned* lastf = F.MISC + 12;
        if (threadIdx.x == 0) { const unsigned old = __hip_atomic_fetch_add(g_ctl + CW_DONE, 1u, __ATOMIC_RELAXED, __HIP_MEMORY_SCOPE_AGENT); lastf[0] = (old == (unsigned)F.G - 1u) ? 1u : 0u; }
        __syncthreads();
        if (lastf[0]) {
            for (int i = threadIdx.x; i < XCD_BAR_WORDS; i += NWAVES * 64) __hip_atomic_store(g_ctl + CW_BAR + i, 0u, __ATOMIC_RELAXED, __HIP_MEMORY_SCOPE_AGENT);
            if (threadIdx.x < 32) __hip_atomic_store(g_ctl + CW_CNT + threadIdx.x, 0u, __ATOMIC_RELAXED, __HIP_MEMORY_SCOPE_AGENT);
            if (threadIdx.x == 0) { __hip_atomic_store(g_ctl + CW_TMO, 0u, __ATOMIC_RELAXED, __HIP_MEMORY_SCOPE_AGENT); __hip_atomic_store(g_ctl + CW_DONE, 0u, __ATOMIC_RELAXED, __HIP_MEMORY_SCOPE_AGENT); }
        }
    }
#undef IN
#undef SEAM
}

static int mk_grid = 0;
static int mk_setup() {
    if (mk_grid != 0) return mk_grid;
    int dev = 0, cus = 0, per_cu = 0;
    if (hipGetDevice(&dev) != hipSuccess || hipDeviceGetAttribute(&cus, hipDeviceAttributeMultiprocessorCount, dev) != hipSuccess) { mk_grid = -1; return mk_grid; }
    if (hipFuncSetAttribute((const void*)mk_fwd, hipFuncAttributeMaxDynamicSharedMemorySize, LDS_BYTES) != hipSuccess) { fprintf(stderr, "hipFuncSetAttribute failed\n"); mk_grid = -1; return mk_grid; }
    if (hipOccupancyMaxActiveBlocksPerMultiprocessor(&per_cu, (const void*)mk_fwd, NWAVES * 64, LDS_BYTES) != hipSuccess || per_cu < 1) { fprintf(stderr, "occupancy query: %d blocks/CU\n", per_cu); (void)hipGetLastError(); mk_grid = -1; return mk_grid; }
    mk_grid = cus;
    return mk_grid;
}
static void mk_launch(void* const* d_in, void* d_out, void* d_ws, hipStream_t stream, int lo, int hi) {
    const int grid = mk_setup(); if (grid <= 0) return;
    Args a{};
    for (int i = 0; i < 17; ++i) a.in[i] = (const float*)d_in[i];
    a.out = (float*)d_out; a.ws = (unsigned char*)d_ws; a.ph_lo = lo; a.ph_hi = hi;
    hipLaunchKernelGGL(mk_fwd, dim3(grid), dim3(NWAVES * 64), LDS_BYTES, stream, a);
}
extern "C" void kernel_launch(void* const* d_in, const int* in_sizes, int n_in, void* d_out, int out_size, void* d_ws, size_t ws_size, hipStream_t stream) {
    mk_launch(d_in, d_out, d_ws, stream, 0, N_PHASES);
}
```

```cpp
#include <hip/hip_runtime.h>
#include <stdint.h>
#include <cstdio>

constexpr int B_ = 8, S_ = 2048, D_ = 1024, T_ = B_ * S_;
constexpr int INW = 7424, NE = 32;
constexpr int OFF_CB = 0, OFF_CC = 1024, OFF_CX = 2048, OFF_Q = 3072, OFF_K = 3840, OFF_V = 4608, OFF_GC = 5376, OFF_GA = 6400;
constexpr float EPS = 1e-6f;
constexpr float LOG2E = 1.4426950408889634f, LN2 = 0.6931471805599453f;
constexpr float QSCALE = 0.125f * LOG2E;
constexpr int K2 = 1280;
constexpr int PMAX = 65536 + 32 * 256;
constexpr int WRS = 1032, WRI_BYTES = 2 * 32 * WRS * 2;

#define GAS __attribute__((address_space(1)))
#define LAS __attribute__((address_space(3)))
typedef unsigned short bf16;
typedef short bf16x8 __attribute__((ext_vector_type(8)));
typedef short s16x4 __attribute__((ext_vector_type(4)));
typedef float f32x4 __attribute__((ext_vector_type(4)));
typedef float f32x2 __attribute__((ext_vector_type(2)));
typedef unsigned u32x4 __attribute__((ext_vector_type(4)));
typedef unsigned u32x2 __attribute__((ext_vector_type(2)));
typedef __bf16 bf16x2_t __attribute__((ext_vector_type(2)));
typedef int v8i __attribute__((ext_vector_type(8)));
typedef int v4i __attribute__((ext_vector_type(4)));

__device__ __forceinline__ unsigned pk2(float lo, float hi) { f32x2 v = {lo, hi}; bf16x2_t b = __builtin_convertvector(v, bf16x2_t); return __builtin_bit_cast(unsigned, b); }
__device__ __forceinline__ float clamp_fp8(float x) { return __builtin_amdgcn_fmed3f(x, -448.f, 448.f); }
__device__ __forceinline__ unsigned pk4_fp8(float a, float b, float c, float d) { int w = __builtin_amdgcn_cvt_pk_fp8_f32(a, b, 0, false); w = __builtin_amdgcn_cvt_pk_fp8_f32(c, d, w, true); return (unsigned)w; }
__device__ __forceinline__ float bf_lo(unsigned u) { return __uint_as_float(u << 16); }
__device__ __forceinline__ float bf_hi(unsigned u) { return __uint_as_float(u & 0xffff0000u); }
__device__ __forceinline__ int lane_fresh() { int l; asm volatile("v_mbcnt_lo_u32_b32 %0, -1, 0\n\tv_mbcnt_hi_u32_b32 %0, -1, %0" : "=v"(l)); return l; }
__device__ __forceinline__ float sigmoidf_(float x) { return __builtin_amdgcn_rcpf(1.f + __builtin_amdgcn_exp2f(-LOG2E * x)); }

namespace pg8 {
constexpr int BM = 256, BK = 64, HALF = 128, HTB = HALF * BK * 2, STAGE_BYTES = 8 * HTB, NXCD = 8, WGM = 8;
__host__ __device__ __forceinline__ int lds_byte(int r, int c) { const int st = (r >> 4) * 2 + (c >> 5), rr = r & 15, cc = c & 31, ob = rr * 64 + cc * 2; return st * 1024 + (ob ^ (((ob >> 9) & 1) << 5)); }
__host__ __device__ __forceinline__ void stage_rc(int b, int& R, int& C) { const int st = b / 1024, sb = b % 1024, swz = sb ^ (((sb >> 9) & 1) << 5); R = (st >> 1) * 16 + swz / 64; C = (st & 1) * 32 + (swz % 64) / 2; }
__host__ __device__ __forceinline__ int perm32(int rho) { const int n = rho >> 4, i = rho & 15; return 8 * (i >> 2) + 4 * n + (i & 3); }

struct Unit { const char* a; const char* b; int pm, pn, e, rows; };

template <int NM, int NN>
struct DenseOrder {
    static_assert(NM % WGM == 0, "row tiles in groups of 8");
    const char* A; const char* Bt; int KB, G, c;
    __device__ void init(const void* A_, const void* Bt_, int KB_, int G_, int c_) { A = (const char*)A_; Bt = (const char*)Bt_; KB = KB_; G = G_; c = c_; }
    __device__ bool next(int i, Unit& u) const {
        constexpr int nwg = NM * NN, q = nwg / NXCD, r = nwg % NXCD, nig = WGM * NN;
        const int L = i * G + c; if (L >= nwg) return false;
        const int xcd = L % NXCD, off = L / NXCD; const int wgid = (xcd < r ? xcd * (q + 1) : r * (q + 1) + (xcd - r) * q) + off;
        const int gid = wgid / nig, rem = wgid % nig;
        u.pm = gid * WGM + (rem % WGM); u.pn = rem / WGM; u.e = 0; u.rows = 256;
        u.a = A + (size_t)u.pm * BM * KB; u.b = Bt + (size_t)u.pn * BM * KB; return true;
    }
    __device__ __forceinline__ unsigned row_off(const Unit&, int) const { return 0u; }
};

#ifndef TPROBE
#define TPROBE (-2)
#endif
template <class Epi, class Sched, bool ALIGN_EPI, bool GATHER, bool FP8, int PID = -1>
__device__ __forceinline__ void gemm_phase(LAS unsigned char* lds, const int KB, const Sched& S, const Epi& E, const int wave_id) {
    constexpr bool TP = (PID == TPROBE);
    unsigned long long tp_t1 = 0; bool tp_pend = false; LAS unsigned* tpw = (LAS unsigned*)(lds + 163840 - 64);
    const int wid = __builtin_amdgcn_readfirstlane(wave_id), lane = lane_fresh(), tid = wid * 64 + lane, wr = wid >> 2, wc = wid & 3, fr = lane & 15, fq = lane >> 4;
    if constexpr (TP) { if (tid == 0) { tpw[0] = 0; tpw[1] = 0; tpw[2] = 0; tpw[3] = 0; } }
    const int nt = KB / 128;
    unsigned voffA[2], voffB[2]; int RA[2]; unsigned CA2[2];
#pragma unroll
    for (int i = 0; i < 2; ++i) { int R, C; stage_rc(tid * 16 + i * 8192, R, C); const int Rb = (R & ~31) + perm32(R & 31);
        voffA[i] = (unsigned)(R * KB + C * 2); voffB[i] = (unsigned)(Rb * KB + C * 2); RA[i] = R; CA2[i] = (unsigned)C * 2u; }
    const size_t kstep = (size_t)(BK * 2);
    const size_t hstep = (size_t)HALF * KB;
    const unsigned ldsw = (unsigned)wid * 1024u;
    const int aoff = lds_byte(wr * 64 + fr, fq * 8), boff = lds_byte(wc * 32 + fr, fq * 8);
#define PG8_SA(b, h) (((b) * 2 + (h)) * HTB)
#define PG8_SB(b, h) ((4 + (b) * 2 + (h)) * HTB)
#define PG8_STAGE2(bufoff, gbase, o0, o1) do { \
        __builtin_amdgcn_global_load_lds((const unsigned*)((const char*)(gbase) + (o0)), (LAS unsigned*)(lds + (bufoff) + ldsw), 16, 0, 0); \
        __builtin_amdgcn_global_load_lds((const unsigned*)((const char*)(gbase) + (o1)), (LAS unsigned*)(lds + (bufoff) + ldsw + 8192), 16, 0, 0); } while (0)
#define PG8_STB(bufoff, gbase) PG8_STAGE2(bufoff, gbase, voffB[0], voffB[1])
#define PG8_STA(bufoff, gbase, h, nx) do { if constexpr (GATHER) { const unsigned o0_ = (nx) ? gn[h][0] : gc[h][0], o1_ = (nx) ? gn[h][1] : gc[h][1]; PG8_STAGE2(bufoff, gbase, o0_, o1_); } \
        else { PG8_STAGE2(bufoff, (gbase) + (h) * hstep, voffA[0], voffA[1]); } } while (0)
#define PG8_RD8(p_) __builtin_shufflevector(__builtin_bit_cast(v4i, *(const LAS bf16x8*)(p_)), __builtin_bit_cast(v4i, *(const LAS bf16x8*)((p_) + 1024)), 0, 1, 2, 3, 4, 5, 6, 7)
#define PG8_LDA(dst, b, h) do { _Pragma("unroll") for (int m = 0; m < 4; ++m) { if constexpr (FP8) { dst##8[m] = PG8_RD8(lds + PG8_SA(b, h) + aoff + m * 2048); } else { _Pragma("unroll") for (int k = 0; k < 2; ++k) dst[m][k] = *(const LAS bf16x8*)(lds + PG8_SA(b, h) + aoff + m * 2048 + k * 1024); } } } while (0)
#define PG8_LDB(dst, b, h) do { _Pragma("unroll") for (int n = 0; n < 2; ++n) { if constexpr (FP8) { dst##8[n] = PG8_RD8(lds + PG8_SB(b, h) + boff + n * 2048); } else { _Pragma("unroll") for (int k = 0; k < 2; ++k) dst[n][k] = *(const LAS bf16x8*)(lds + PG8_SB(b, h) + boff + n * 2048 + k * 1024); } } } while (0)
#define PG8_MMA(ai, bj, At, Bt) do { __builtin_amdgcn_s_setprio(1); _Pragma("unroll") for (int m = 0; m < 4; ++m) _Pragma("unroll") for (int n = 0; n < 2; ++n) { \
        if constexpr (FP8) { asm volatile("v_mfma_scale_f32_16x16x128_f8f6f4 %0, %1, %2, %0, %3, %3 op_sel_hi:[0,0,0]" : "+v"(acc[ai][bj][m][n]) : "v"(Bt##8[n]), "v"(At##8[m]), "v"(sc1_)); } \
        else { _Pragma("unroll") for (int k = 0; k < 2; ++k) acc[ai][bj][m][n] = __builtin_amdgcn_mfma_f32_16x16x32_bf16(Bt[n][k], At[m][k], acc[ai][bj][m][n], 0, 0, 0); } } \
        if constexpr (FP8) asm volatile("s_nop 4"); \
        __builtin_amdgcn_s_setprio(0); } while (0)
#define PG8_WAIT_V(n) asm volatile("s_waitcnt vmcnt(" #n ")" ::: "memory")
#define PG8_WAIT_L(n) asm volatile("s_waitcnt lgkmcnt(" #n ")" ::: "memory")
#define PG8_BAR __builtin_amdgcn_s_barrier()
#define PG8_SCHED __builtin_amdgcn_sched_barrier(0)
#define PG8_TPH(w) do { if constexpr (TP) { if (tp_pend) { const unsigned long long tn_ = __builtin_amdgcn_s_memrealtime(); if (blockIdx.x == 0 && tid == 0 && (w) < 2) tpw[1 + (w)] += (unsigned)(tn_ - tp_t1); tp_t1 = tn_; if ((w) == 2) tp_pend = false; } } } while (0)
#define PG8_KBODY do { \
            const bool last = (t == nt - 2); \
            const char* a1 = cA + (size_t)(t + 1) * kstep; \
            const char* a2 = last ? nA : cA + (size_t)(t + 2) * kstep; const char* b2 = last ? nB : cB + (size_t)(t + 2) * kstep; \
            const char* a3 = a2 + kstep; const char* b3 = b2 + kstep; \
            PG8_LDB(B0, 0, 0); PG8_LDB(B1, 0, 1); PG8_SCHED; PG8_LDA(At, 0, 0); PG8_STA(PG8_SA(1, 1), a1, 1, false); \
            PG8_TPH(0); PG8_WAIT_V(8); PG8_TPH(1); PG8_WAIT_L(0); PG8_BAR; PG8_TPH(2); PG8_MMA(0, 0, At, B0); PG8_MMA(0, 1, At, B1); PG8_BAR; PG8_SCHED; \
            PG8_LDA(At, 0, 1); PG8_STB(PG8_SB(0, 0), b2); PG8_STB(PG8_SB(0, 1), b2 + hstep); PG8_STA(PG8_SA(0, 0), a2, 0, last); \
            PG8_WAIT_V(8); PG8_WAIT_L(0); PG8_BAR; PG8_MMA(1, 0, At, B0); PG8_MMA(1, 1, At, B1); PG8_BAR; PG8_SCHED; \
            PG8_LDB(B0, 1, 0); PG8_LDB(B1, 1, 1); PG8_SCHED; PG8_LDA(At, 1, 0); PG8_STA(PG8_SA(0, 1), a2, 1, last); \
            PG8_WAIT_V(8); PG8_WAIT_L(0); PG8_BAR; PG8_MMA(0, 0, At, B0); PG8_MMA(0, 1, At, B1); PG8_BAR; PG8_SCHED; \
            PG8_LDA(At, 1, 1); PG8_STB(PG8_SB(1, 0), b3); PG8_STB(PG8_SB(1, 1), b3 + hstep); PG8_STA(PG8_SA(1, 0), a3, 0, last); \
            PG8_WAIT_V(8); PG8_WAIT_L(0); PG8_BAR; PG8_MMA(1, 0, At, B0); PG8_MMA(1, 1, At, B1); PG8_BAR; PG8_SCHED; \
        } while (0)
    Unit cur, nxt; int ui = 0;
    if (!S.next(0, cur)) return;
    f32x4 acc[2][2][4][2];
#pragma unroll
    for (int a = 0; a < 2; ++a)
#pragma unroll
        for (int b = 0; b < 2; ++b)
#pragma unroll
            for (int m = 0; m < 4; ++m)
#pragma unroll
                for (int n = 0; n < 2; ++n) acc[a][b][m][n] = (f32x4){0.f, 0.f, 0.f, 0.f};
#define PG8_OPAQ() do { if constexpr (FP8) { _Pragma("unroll") for (int a = 0; a < 2; ++a) _Pragma("unroll") for (int b = 0; b < 2; ++b) \
        asm volatile("" : "+v"(acc[a][b][0][0]), "+v"(acc[a][b][0][1]), "+v"(acc[a][b][1][0]), "+v"(acc[a][b][1][1]), "+v"(acc[a][b][2][0]), "+v"(acc[a][b][2][1]), "+v"(acc[a][b][3][0]), "+v"(acc[a][b][3][1])); } } while (0)
    bf16x8 At[4][2], B0[2][2], B1[2][2]; v8i At8[4], B08[2], B18[2]; int sc1_ = 0x7f7f7f7f; asm volatile("" : "+v"(sc1_));
    unsigned gc[2][2], gn[2][2];
    if constexpr (GATHER) {
#pragma unroll
        for (int h = 0; h < 2; ++h)
#pragma unroll
            for (int i = 0; i < 2; ++i) { gc[h][i] = S.row_off(cur, h * HALF + RA[i]) + CA2[i]; gn[h][i] = gc[h][i]; }
    }
    const char* cA = cur.a; const char* cB = cur.b;
    PG8_STB(PG8_SB(0, 0), cB); PG8_STB(PG8_SB(0, 1), cB + hstep); PG8_STA(PG8_SA(0, 0), cA, 0, false); PG8_STA(PG8_SA(0, 1), cA, 1, false);
    if (wr == 1) PG8_BAR;
    PG8_WAIT_V(2); PG8_BAR;
    PG8_STB(PG8_SB(1, 0), cB + kstep); PG8_STA(PG8_SA(1, 0), cA + kstep, 0, false); PG8_STB(PG8_SB(1, 1), cB + hstep + kstep);
    PG8_WAIT_V(6); PG8_BAR;
    LAS unsigned char* const pfbase = lds + 133120;
    for (;;) {
        if constexpr (Epi::PF) E.prefetch(cur, pfbase + (ui & 1) * 4096, wid, lane);
        const bool has_next = S.next(ui + 1, nxt);
        if constexpr (GATHER) {
            if (has_next) {
#pragma unroll
                for (int h = 0; h < 2; ++h)
#pragma unroll
                    for (int i = 0; i < 2; ++i) gn[h][i] = S.row_off(nxt, h * HALF + RA[i]) + CA2[i];
            }
        }
        const char* nA = has_next ? nxt.a : cA; const char* nB = has_next ? nxt.b : cB;
        if constexpr (Epi::MID_T > 0) {
            for (int t = 0; t < Epi::MID_T; t += 2) PG8_KBODY;
            E.mid(acc, cur, wr, wc, fr, fq);
            for (int t = Epi::MID_T; t < nt; t += 2) PG8_KBODY;
        } else {
            for (int t = 0; t < nt; t += 2) PG8_KBODY;
        }
        if constexpr (FP8) asm volatile("s_nop 15\n\ts_nop 15");
        if constexpr (ALIGN_EPI) { if (wr == 0) PG8_BAR; }
        unsigned long long tp_t0 = 0; if constexpr (TP) tp_t0 = __builtin_amdgcn_s_memrealtime();
        E(acc, cur, wr, wc, fr, fq, pfbase + (ui & 1) * 4096);
        if constexpr (TP) { tp_t1 = __builtin_amdgcn_s_memrealtime(); if (blockIdx.x == 0 && tid == 0) { tpw[0] += (unsigned)(tp_t1 - tp_t0); tpw[3] += 1u; } tp_pend = true; }
        if (!has_next) break;
#pragma unroll
        for (int a = 0; a < 2; ++a)
#pragma unroll
            for (int b = 0; b < 2; ++b)
#pragma unroll
                for (int m = 0; m < 4; ++m)
#pragma unroll
                    for (int n = 0; n < 2; ++n) acc[a][b][m][n] = (f32x4){0.f, 0.f, 0.f, 0.f};
            cur = nxt; cA = nA; cB = nB; ++ui;
        if constexpr (GATHER) {
#pragma unroll
            for (int h = 0; h < 2; ++h)
#pragma unroll
                for (int i = 0; i < 2; ++i) gc[h][i] = gn[h][i];
        }
        if constexpr (ALIGN_EPI) { if (wr == 1) PG8_BAR; }
    }
    PG8_WAIT_V(0);
    if constexpr (!ALIGN_EPI) { if (wr == 0) PG8_BAR; }
    PG8_BAR;

#undef PG8_KBODY
#undef PG8_TPH
#undef PG8_OPAQ
#undef PG8_SA
#undef PG8_SB
#undef PG8_STAGE2
#undef PG8_STB
#undef PG8_STA
#undef PG8_LDA
#undef PG8_LDB
#undef PG8_MMA
#undef PG8_WAIT_V
#undef PG8_WAIT_L
#undef PG8_BAR
#undef PG8_SCHED
}
}
__device__ __forceinline__ int deint_row(int g, int t) {
    const int b = t & ~2047, s = t & 2047;
    if (g == 0) return t;
    if (g == 1) return b + (s & 3) * 512 + (s >> 2);
    return b + (s & 15) * 128 + (s >> 4);
}
__device__ __forceinline__ int reint_row(int g, int R) {
    const int b = R & ~2047, s = R & 2047;
    if (g == 0) return R;
    if (g == 1) return b + (s & 511) * 4 + (s >> 9);
    return b + (s & 127) * 16 + (s >> 7);
}
#ifdef USE_NT
#define NTST(p, v) __builtin_nontemporal_store((v), (u32x4*)(p))
#else
#define NTST(p, v) (*(u32x4*)(p) = (v))
#endif
__device__ __forceinline__ u32x4 pack8(const f32x4 a, const f32x4 b) { u32x4 w; w.x = pk2(a[0], a[1]); w.y = pk2(a[2], a[3]); w.z = pk2(b[0], b[1]); w.w = pk2(b[2], b[3]); return w; }

__device__ __forceinline__ u32x4 fp8_pair16(const u32x2 pa, const u32x2 pb, const bool odd) {
    const u32x2 snd = odd ? pa : pb;
    u32x2 rcv; rcv.x = (unsigned)__shfl_xor((int)snd.x, 16); rcv.y = (unsigned)__shfl_xor((int)snd.y, 16);
    return odd ? (u32x4){rcv.x, rcv.y, pb.x, pb.y} : (u32x4){pa.x, pa.y, rcv.x, rcv.y};
}
__host__ __device__ __forceinline__ int colmap1(int nphys) {
    const int pn = nphys >> 8, x = nphys & 255, bj = x >> 7, y = x & 127;
    if (pn < 8) return (bj ? OFF_CX : OFF_CC) + 128 * pn + y;
    if (pn < 12) return OFF_CB + 256 * (pn - 8) + x;
    if (pn < 18) { const int isk = pn >= 15, g = (pn - 12) % 3, wc = y >> 5, xx = y & 31; return (isk ? OFF_K : OFF_Q) + 256 * g + 64 * wc + 32 * bj + xx; }
    if (pn < 21) return OFF_V + 256 * (pn - 18) + x;
    return (bj ? OFF_GA : OFF_GC) + 128 * (pn - 21) + y;
}
struct Epi1 {
    static constexpr int MID_T = 0; static constexpr bool PF = false;
    bf16* U; bf16* CB; bf16* QG; bf16* KG; bf16* VG; bf16* SGC; bf16* RAT; const float* gq; const float* gk;
    __device__ __forceinline__ void mid(f32x4 (&)[2][2][4][2], const pg8::Unit&, int, int, int, int) const {}
    __device__ __forceinline__ void operator()(const f32x4 (&acc)[2][2][4][2], const pg8::Unit& u, int wr, int wc, int fr_, int fq_, LAS unsigned char* pf) const {
        const int lane_ = lane_fresh(), fr = lane_ & 15, fq = lane_ >> 4;
        const int pn = u.pn, row0 = u.pm * 256 + wr * 64 + fr;
        if (pn < 8) {
            const int col = 128 * pn + 32 * wc + 8 * fq;
#pragma unroll
            for (int ai = 0; ai < 2; ++ai)
#pragma unroll
                for (int m = 0; m < 4; ++m) { const int row = row0 + ai * 128 + m * 16;
                    NTST(U + (size_t)row * 1024 + col, pack8(acc[ai][0][m][0] * acc[ai][1][m][0], acc[ai][0][m][1] * acc[ai][1][m][1])); }
        } else if (pn < 12) {
            const int col = 256 * (pn - 8) + 32 * wc + 8 * fq;
#pragma unroll
            for (int ai = 0; ai < 2; ++ai)
#pragma unroll
                for (int m = 0; m < 4; ++m) { const int row = row0 + ai * 128 + m * 16;
#pragma unroll
                    for (int bj = 0; bj < 2; ++bj) NTST(CB + (size_t)row * 1024 + col + 128 * bj, pack8(acc[ai][bj][m][0], acc[ai][bj][m][1])); }
        } else if (pn < 18) {
            const bool isk = pn >= 15; const int g = (pn - 12) % 3;
            const float* gg = isk ? gk : gq; bf16* dst = (isk ? KG : QG) + (size_t)g * T_ * 256;
            f32x4 gv[2][2];
#pragma unroll
            for (int bj = 0; bj < 2; ++bj)
#pragma unroll
                for (int n = 0; n < 2; ++n) gv[bj][n] = *(const f32x4*)(gg + 32 * bj + 8 * fq + 4 * n);
            const float sc = isk ? 1.f : QSCALE;
#pragma unroll
            for (int ai = 0; ai < 2; ++ai)
#pragma unroll
                for (int m = 0; m < 4; ++m) {
                    float ss = 0.f;
#pragma unroll
                    for (int bj = 0; bj < 2; ++bj)
#pragma unroll
                        for (int n = 0; n < 2; ++n) { const f32x4 x = acc[ai][bj][m][n]; ss += (x[0] * x[0] + x[1] * x[1]) + (x[2] * x[2] + x[3] * x[3]); }
                    ss += __shfl_xor(ss, 16); ss += __shfl_xor(ss, 32);
                    const float rs = __builtin_amdgcn_rsqf(ss * (1.f / 64.f) + EPS) * sc;
                    const int drow = deint_row(g, row0 + ai * 128 + m * 16);
                    bf16* p = dst + ((size_t)drow * 4 + wc) * 64 + 8 * fq;
#pragma unroll
                    for (int bj = 0; bj < 2; ++bj) NTST(p + 32 * bj, pack8(acc[ai][bj][m][0] * gv[bj][0] * rs, acc[ai][bj][m][1] * gv[bj][1] * rs));
                }
        } else if (pn < 21) {
            const int g = pn - 18; bf16* dst = VG + (size_t)g * T_ * 256;
#pragma unroll
            for (int ai = 0; ai < 2; ++ai)
#pragma unroll
                for (int m = 0; m < 4; ++m) { const int drow = deint_row(g, row0 + ai * 128 + m * 16);
#pragma unroll
                    for (int bj = 0; bj < 2; ++bj) NTST(dst + (size_t)drow * 256 + 128 * bj + 32 * wc + 8 * fq, pack8(acc[ai][bj][m][0], acc[ai][bj][m][1])); }
        } else {
            const int col = 128 * (pn - 21) + 32 * wc + 8 * fq;
#pragma unroll
            for (int ai = 0; ai < 2; ++ai)
#pragma unroll
                for (int m = 0; m < 4; ++m) { const int row = row0 + ai * 128 + m * 16;
                    f32x4 sc[2], rt[2];
                    const f32x2 one2 = {1.f, 1.f}, nl2 = {-LOG2E, -LOG2E};
#pragma unroll
                    for (int n = 0; n < 2; ++n)
#pragma unroll
                        for (int h = 0; h < 2; ++h) {
                            const f32x2 gc = {acc[ai][0][m][n][2 * h], acc[ai][0][m][n][2 * h + 1]}, ga = {acc[ai][1][m][n][2 * h], acc[ai][1][m][n][2 * h + 1]};
                            f32x2 tc = gc * nl2, ta = ga * nl2; tc.x = fminf(tc.x, 60.f); tc.y = fminf(tc.y, 60.f); ta.x = fminf(ta.x, 60.f); ta.y = fminf(ta.y, 60.f);
                            f32x2 ec, ea; ec.x = __builtin_amdgcn_exp2f(tc.x); ec.y = __builtin_amdgcn_exp2f(tc.y); ea.x = __builtin_amdgcn_exp2f(ta.x); ea.y = __builtin_amdgcn_exp2f(ta.y);
                            const f32x2 dc = ec + one2, da = ea + one2, pr = dc * da; f32x2 r; r.x = __builtin_amdgcn_rcpf(pr.x); r.y = __builtin_amdgcn_rcpf(pr.y);
                            const f32x2 rc = r * da, rr = (dc * dc) * r;
                            sc[n][2 * h] = rc.x; sc[n][2 * h + 1] = rc.y; rt[n][2 * h] = rr.x; rt[n][2 * h + 1] = rr.y; }
                    NTST(SGC + (size_t)row * 1024 + col, pack8(sc[0], sc[1]));
                    NTST(RAT + (size_t)row * 1024 + col, pack8(rt[0], rt[1])); }
        }
    }
};

struct Epi2 {
    static constexpr int MID_T = 4; static constexpr bool PF = false;
    const bf16* SGC; const bf16* RAT; bf16* MERGED;
    __device__ __forceinline__ void mid(f32x4 (&acc)[2][2][4][2], const pg8::Unit& u, int wr, int wc, int fr_, int fq_) const {
        const int lane_ = lane_fresh(), fr = lane_ & 15, fq = lane_ >> 4;
        const int row0 = u.pm * 256 + wr * 64 + fr, col0 = u.pn * 256 + 32 * wc + 8 * fq;
        u32x4 rr[2][4][2];
#pragma unroll
        for (int ai = 0; ai < 2; ++ai)
#pragma unroll
            for (int m = 0; m < 4; ++m)
#pragma unroll
                for (int bj = 0; bj < 2; ++bj) rr[ai][m][bj] = *(const u32x4*)(RAT + (size_t)(row0 + ai * 128 + m * 16) * 1024 + col0 + 128 * bj);
#pragma unroll
        for (int ai = 0; ai < 2; ++ai)
#pragma unroll
            for (int m = 0; m < 4; ++m)
#pragma unroll
                for (int bj = 0; bj < 2; ++bj) { const u32x4 r = rr[ai][m][bj];
                    acc[ai][bj][m][0] *= (f32x4){bf_lo(r.x), bf_hi(r.x), bf_lo(r.y), bf_hi(r.y)}; acc[ai][bj][m][1] *= (f32x4){bf_lo(r.z), bf_hi(r.z), bf_lo(r.w), bf_hi(r.w)}; }
    }
    __device__ __forceinline__ void operator()(const f32x4 (&acc)[2][2][4][2], const pg8::Unit& u, int wr, int wc, int fr_, int fq_, LAS unsigned char* pf) const {
        const int lane_ = lane_fresh(), fr = lane_ & 15, fq = lane_ >> 4;
        const int row0 = u.pm * 256 + wr * 64 + fr, col0 = u.pn * 256 + 32 * wc + 8 * fq;
        u32x4 ss[2][4][2];
#pragma unroll
        for (int ai = 0; ai < 2; ++ai)
#pragma unroll
            for (int m = 0; m < 4; ++m)
#pragma unroll
                for (int bj = 0; bj < 2; ++bj) ss[ai][m][bj] = *(const u32x4*)(SGC + (size_t)(row0 + ai * 128 + m * 16) * 1024 + col0 + 128 * bj);
#pragma unroll
        for (int ai = 0; ai < 2; ++ai)
#pragma unroll
            for (int m = 0; m < 4; ++m)
#pragma unroll
                for (int bj = 0; bj < 2; ++bj) { const size_t off = (size_t)(row0 + ai * 128 + m * 16) * 1024 + col0 + 128 * bj; const u32x4 r = ss[ai][m][bj];
                    NTST(MERGED + off, pack8(acc[ai][bj][m][0] * (f32x4){bf_lo(r.x), bf_hi(r.x), bf_lo(r.y), bf_hi(r.y)}, acc[ai][bj][m][1] * (f32x4){bf_lo(r.z), bf_hi(r.z), bf_lo(r.w), bf_hi(r.w)})); }
    }
};

constexpr size_t EPI3_X1B = 248u << 20, EPI3_XG = 216u << 20, EPI3_WRI = (837u << 20) + 65536u, EPI3_PL = 546u << 20;
__device__ __forceinline__ size_t pl_idx(int t) { return ((size_t)(t >> 11) << 20) + (size_t)(t & 2047) * 128; }
__device__ __forceinline__ size_t pss_idx(int t) { return ((size_t)(t >> 11) << 20) + (1u << 18) + (size_t)(t & 2047) * 4; }
struct Epi3 {
    static constexpr int MID_T = 0; static constexpr bool PF = false;
    const float* X; const float* g2; GAS unsigned char* wsb; LAS unsigned char* ldsb; long ring_free;
    __device__ __forceinline__ void mid(f32x4 (&)[2][2][4][2], const pg8::Unit&, int, int, int, int) const {}
    __device__ __forceinline__ void operator()(const f32x4 (&acc)[2][2][4][2], const pg8::Unit& u, int wr, int wc, int fr_, int fq_, LAS unsigned char* pf) const {
        const int lane_ = lane_fresh(), fr = lane_ & 15, fq = lane_ >> 4;
        const int row0 = u.pm * 256 + wr * 64 + fr, col0 = u.pn * 256 + 32 * wc + 8 * fq;
        bf16* const X1B = (bf16*)(wsb + EPI3_X1B); unsigned char* const XG = (unsigned char*)(wsb + EPI3_XG); const bf16* const WRI = (const bf16*)(wsb + EPI3_WRI); float* const PL = (float*)(wsb + EPI3_PL);
        LAS float* red = (LAS float*)(ldsb + 131072);
        if (!ring_free) { const int tid = (wr * 4 + wc) * 64 + lane_fresh(), orow = tid >> 2, och = tid & 3;
#pragma unroll
            for (int i = 0; i < 8; ++i) red[orow * 33 + 8 * och + i] = 0.f;
            if (och == 0) red[orow * 33 + 32] = 0.f; }
        f32x4 gv[2][2];
#pragma unroll
        for (int bj = 0; bj < 2; ++bj)
#pragma unroll
            for (int n = 0; n < 2; ++n) gv[bj][n] = *(const f32x4*)(g2 + col0 + 128 * bj + 4 * n);
        const bool odd = (fq & 1) != 0; const int colw = u.pn * 256 + 32 * wc + 16 * (fq >> 1);
        u32x4 hb[2][4][2];
        u32x4 xg[2][2][2];
#pragma unroll
        for (int ai = 0; ai < 2; ++ai) {
            f32x4 xv[4][2][2];
#pragma unroll
            for (int m = 0; m < 4; ++m)
#pragma unroll
                for (int bj = 0; bj < 2; ++bj) { const size_t off = (size_t)(row0 + ai * 128 + m * 16) * 1024 + col0 + 128 * bj; xv[m][bj][0] = *(const f32x4*)(X + off); xv[m][bj][1] = *(const f32x4*)(X + off + 4); }
#pragma unroll
            for (int mp = 0; mp < 2; ++mp)
#pragma unroll
                for (int bj = 0; bj < 2; ++bj) { u32x2 pc[2];
#pragma unroll
                    for (int mm = 0; mm < 2; ++mm) { const int m = 2 * mp + mm;
                        const f32x4 x0 = xv[m][bj][0] + acc[ai][bj][m][0], x1 = xv[m][bj][1] + acc[ai][bj][m][1];
                        hb[ai][m][bj] = pack8(x0, x1);
                        const f32x4 y0 = x0 * gv[bj][0], y1 = x1 * gv[bj][1]; pc[mm].x = pk4_fp8(clamp_fp8(y0[0]), clamp_fp8(y0[1]), clamp_fp8(y0[2]), clamp_fp8(y0[3])); pc[mm].y = pk4_fp8(clamp_fp8(y1[0]), clamp_fp8(y1[1]), clamp_fp8(y1[2]), clamp_fp8(y1[3])); }
                    xg[ai][mp][bj] = fp8_pair16(pc[0], pc[1], odd); }
        }
        bf16x8 wh[2][2], wl[2][2];
#pragma unroll
        for (int bj = 0; bj < 2; ++bj)
#pragma unroll
            for (int tl = 0; tl < 2; ++tl) { const bf16* wp = WRI + (size_t)(16 * tl + fr) * WRS + col0 + 128 * bj; wh[bj][tl] = *(const bf16x8*)wp; wl[bj][tl] = *(const bf16x8*)(wp + 32 * WRS); }
        asm volatile("" ::: "memory");
#pragma unroll
        for (int ai = 0; ai < 2; ++ai) {
#pragma unroll
            for (int m = 0; m < 4; ++m)
#pragma unroll
                for (int bj = 0; bj < 2; ++bj) NTST(X1B + (size_t)(row0 + ai * 128 + m * 16) * 1024 + col0 + 128 * bj, hb[ai][m][bj]);
#pragma unroll
            for (int mp = 0; mp < 2; ++mp)
#pragma unroll
                for (int bj = 0; bj < 2; ++bj) NTST(XG + (size_t)(row0 + ai * 128 + (2 * mp + (odd ? 1 : 0)) * 16) * 1024 + colw + 128 * bj, xg[ai][mp][bj]);
        }
        asm volatile("s_waitcnt lgkmcnt(0)" ::: "memory"); __builtin_amdgcn_s_barrier(); asm volatile("" ::: "memory");
        LAS float* const P = (LAS float*)ldsb + wc * 8448;
#pragma unroll
        for (int ai = 0; ai < 2; ++ai) {
#pragma unroll
            for (int m = 0; m < 4; ++m) {
                f32x4 c0 = (f32x4){0.f, 0.f, 0.f, 0.f}, c1 = (f32x4){0.f, 0.f, 0.f, 0.f}; float ss = 0.f;
#pragma unroll
                for (int bj = 0; bj < 2; ++bj) { const u32x4 h = hb[ai][m][bj]; const bf16x8 xh = __builtin_bit_cast(bf16x8, h);
                    { const float a0 = bf_lo(h.x), a1 = bf_hi(h.x), a2 = bf_lo(h.y), a3 = bf_hi(h.y), b0 = bf_lo(h.z), b1 = bf_hi(h.z), b2 = bf_lo(h.w), b3 = bf_hi(h.w);
                      ss += (a0 * a0 + a1 * a1) + (a2 * a2 + a3 * a3) + (b0 * b0 + b1 * b1) + (b2 * b2 + b3 * b3); }
                    c0 = __builtin_amdgcn_mfma_f32_16x16x32_bf16(wh[bj][0], xh, c0, 0, 0, 0); c1 = __builtin_amdgcn_mfma_f32_16x16x32_bf16(wh[bj][1], xh, c1, 0, 0, 0);
                    c0 = __builtin_amdgcn_mfma_f32_16x16x32_bf16(wl[bj][0], xh, c0, 0, 0, 0); c1 = __builtin_amdgcn_mfma_f32_16x16x32_bf16(wl[bj][1], xh, c1, 0, 0, 0); }
                if (ring_free) {
                    ss += __shfl_xor(ss, 16); ss += __shfl_xor(ss, 32);
                    LAS float* rp = P + (128 * ai + 64 * wr + 16 * m + fr) * 33;
#pragma unroll
                    for (int i = 0; i < 4; ++i) { rp[4 * fq + i] = c0[i]; rp[16 + 4 * fq + i] = c1[i]; }
                    if (fq == 0) rp[32] = ss;
                } else {
                    LAS float* rp = red + (64 * wr + 16 * m + fr) * 33;
#pragma unroll
                    for (int i = 0; i < 4; ++i) { (void)__hip_atomic_fetch_add(rp + 4 * fq + i, c0[i], __ATOMIC_RELAXED, __HIP_MEMORY_SCOPE_WORKGROUP); (void)__hip_atomic_fetch_add(rp + 16 + 4 * fq + i, c1[i], __ATOMIC_RELAXED, __HIP_MEMORY_SCOPE_WORKGROUP); }
                    (void)__hip_atomic_fetch_add(rp + 32, ss, __ATOMIC_RELAXED, __HIP_MEMORY_SCOPE_WORKGROUP);
                }
            }
            if (!ring_free) {
                asm volatile("s_waitcnt lgkmcnt(0)" ::: "memory"); __builtin_amdgcn_s_barrier(); asm volatile("" ::: "memory");
                { const int tid = (wr * 4 + wc) * 64 + lane_fresh(), orow = tid >> 2, och = tid & 3;
                  const int t = u.pm * 256 + ai * 128 + orow; LAS float* rp = red + orow * 33 + 8 * och;
                  const f32x4 o0 = (f32x4){rp[0], rp[1], rp[2], rp[3]}, o1 = (f32x4){rp[4], rp[5], rp[6], rp[7]};
                  float* dst = PL + pl_idx(t) + u.pn * 32 + 8 * och; *(f32x4*)dst = o0; *(f32x4*)(dst + 4) = o1;
                  if (och == 0) { PL[pss_idx(t) + u.pn] = red[orow * 33 + 32]; red[orow * 33 + 32] = 0.f; }
#pragma unroll
                  for (int i = 0; i < 8; ++i) rp[i] = 0.f; }
                if (ai == 0) { asm volatile("s_waitcnt lgkmcnt(0)" ::: "memory"); __builtin_amdgcn_s_barrier(); asm volatile("" ::: "memory"); }
            }
        }
        if (ring_free) {
            asm volatile("s_waitcnt lgkmcnt(0)" ::: "memory"); __builtin_amdgcn_s_barrier(); asm volatile("" ::: "memory");
            const int tid = (wr * 4 + wc) * 64 + lane_fresh(), row = tid >> 1, eh = tid & 1; const LAS float* rp = (const LAS float*)ldsb + row * 33 + 16 * eh;
            f32x4 o[4];
#pragma unroll
            for (int j = 0; j < 4; ++j) o[j] = (f32x4){rp[4 * j], rp[4 * j + 1], rp[4 * j + 2], rp[4 * j + 3]};
#pragma unroll
            for (int w = 1; w < 4; ++w)
#pragma unroll
                for (int j = 0; j < 4; ++j) o[j] += (f32x4){rp[w * 8448 + 4 * j], rp[w * 8448 + 4 * j + 1], rp[w * 8448 + 4 * j + 2], rp[w * 8448 + 4 * j + 3]};
            const int t = u.pm * 256 + row; float* dst = PL + pl_idx(t) + u.pn * 32 + 16 * eh;
#pragma unroll
            for (int j = 0; j < 4; ++j) *(f32x4*)(dst + 4 * j) = o[j];
            if (eh == 0) { const LAS float* sp = (const LAS float*)ldsb + row * 33 + 32; PL[pss_idx(t) + u.pn] = (sp[0] + sp[8448]) + (sp[2 * 8448] + sp[3 * 8448]); }
        }
    }
};

struct EpiGU {
    static constexpr int MID_T = 0; static constexpr bool PF = true;
    __device__ __forceinline__ void prefetch(const pg8::Unit& u, LAS unsigned char* pf, int wid, int lane) const {
        if (wid == 0) { const float* src = bgu + (size_t)u.e * 2048 + 128 * u.pn + (lane < 32 ? 4 * lane : 1024 + 4 * (lane - 32)); __builtin_amdgcn_global_load_lds((const unsigned*)src, (LAS unsigned*)pf, 16, 0, 0); }
        else if (wid == 1) { const float* src = RS + (size_t)u.e * T_ + u.rows + 4 * lane; __builtin_amdgcn_global_load_lds((const unsigned*)src, (LAS unsigned*)(pf + 1024), 16, 0, 0); }
    }
    unsigned char* ACT; const float* bgu; const float* RS; const LAS int* cnt;
    __device__ __forceinline__ void mid(f32x4 (&)[2][2][4][2], const pg8::Unit&, int, int, int, int) const {}
    __device__ __forceinline__ void operator()(const f32x4 (&acc)[2][2][4][2], const pg8::Unit& u, int wr, int wc, int fr, int fq, LAS unsigned char* pf) const {
        const int row0 = u.pm * 256 + wr * 64 + fr, col = 128 * u.pn + 32 * wc + 8 * fq;
        const LAS float* pb = (const LAS float*)pf + 32 * wc + 8 * fq;
        f32x4 bgate[2], bup[2];
#pragma unroll
        for (int n = 0; n < 2; ++n) { bgate[n] = *(const LAS f32x4*)(pb + 4 * n); bup[n] = *(const LAS f32x4*)(pb + 128 + 4 * n); }
        const int ce = cnt[u.e]; const bool odd = (fq & 1) != 0; const int colw = 128 * u.pn + 32 * wc + 16 * (fq >> 1);
        float rsv[2][4];
#pragma unroll
        for (int ai = 0; ai < 2; ++ai)
#pragma unroll
            for (int m = 0; m < 4; ++m) { const int tr = ai * 128 + wr * 64 + m * 16 + fr; const float v = ((const LAS float*)(pf + 1024))[tr]; rsv[ai][m] = (u.rows + tr < ce) ? v * (1.f / 32.f) : 0.f; }
        const f32x2 one2 = {1.f, 1.f}, k2 = {-1.702f * LOG2E, -1.702f * LOG2E};
#pragma unroll
        for (int ai = 0; ai < 2; ++ai)
#pragma unroll
            for (int mp = 0; mp < 2; ++mp) { u32x2 pc[2];
#pragma unroll
                for (int mm = 0; mm < 2; ++mm) { const int m = 2 * mp + mm; f32x2 o[2][2];
                    const f32x2 rs2 = {rsv[ai][m], rsv[ai][m]};
#pragma unroll
                    for (int n = 0; n < 2; ++n)
#pragma unroll
                        for (int h = 0; h < 2; ++h) {
                            const f32x2 ga = {acc[ai][0][m][n][2 * h], acc[ai][0][m][n][2 * h + 1]}, ua = {acc[ai][1][m][n][2 * h], acc[ai][1][m][n][2 * h + 1]};
                            const f32x2 bg = {bgate[n][2 * h], bgate[n][2 * h + 1]}, bu = {bup[n][2 * h], bup[n][2 * h + 1]};
                            f32x2 gt = ga * rs2 + bg; gt.x = fminf(gt.x, 7.f); gt.y = fminf(gt.y, 7.f);
                            f32x2 up = ua * rs2 + bu; up.x = __builtin_amdgcn_fmed3f(up.x, -7.f, 7.f); up.y = __builtin_amdgcn_fmed3f(up.y, -7.f, 7.f);
                            const f32x2 t = gt * k2; f32x2 ex; ex.x = __builtin_amdgcn_exp2f(t.x); ex.y = __builtin_amdgcn_exp2f(t.y);
                            const f32x2 d = ex + one2; f32x2 r; r.x = __builtin_amdgcn_rcpf(d.x); r.y = __builtin_amdgcn_rcpf(d.y);
                            o[n][h] = ((up + one2) * gt) * r; }
                    pc[mm].x = pk4_fp8(o[0][0].x, o[0][0].y, o[0][1].x, o[0][1].y); pc[mm].y = pk4_fp8(o[1][0].x, o[1][0].y, o[1][1].x, o[1][1].y); }
                const u32x4 w16 = fp8_pair16(pc[0], pc[1], odd);
                NTST(ACT + (size_t)(row0 + ai * 128 + (2 * mp + (odd ? 1 : 0)) * 16) * 1024 + colw, w16); }
    }
};
struct EpiDN {
    static constexpr int MID_T = 0; static constexpr bool PF = true;
    __device__ __forceinline__ void prefetch(const pg8::Unit& u, LAS unsigned char* pf, int wid, int lane) const {
        if (wid == 0) { const float* src = bd + (size_t)u.e * 1024 + 256 * u.pn + 4 * lane; __builtin_amdgcn_global_load_lds((const unsigned*)src, (LAS unsigned*)pf, 16, 0, 0); }
    }
    unsigned char* YS; const float* bd;
    __device__ __forceinline__ void mid(f32x4 (&)[2][2][4][2], const pg8::Unit&, int, int, int, int) const {}
    __device__ __forceinline__ void operator()(const f32x4 (&acc)[2][2][4][2], const pg8::Unit& u, int wr, int wc, int fr, int fq, LAS unsigned char* pf) const {
        const int row0 = u.pm * 256 + wr * 64 + fr, col0 = 256 * u.pn + 32 * wc + 8 * fq;
        const LAS float* bb = (const LAS float*)pf + 32 * wc + 8 * fq;
        f32x4 bv[2][2];
#pragma unroll
        for (int bj = 0; bj < 2; ++bj)
#pragma unroll
            for (int n = 0; n < 2; ++n) bv[bj][n] = *(const LAS f32x4*)(bb + 128 * bj + 4 * n);
        const bool odd = (fq & 1) != 0; const int colw = 256 * u.pn + 32 * wc + 16 * (fq >> 1);
#pragma unroll
        for (int ai = 0; ai < 2; ++ai)
#pragma unroll
            for (int mp = 0; mp < 2; ++mp)
#pragma unroll
                for (int bj = 0; bj < 2; ++bj) { u32x2 pc[2];
#pragma unroll
                    for (int mm = 0; mm < 2; ++mm) { const int m = 2 * mp + mm; const f32x4 y0 = acc[ai][bj][m][0] * (1.f / 32.f) + bv[bj][0], y1 = acc[ai][bj][m][1] * (1.f / 32.f) + bv[bj][1];
                        pc[mm].x = pk4_fp8(clamp_fp8(y0[0]), clamp_fp8(y0[1]), clamp_fp8(y0[2]), clamp_fp8(y0[3])); pc[mm].y = pk4_fp8(clamp_fp8(y1[0]), clamp_fp8(y1[1]), clamp_fp8(y1[2]), clamp_fp8(y1[3])); }
                    const u32x4 w16 = fp8_pair16(pc[0], pc[1], odd);
                    NTST(YS + (size_t)(row0 + ai * 128 + (2 * mp + (odd ? 1 : 0)) * 16) * 1024 + colw + 128 * bj, w16); }
    }
};
namespace attn {
constexpr int KROW = 144;
constexpr int LDS_K = 0, LDS_V = 256 * KROW, LDS_BIAS = 147456, BIAS_STRIDE = 132;
constexpr int LDS_END = LDS_BIAS + 12 * BIAS_STRIDE * 4;
typedef short v4i16_t __attribute__((ext_vector_type(4)));
__device__ __forceinline__ s16x4 vtr(const LAS unsigned char* p) { return __builtin_bit_cast(s16x4, __builtin_amdgcn_ds_read_tr16_b64_v4i16((LAS v4i16_t*)p)); }

struct Pre { u32x4 k[4], v[4]; bf16x8 q0, q1; };
struct ItemP { int g, q, j; bool hasprev; };
__device__ __forceinline__ ItemP decode(int it) { ItemP p; p.j = it & 3; p.q = (it >> 2) & 127; p.g = it >> 9; const int nbm1 = (p.g == 0) ? 15 : (p.g == 1 ? 3 : 0); p.hasprev = (p.q & nbm1) != 0; return p; }
__device__ __forceinline__ void issue(Pre& P, const ItemP& I, const bf16* QG, const bf16* KG, const bf16* VG, int tid, int lane, int wave) {
    const size_t gofs = (size_t)I.g * T_ * 256 + I.j * 64;
    const bf16* Kg = KG + gofs; const bf16* Vg = VG + gofs; const bf16* Qg = QG + gofs;
    const int R0 = 128 * (I.q - 1), klo = I.hasprev ? 0 : 128;
#pragma unroll
    for (int it = 0; it < 4; ++it) {
        const int c = tid + it * 512, r = c >> 3, ch = c & 7;
        if (r >= klo) { P.k[it] = *(const u32x4*)(Kg + (size_t)(R0 + r) * 256 + ch * 8); P.v[it] = *(const u32x4*)(Vg + (size_t)(R0 + r) * 256 + ch * 8); }
    }
    const int ql = lane & 15, quad = lane >> 4, qi = 16 * wave + ql;
    const bf16* qp = Qg + (size_t)(128 * I.q + qi) * 256 + 8 * quad;
    P.q0 = *(const bf16x8*)(qp); P.q1 = *(const bf16x8*)(qp + 32);
}
__device__ __forceinline__ void commit(const Pre& P, const ItemP& I, LAS unsigned char* lds, int tid) {
    const int klo = I.hasprev ? 0 : 128;
#pragma unroll
    for (int it = 0; it < 4; ++it) {
        const int c = tid + it * 512, r = c >> 3, ch = c & 7;
        if (r >= klo) { *(LAS u32x4*)(lds + LDS_K + r * KROW + ch * 16) = P.k[it]; *(LAS u32x4*)(lds + LDS_V + r * KROW + ch * 16) = P.v[it]; }
    }
}
__device__ __forceinline__ void compute(LAS unsigned char* lds, const ItemP& I, const bf16x8 qf0, const bf16x8 qf1, bf16* OG, float* LSE, int lane, int wave) {
    const int g = I.g, q = I.q, j = I.j; const bool hasprev = I.hasprev;
    const int ql = lane & 15, quad = lane >> 4;
    const int qi = 16 * wave + ql;
    const LAS float* bias = (const LAS float*)(lds + LDS_BIAS) + (g * 4 + j) * BIAS_STRIDE;
    const LAS unsigned char* kbase = lds + LDS_K + ql * KROW + quad * 16;
    const LAS unsigned char* vbase = lds + LDS_V + (4 * quad + (ql >> 2)) * KROW + (ql & 3) * 8;
    const int sb = wave >> 1;
    f32x4 c0[5], c1[5]; float mx = -INFINITY;
#pragma unroll
    for (int k = 0; k < 5; ++k) {
        const int s = sb + k;
        if (hasprev || s >= 4) {
            const LAS unsigned char* kp = kbase + 32 * s * KROW;
            const bf16x8 k00 = *(const LAS bf16x8*)(kp), k01 = *(const LAS bf16x8*)(kp + 64);
            const bf16x8 k10 = *(const LAS bf16x8*)(kp + 16 * KROW), k11 = *(const LAS bf16x8*)(kp + 16 * KROW + 64);
            f32x4 a0 = (f32x4){0.f, 0.f, 0.f, 0.f}, a1 = (f32x4){0.f, 0.f, 0.f, 0.f};
            a0 = __builtin_amdgcn_mfma_f32_16x16x32_bf16(k00, qf0, a0, 0, 0, 0);
            a0 = __builtin_amdgcn_mfma_f32_16x16x32_bf16(k01, qf1, a0, 0, 0, 0);
            a1 = __builtin_amdgcn_mfma_f32_16x16x32_bf16(k10, qf0, a1, 0, 0, 0);
            a1 = __builtin_amdgcn_mfma_f32_16x16x32_bf16(k11, qf1, a1, 0, 0, 0);
            const int dbase = qi + 128 - (32 * s + 4 * quad);
            if (k >= 1 && k <= 3) {
                const LAS float* bp = bias + (dbase - 19);
#pragma unroll
                for (int i = 0; i < 4; ++i) { a0[i] += bp[19 - i]; a1[i] += bp[3 - i]; mx = fmaxf(mx, fmaxf(a0[i], a1[i])); }
            } else {
#pragma unroll
                for (int i = 0; i < 4; ++i) {
                    const int d0 = dbase - i, d1 = d0 - 16;
                    const float b0 = bias[min(max(d0, 0), 128)], b1 = bias[min(max(d1, 0), 128)];
                    a0[i] = ((unsigned)d0 <= 128u) ? a0[i] + b0 : -INFINITY; a1[i] = ((unsigned)d1 <= 128u) ? a1[i] + b1 : -INFINITY;
                    mx = fmaxf(mx, fmaxf(a0[i], a1[i]));
                }
            }
            c0[k] = a0; c1[k] = a1;
        } else { c0[k] = (f32x4){-INFINITY, -INFINITY, -INFINITY, -INFINITY}; c1[k] = c0[k]; }
    }
    mx = fmaxf(mx, __shfl_xor(mx, 16)); mx = fmaxf(mx, __shfl_xor(mx, 32));
    const float m = mx;
    float l = 0.f;
    f32x4 o[4];
#pragma unroll
    for (int dt = 0; dt < 4; ++dt) o[dt] = (f32x4){0.f, 0.f, 0.f, 0.f};
#pragma unroll
    for (int k = 0; k < 5; ++k) {
        const int s = sb + k;
        if (hasprev || s >= 4) {
            f32x4 p0, p1;
#pragma unroll
            for (int i = 0; i < 4; ++i) { p0[i] = __builtin_amdgcn_exp2f(c0[k][i] - m); p1[i] = __builtin_amdgcn_exp2f(c1[k][i] - m); l += p0[i] + p1[i]; }
            u32x4 pw; pw.x = pk2(p0[0], p0[1]); pw.y = pk2(p0[2], p0[3]); pw.z = pk2(p1[0], p1[1]); pw.w = pk2(p1[2], p1[3]);
            const bf16x8 pf = __builtin_bit_cast(bf16x8, pw);
            const LAS unsigned char* vp = vbase + 32 * s * KROW;
#pragma unroll
            for (int dt = 0; dt < 4; ++dt) {
                const s16x4 lo = vtr(vp + dt * 32), hi = vtr(vp + dt * 32 + 16 * KROW);
                const bf16x8 vf = (bf16x8){lo[0], lo[1], lo[2], lo[3], hi[0], hi[1], hi[2], hi[3]};
                o[dt] = __builtin_amdgcn_mfma_f32_16x16x32_bf16(vf, pf, o[dt], 0, 0, 0);
            }
        }
    }
    l += __shfl_xor(l, 16); l += __shfl_xor(l, 32);
    const float inv = __builtin_amdgcn_rcpf(l);
    const int tok = reint_row(g, 128 * q + qi);
    bf16* op = OG + (size_t)g * T_ * 256 + (size_t)tok * 256 + j * 64 + 4 * quad;
#pragma unroll
    for (int dt = 0; dt < 4; ++dt) { u32x2 w; w.x = pk2(o[dt][0] * inv, o[dt][1] * inv); w.y = pk2(o[dt][2] * inv, o[dt][3] * inv); *(u32x2*)(op + 16 * dt) = w; }
    if (quad == 0) LSE[(size_t)g * T_ * 4 + tok * 4 + j] = m + __builtin_amdgcn_logf(l);
}
__device__ __forceinline__ int item_of(int n, int xsel) { return xsel >= 0 ? ((n >> 6) * 512 + (16 * xsel + ((n >> 2) & 15)) * 4 + (n & 3)) : n; }
__device__ __forceinline__ void run(LAS unsigned char* lds, int first, int stride, int nitems, int xsel, const bf16* QG, const bf16* KG, const bf16* VG, bf16* OG, float* LSE, int tid, int lane, int wave) {
    if (first >= nitems) return;
    Pre P0, P1; ItemP I0 = decode(item_of(first, xsel)), I1 = I0;
    issue(P0, I0, QG, KG, VG, tid, lane, wave);
    if (first + stride < nitems) { I1 = decode(item_of(first + stride, xsel)); issue(P1, I1, QG, KG, VG, tid, lane, wave); }
    for (int it = first; it < nitems; it += 2 * stride) {
        { commit(P0, I0, lds, tid);
          const bf16x8 q0 = P0.q0, q1 = P0.q1; const ItemP C = I0;
          __syncthreads();
          if (it + 2 * stride < nitems) { I0 = decode(item_of(it + 2 * stride, xsel)); issue(P0, I0, QG, KG, VG, tid, lane, wave); }
          compute(lds, C, q0, q1, OG, LSE, lane, wave);
          __syncthreads(); }
        if (it + stride >= nitems) break;
        { commit(P1, I1, lds, tid);
          const bf16x8 q0 = P1.q0, q1 = P1.q1; const ItemP C = I1;
          __syncthreads();
          if (it + 3 * stride < nitems) { I1 = decode(item_of(it + 3 * stride, xsel)); issue(P1, I1, QG, KG, VG, tid, lane, wave); }
          compute(lds, C, q0, q1, OG, LSE, lane, wave);
          __syncthreads(); }
    }
}
}
constexpr int NWAVES = 8;
constexpr size_t MiB = 1u << 20;
constexpr size_t WS_CTL = 0, CTL_ZERO_BYTES = 256 * 1024;
constexpr size_t WS_WT1 = 2 * MiB;
constexpr size_t WS_WT2 = 17 * MiB;
constexpr size_t WS_WT3 = 20 * MiB;
constexpr size_t WS_WGU = 24 * MiB;
constexpr size_t WS_WD = 152 * MiB;
constexpr size_t WS_H = 216 * MiB;
constexpr size_t WS_U = 248 * MiB;
constexpr size_t WS_CB = 280 * MiB;
constexpr size_t WS_QG = 312 * MiB, WS_KG = 336 * MiB, WS_VG = 360 * MiB;
constexpr size_t WS_SGC = 384 * MiB, WS_RAT = 416 * MiB;
constexpr size_t WS_OG = 448 * MiB;
constexpr size_t WS_LSE = 472 * MiB;
constexpr size_t WS_A2 = 474 * MiB;
constexpr size_t WS_MERGED = 514 * MiB;
constexpr size_t WS_ACT = 546 * MiB;
constexpr size_t WS_YS = 690 * MiB;
constexpr size_t WS_LISTS = 834 * MiB;
constexpr size_t WS_TOKE = 836 * MiB, WS_TOKS = WS_TOKE + 256 * 1024, WS_TOKW = WS_TOKS + 256 * 1024;
constexpr size_t WS_BIAS2 = 837 * MiB;
constexpr size_t WS_WRI = 837 * MiB + 65536;
constexpr size_t WS_RS = 838 * MiB;
constexpr size_t WS_END = 840 * MiB;
constexpr int CW_TMO = 0, CW_BAR = 4096, CW_CNT = 8192, CNT_STRIDE = 32;
static_assert(EPI3_X1B == WS_U && EPI3_XG == WS_H && EPI3_WRI == WS_WRI && EPI3_PL == WS_ACT, "Epi3 offsets");
constexpr int RING_OFF = 0, RING_BYTES = 131072;
constexpr int LDSCTL_OFF = 153600, MISC_OFF = LDSCTL_OFF + 320;
constexpr int LDS_TOK = MISC_OFF + 128;
constexpr int LDS_BYTES = 163840;
constexpr int LDS_RX = 135168;

__device__ unsigned g_ctl[32768];
constexpr int CW_DONE = 12288, CW_FLAG = 12544, CW_FLAG_WORDS = 4 * 1024, CW_XCC = 16640;
typedef GAS unsigned gu32;
#define RLX_AGENT __ATOMIC_RELAXED, __HIP_MEMORY_SCOPE_AGENT
#define LDS_WAIT() asm volatile("s_waitcnt lgkmcnt(0)" ::: "memory")
#define VM_WAIT() asm volatile("s_waitcnt vmcnt(0)" ::: "memory")

#define XB_TMO      128
#define XB_XCNT(j)  (256  + 64 * (j))
#define XB_XSUB(j)  (1280 + 64 * (j))
#define XB_XGEN(j)  (2304 + 64 * (j))
#define XB_TOP      3328
#define XB_TOPGEN   3392
#define XCD_BAR_WORDS 3456
#define XB_SPIN_CAP (1u << 18)
__device__ __forceinline__ unsigned xb_ld(unsigned* p)              { return __hip_atomic_load(p, __ATOMIC_RELAXED, __HIP_MEMORY_SCOPE_AGENT); }
__device__ __forceinline__ unsigned xb_add(unsigned* p, unsigned v) { return __hip_atomic_fetch_add(p, v, __ATOMIC_RELAXED, __HIP_MEMORY_SCOPE_AGENT); }
__device__ __forceinline__ unsigned xb_xcc_id() { return (unsigned)__builtin_amdgcn_s_getreg((3 << 11) | 20) & 0xFu; }
#define XB_SPIN(cond, bar) do { unsigned _sp = 0; while (cond) { __builtin_amdgcn_s_sleep(1); \
    if ((++_sp & 255u) == 0u) { if (xb_ld(&(bar)[XB_TMO])) break; if (_sp > XB_SPIN_CAP) { atomicAdd(&(bar)[XB_TMO], 1u); break; } } } } while (0)
struct XcdBarrier { unsigned* bar; unsigned x; volatile LAS unsigned* st; unsigned wave; };
__device__ __forceinline__ XcdBarrier xcd_barrier_post(unsigned* bar, volatile LAS unsigned* st, unsigned wave) {
    XcdBarrier b; b.bar = bar; b.x = xb_xcc_id(); b.st = st; b.wave = wave;
    if (wave == 0u && lane_fresh() == 0) (void)xb_add(&bar[XB_XCNT(b.x)], 1u);
    return b;
}
__device__ __forceinline__ void xcd_barrier_complete(unsigned* bar, unsigned x, unsigned& nloc, unsigned& nx) {
    const unsigned G = gridDim.x * gridDim.y * gridDim.z;
    unsigned sum, cnt, mine, sp = 0u;
    for (;;) {
        sum = 0u; cnt = 0u; mine = 0u;
#pragma unroll
        for (unsigned j = 0; j < 16; ++j) { const unsigned c = xb_ld(&bar[XB_XCNT(j)]); sum += c; cnt += (c > 0u) ? 1u : 0u; mine = (j == x) ? c : mine; }
        if (sum == G) break;
        __builtin_amdgcn_s_sleep(1);
        if ((++sp & 255u) == 0u) { if (xb_ld(&bar[XB_TMO])) break; if (sp > XB_SPIN_CAP) { atomicAdd(&bar[XB_TMO], 1u); break; } }
    }
    nloc = mine > 0u ? mine : 1u; nx = cnt > 0u ? cnt : 1u;
}
__device__ __forceinline__ void xcd_barrier(const XcdBarrier& b) {
    asm volatile("s_waitcnt vmcnt(0)" ::: "memory");
    __syncthreads();
    if (b.wave == 0u && lane_fresh() == 0) {
        unsigned* bar = b.bar;
        __builtin_amdgcn_s_waitcnt(0);
        unsigned nloc = b.st[0], nx = b.st[1];
        if (nloc == 0u) { xcd_barrier_complete(bar, b.x, nloc, nx); b.st[0] = nloc; b.st[1] = nx; }
        const unsigned old = xb_add(&bar[XB_XSUB(b.x)], 1u);
        const unsigned gen = old / nloc;
        if (old + 1u == (gen + 1u) * nloc) {
            __builtin_amdgcn_fence(__ATOMIC_RELEASE, "agent");
            asm volatile("s_waitcnt vmcnt(0)" ::: "memory");
            const unsigned og = xb_add(&bar[XB_TOP], 1u);
            const unsigned tg = og / nx;
            if (og + 1u == (tg + 1u) * nx) xb_add(&bar[XB_TOPGEN], 1u);
            else XB_SPIN(xb_ld(&bar[XB_TOPGEN]) == tg, bar);
            __builtin_amdgcn_fence(__ATOMIC_ACQUIRE, "agent");
            xb_add(&bar[XB_XGEN(b.x)], 1u);
            asm volatile("s_waitcnt vmcnt(0)" ::: "memory");
        } else {
            asm volatile("buffer_inv sc1" ::: "memory");
            XB_SPIN(xb_ld(&bar[XB_XGEN(b.x)]) == gen, bar);
            asm volatile("s_waitcnt vmcnt(0)" ::: "memory");
        }
    }
    __syncthreads();
}
__device__ __forceinline__ void flag_signal(unsigned* f, unsigned wave, bool same_l2) {
    asm volatile("s_waitcnt vmcnt(0)" ::: "memory");
    __syncthreads();
    if (wave == 0u && lane_fresh() == 0) { if (!same_l2) __builtin_amdgcn_fence(__ATOMIC_RELEASE, "agent"); (void)xb_add(f, 1u); }
}
__device__ __forceinline__ void flag_wait(unsigned* f, unsigned target, unsigned* bar, unsigned wave, bool fresh) {
    if (wave == 0u && lane_fresh() == 0) { XB_SPIN(xb_ld(f) < target, bar); if (!fresh) __builtin_amdgcn_fence(__ATOMIC_ACQUIRE, "agent"); }
    __syncthreads();
}

struct Frame {
    LAS unsigned char* lds; volatile LAS unsigned* MISC; gu32* ctl;
    int tid, lane, wave, vcu, G;
    const float *x, *n1g, *w_in, *gq, *gk, *relb, *convw, *w_bc, *w_ba, *w_out, *n2g, *w_r, *b_r, *w_gu, *b_gu, *w_d, *b_d; float* out;
    GAS unsigned char* ws;
#define FP(name, type, off) __device__ __forceinline__ type* name() const { return (type*)(ws + (off)); }
    FP(WT1, bf16, WS_WT1) FP(WT2, bf16, WS_WT2) FP(WT3, bf16, WS_WT3) FP(WGU, bf16, WS_WGU) FP(WD, bf16, WS_WD) FP(H, bf16, WS_H) FP(U, bf16, WS_U) FP(CB, bf16, WS_CB)
    FP(QG, bf16, WS_QG) FP(KG, bf16, WS_KG) FP(VG, bf16, WS_VG) FP(SGC, bf16, WS_SGC) FP(RAT, bf16, WS_RAT) FP(OG, bf16, WS_OG) FP(A2, bf16, WS_A2) FP(MERGED, bf16, WS_MERGED)
    FP(ACT, bf16, WS_ACT) FP(YS, bf16, WS_YS) FP(LSE, float, WS_LSE) FP(BIAS2, float, WS_BIAS2) FP(TOKW, float, WS_TOKW) FP(RS, float, WS_RS) FP(LISTS, int, WS_LISTS) FP(TOKE, int, WS_TOKE)
    FP(TOKS, int, WS_TOKS) FP(WRI, bf16, WS_WRI) FP(X1B, bf16, WS_U) FP(PL, float, WS_ACT)
    __device__ __forceinline__ int* CNT() const { return (int*)g_ctl + CW_CNT; }
#undef FP
};
__device__ __forceinline__ float wave_sum(float v) {
#pragma unroll
    for (int o = 1; o < 64; o <<= 1) v += __shfl_xor(v, o);
    return v;
}
__device__ __forceinline__ float wave_max(float v) {
#pragma unroll
    for (int o = 1; o < 64; o <<= 1) v = fmaxf(v, __shfl_xor(v, o));
    return v;
}

struct P0Item { const float* src; int ldw; unsigned char* dst; int ldt; bool fp8; };
__device__ __forceinline__ void p0_load(const P0Item& I, f32x4 (&v)[8], int lane) {
    const float* s = I.src + (size_t)(lane >> 3) * I.ldw + 4 * (lane & 7);
#pragma unroll
    for (int i = 0; i < 8; ++i) v[i] = __builtin_nontemporal_load((const f32x4*)(s + (size_t)(8 * i) * I.ldw));
}
__device__ __forceinline__ void p0_finish(const P0Item& I, const f32x4 (&v)[8], LAS float* scr, int lane) {
    const float sc = I.fp8 ? 32.f : 1.f;
    { LAS float* w = scr + (4 * (lane & 7)) * 65 + (lane >> 3);
#pragma unroll
      for (int i = 0; i < 8; ++i) { const f32x4 x = v[i] * sc; w[0 * 65 + 8 * i] = x[0]; w[1 * 65 + 8 * i] = x[1]; w[2 * 65 + 8 * i] = x[2]; w[3 * 65 + 8 * i] = x[3]; } }
    LDS_WAIT(); asm volatile("" ::: "memory");
    const int c = lane & 7;
#pragma unroll
    for (int j = 0; j < 4; ++j) { const int n = (lane >> 3) + 8 * j; const LAS float* s = scr + n * 65 + 8 * c;
        if (I.fp8) { u32x2 o; o.x = pk4_fp8(clamp_fp8(s[0]), clamp_fp8(s[1]), clamp_fp8(s[2]), clamp_fp8(s[3])); o.y = pk4_fp8(clamp_fp8(s[4]), clamp_fp8(s[5]), clamp_fp8(s[6]), clamp_fp8(s[7]));
            *(GAS u32x2*)(I.dst + (size_t)n * I.ldt + 8 * c) = o; }
        else { u32x4 o; o.x = pk2(s[0], s[1]); o.y = pk2(s[2], s[3]); o.z = pk2(s[4], s[5]); o.w = pk2(s[6], s[7]);
            *(GAS u32x4*)(I.dst + ((size_t)n * I.ldt + 8 * c) * 2) = o; } }
    LDS_WAIT(); asm volatile("" ::: "memory");
}
__device__ __forceinline__ void rms_row_to_bf16(const float* xrow, const float* g, bf16* orow, int lane) {
    const GAS f32x4* xr = (const GAS f32x4*)xrow + lane; const GAS f32x4* gr = (const GAS f32x4*)g + lane;
    f32x4 v[4]; float s2 = 0.f;
#pragma unroll
    for (int j = 0; j < 4; ++j) { v[j] = xr[64 * j]; s2 += (v[j].x * v[j].x + v[j].y * v[j].y) + (v[j].z * v[j].z + v[j].w * v[j].w); }
    const float rstd = 1.f / sqrtf(wave_sum(s2) * (1.f / D_) + EPS);
    GAS unsigned long long* o8 = (GAS unsigned long long*)orow + lane;
#pragma unroll
    for (int j = 0; j < 4; ++j) { const f32x4 gg = gr[64 * j]; o8[64 * j] = (unsigned long long)pk2(v[j].x * rstd * gg.x, v[j].y * rstd * gg.y) | ((unsigned long long)pk2(v[j].z * rstd * gg.z, v[j].w * rstd * gg.w) << 32); }
}
constexpr int P0_I1 = (INW / 32) * 16, P0_I2A = 32 * 4, P0_I2B = 32 * 16, P0_I3 = 32 * 16, P0_I4 = NE * 64 * 16, P0_I5 = NE * 32 * 16;
constexpr int P0_NITEMS = P0_I1 + P0_I2A + P0_I2B + P0_I3 + P0_I4 + P0_I5;
#ifndef P0_D7
#define P0_D7 4500
#endif
constexpr int P0_DEFER7 = P0_D7;
#ifndef P1_ROUNDS
#define P1_ROUNDS 10
#endif
#ifndef P0_D1
#define P0_D1 45804
#endif
constexpr int P0_DEFER1 = P0_D1;
constexpr int P0_N0 = P0_NITEMS - P0_DEFER1 - P0_DEFER7;
static_assert(P0_DEFER7 <= P0_I5 && P0_N0 >= P0_I1, "P0 itself converts at least w_in (needed by GEMM1); W_down items only for the gate_up phase's idle CUs");
__device__ __forceinline__ P0Item p0_decode(Frame& F, int it) {
    P0Item I; int r = it;
    if (r < P0_I1) { const int gb = r >> 4, kb = r & 15; I.src = F.w_in + (size_t)(64 * kb) * INW + colmap1(32 * gb); I.ldw = INW; I.dst = (unsigned char*)(F.WT1() + (size_t)(32 * gb) * 1024 + 64 * kb); I.ldt = 1024; I.fp8 = false; return I; } r -= P0_I1;
    if (r < P0_I2A) { const int gb = r >> 2, kb = r & 3; I.src = F.w_ba + (size_t)(64 * kb) * 1024 + 32 * gb; I.ldw = 1024; I.dst = (unsigned char*)(F.WT2() + (size_t)(32 * gb) * K2 + 64 * kb); I.ldt = K2; I.fp8 = false; return I; } r -= P0_I2A;
    if (r < P0_I2B) { const int gb = r >> 4, kb = r & 15; I.src = F.w_bc + (size_t)(64 * kb) * 1024 + 32 * gb; I.ldw = 1024; I.dst = (unsigned char*)(F.WT2() + (size_t)(32 * gb) * K2 + 256 + 64 * kb); I.ldt = K2; I.fp8 = false; return I; } r -= P0_I2B;
    if (r < P0_I3) { const int gb = r >> 4, kb = r & 15; I.src = F.w_out + (size_t)(64 * kb) * 1024 + 32 * gb; I.ldw = 1024; I.dst = (unsigned char*)(F.WT3() + (size_t)(32 * gb) * 1024 + 64 * kb); I.ldt = 1024; I.fp8 = false; return I; } r -= P0_I3;
    if (r < P0_I4) { const int e = r >> 10, gb = (r >> 4) & 63, kb = r & 15; const int nphys = 32 * gb, pn = nphys >> 8, bj = (nphys >> 7) & 1, y = nphys & 127;
        I.src = F.w_gu + (size_t)e * 1024 * 2048 + (size_t)(64 * kb) * 2048 + (bj ? 1024 : 0) + 128 * pn + y; I.ldw = 2048;
        I.dst = (unsigned char*)F.WGU() + (size_t)e * 2048 * 1024 + (size_t)nphys * 1024 + 64 * kb; I.ldt = 1024; I.fp8 = true; return I; } r -= P0_I4;
    { const int e = r >> 9, gb = (r >> 4) & 31, kb = r & 15;
        I.src = F.w_d + (size_t)e * 1024 * 1024 + (size_t)(64 * kb) * 1024 + 32 * gb; I.ldw = 1024;
        I.dst = (unsigned char*)F.WD() + (size_t)e * 1024 * 1024 + (size_t)(32 * gb) * 1024 + 64 * kb; I.ldt = 1024; I.fp8 = true; return I; }
}
__device__ __forceinline__ void p0_items(Frame& F, int lo, int hi, int w, int nw) {
    LAS float* scr = (LAS float*)(F.lds + RING_OFF + F.wave * 16384);
    int it = lo + w; if (it >= hi) return;
    f32x4 va[8], vb[8];
    P0Item Ia = p0_decode(F, it), Ib = Ia;
    p0_load(Ia, va, F.lane);
    for (;;) {
        const bool hb = (it + nw) < hi;
        if (hb) { Ib = p0_decode(F, it + nw); p0_load(Ib, vb, F.lane); }
        p0_finish(Ia, va, scr, F.lane);
        if (!hb) break;
        it += nw;
        const bool ha = (it + nw) < hi;
        if (ha) { Ia = p0_decode(F, it + nw); p0_load(Ia, va, F.lane); }
        p0_finish(Ib, vb, scr, F.lane);
        if (!ha) break;
        it += nw;
    }
}
__device__ __forceinline__ void p0_prologue(Frame& F) {
    const int gw = F.vcu * NWAVES + F.wave, NGW = F.G * NWAVES;
    p0_items(F, 0, P0_N0, gw, NGW);
    for (int m = gw; m < T_; m += NGW) rms_row_to_bf16(F.x + (size_t)m * D_, F.n1g, F.H() + (size_t)m * D_, F.lane);
    for (int i = gw * 64 + F.lane; i < 32 * 1024; i += NGW * 64) {
        const int k = i >> 5, e = i & 31; const float w = F.n2g[k] * F.w_r[i];
        const unsigned h = pk2(w, 0.f) & 0xffffu; const float r = w - bf_lo(h);
        F.WRI()[e * WRS + k] = (bf16)h; F.WRI()[32 * WRS + e * WRS + k] = (bf16)(pk2(r, 0.f) & 0xffffu);
    }
    if (blockIdx.x == 0) {
        for (int i = F.tid; i < 12 * 129; i += NWAVES * 64) {
            const int hh = i / 129, dl = i % 129, g = hh >> 2, dil = (g == 0) ? 1 : (g == 1 ? 4 : 16), dist = dl * dil;
            int b;
            if (dist < 16) b = dist; else { const double xx = log((double)dist / 16.0) / log(128.0) * 16.0; b = 16 + (int)xx; if (b > 31) b = 31; }
            F.BIAS2()[hh * attn::BIAS_STRIDE + dl] = F.relb[b * 12 + hh] * LOG2E;
        }
    }
}

__device__ __forceinline__ void p2_load_bias(Frame& F) {
    for (int i = F.tid; i < 12 * attn::BIAS_STRIDE; i += NWAVES * 64) ((LAS float*)(F.lds + RING_OFF + attn::LDS_BIAS))[i] = F.BIAS2()[i];
}
__device__ __forceinline__ void p2_attn_conv(Frame& F, const bool load_bias) {
    LAS unsigned char* lds = F.lds + RING_OFF;
    static_assert(attn::LDS_BIAS >= 141312 && attn::LDS_END <= MISC_OFF, "bias table: above the GEMM ring and its prefetch slots, below the barrier state");
    if (load_bias) { p2_load_bias(F); __syncthreads(); }
    if (F.G == 256) attn::run(lds, F.vcu & 31, 32, 192, F.vcu >> 5, F.QG(), F.KG(), F.VG(), F.OG(), F.LSE(), F.tid, F.lane, F.wave);
    else attn::run(lds, F.vcu, F.G, 3 * 128 * 4, -1, F.QG(), F.KG(), F.VG(), F.OG(), F.LSE(), F.tid, F.lane, F.wave);
    const int ch = F.tid & 127;
    f32x4 w0[2], w1[2], w2[2];
#pragma unroll
    for (int h = 0; h < 2; ++h) { w0[h] = *(const f32x4*)(F.convw + 8 * ch + 4 * h); w1[h] = *(const f32x4*)(F.convw + 1024 + 8 * ch + 4 * h); w2[h] = *(const f32x4*)(F.convw + 2048 + 8 * ch + 4 * h); }
    for (int tile = F.vcu; tile < T_ / 64; tile += F.G) {
#pragma unroll 4
        for (int i = 0; i < 16; ++i) {
            const int t = tile * 64 + (F.tid >> 7) + 4 * i, s = t & 2047;
            const u32x4 z = (u32x4){0u, 0u, 0u, 0u};
            const u32x4 a0 = *(const u32x4*)(F.U() + (size_t)t * 1024 + 8 * ch);
            const u32x4 a1 = (s >= 1) ? *(const u32x4*)(F.U() + (size_t)(t - 1) * 1024 + 8 * ch) : z;
            const u32x4 a2 = (s >= 2) ? *(const u32x4*)(F.U() + (size_t)(t - 2) * 1024 + 8 * ch) : z;
            const u32x4 cb = *(const u32x4*)(F.CB() + (size_t)t * 1024 + 8 * ch);
            f32x4 r0, r1;
            r0[0] = bf_lo(cb.x) * (w2[0][0] * bf_lo(a0.x) + w1[0][0] * bf_lo(a1.x) + w0[0][0] * bf_lo(a2.x));
            r0[1] = bf_hi(cb.x) * (w2[0][1] * bf_hi(a0.x) + w1[0][1] * bf_hi(a1.x) + w0[0][1] * bf_hi(a2.x));
            r0[2] = bf_lo(cb.y) * (w2[0][2] * bf_lo(a0.y) + w1[0][2] * bf_lo(a1.y) + w0[0][2] * bf_lo(a2.y));
            r0[3] = bf_hi(cb.y) * (w2[0][3] * bf_hi(a0.y) + w1[0][3] * bf_hi(a1.y) + w0[0][3] * bf_hi(a2.y));
            r1[0] = bf_lo(cb.z) * (w2[1][0] * bf_lo(a0.z) + w1[1][0] * bf_lo(a1.z) + w0[1][0] * bf_lo(a2.z));
            r1[1] = bf_hi(cb.z) * (w2[1][1] * bf_hi(a0.z) + w1[1][1] * bf_hi(a1.z) + w0[1][1] * bf_hi(a2.z));
            r1[2] = bf_lo(cb.w) * (w2[1][2] * bf_lo(a0.w) + w1[1][2] * bf_lo(a1.w) + w0[1][2] * bf_lo(a2.w));
            r1[3] = bf_hi(cb.w) * (w2[1][3] * bf_hi(a0.w) + w1[1][3] * bf_hi(a1.w) + w0[1][3] * bf_hi(a2.w));
            *(u32x4*)(F.A2() + (size_t)t * K2 + 256 + 8 * ch) = pack8(r0, r1);
        }
    }
}
__device__ __forceinline__ void p2b_combine(Frame& F, const int tok0) {
    if (tok0 >= 0) {
        float l[4][3]; u32x4 og[4][3];
#pragma unroll
        for (int it = 0; it < 4; ++it) { const int idx = tok0 * 32 + it * 512 + F.tid, t = idx >> 5, c8 = idx & 31, j = c8 >> 3;
#pragma unroll
            for (int g = 0; g < 3; ++g) { l[it][g] = F.LSE()[(size_t)g * T_ * 4 + (size_t)t * 4 + j]; og[it][g] = *(const u32x4*)(F.OG() + (size_t)g * T_ * 256 + (size_t)t * 256 + 8 * c8); } }
#pragma unroll
        for (int it = 0; it < 4; ++it) { const int idx = tok0 * 32 + it * 512 + F.tid, t = idx >> 5, c8 = idx & 31;
            const float mx = fmaxf(l[it][0], fmaxf(l[it][1], l[it][2]));
            float e0 = __builtin_amdgcn_exp2f(l[it][0] - mx), e1 = __builtin_amdgcn_exp2f(l[it][1] - mx), e2 = __builtin_amdgcn_exp2f(l[it][2] - mx);
            const float inv = __builtin_amdgcn_rcpf(e0 + e1 + e2); e0 *= inv; e1 *= inv; e2 *= inv;
            const u32x4 a = og[it][0], b = og[it][1], c = og[it][2]; u32x4 w;
            w.x = pk2(e0 * bf_lo(a.x) + e1 * bf_lo(b.x) + e2 * bf_lo(c.x), e0 * bf_hi(a.x) + e1 * bf_hi(b.x) + e2 * bf_hi(c.x));
            w.y = pk2(e0 * bf_lo(a.y) + e1 * bf_lo(b.y) + e2 * bf_lo(c.y), e0 * bf_hi(a.y) + e1 * bf_hi(b.y) + e2 * bf_hi(c.y));
            w.z = pk2(e0 * bf_lo(a.z) + e1 * bf_lo(b.z) + e2 * bf_lo(c.z), e0 * bf_hi(a.z) + e1 * bf_hi(b.z) + e2 * bf_hi(c.z));
            w.w = pk2(e0 * bf_lo(a.w) + e1 * bf_lo(b.w) + e2 * bf_lo(c.w), e0 * bf_hi(a.w) + e1 * bf_hi(b.w) + e2 * bf_hi(c.w));
            *(u32x4*)(F.A2() + (size_t)t * K2 + 8 * c8) = w; }
        return;
    }
    const int gt = F.vcu * NWAVES * 64 + F.tid, NT = F.G * NWAVES * 64, iend = T_ * 32;
    for (int idx = gt; idx < iend; idx += NT) {
        const int t = idx >> 5, c8 = idx & 31, j = c8 >> 3;
        const float l0 = F.LSE()[(size_t)t * 4 + j], l1 = F.LSE()[(size_t)T_ * 4 + t * 4 + j], l2 = F.LSE()[(size_t)2 * T_ * 4 + t * 4 + j];
        const float mx = fmaxf(l0, fmaxf(l1, l2));
        float e0 = __builtin_amdgcn_exp2f(l0 - mx), e1 = __builtin_amdgcn_exp2f(l1 - mx), e2 = __builtin_amdgcn_exp2f(l2 - mx);
        const float inv = __builtin_amdgcn_rcpf(e0 + e1 + e2); e0 *= inv; e1 *= inv; e2 *= inv;
        const u32x4 a = *(const u32x4*)(F.OG() + (size_t)t * 256 + 8 * c8), b = *(const u32x4*)(F.OG() + (size_t)T_ * 256 + (size_t)t * 256 + 8 * c8), c = *(const u32x4*)(F.OG() + (size_t)2 * T_ * 256 + (size_t)t * 256 + 8 * c8);
        u32x4 w;
        w.x = pk2(e0 * bf_lo(a.x) + e1 * bf_lo(b.x) + e2 * bf_lo(c.x), e0 * bf_hi(a.x) + e1 * bf_hi(b.x) + e2 * bf_hi(c.x));
        w.y = pk2(e0 * bf_lo(a.y) + e1 * bf_lo(b.y) + e2 * bf_lo(c.y), e0 * bf_hi(a.y) + e1 * bf_hi(b.y) + e2 * bf_hi(c.y));
        w.z = pk2(e0 * bf_lo(a.z) + e1 * bf_lo(b.z) + e2 * bf_lo(c.z), e0 * bf_hi(a.z) + e1 * bf_hi(b.z) + e2 * bf_hi(c.z));
        w.w = pk2(e0 * bf_lo(a.w) + e1 * bf_lo(b.w) + e2 * bf_lo(c.w), e0 * bf_hi(a.w) + e1 * bf_hi(b.w) + e2 * bf_hi(c.w));
        *(u32x4*)(F.A2() + (size_t)t * K2 + 8 * c8) = w;
    }
}
__device__ __forceinline__ void p5_router(Frame& F, const int tile0) {
    LAS int* te = (LAS int*)(F.lds + LDS_TOK); LAS float* tw = (LAS float*)(F.lds + LDS_TOK + 1024); LAS int* rk = (LAS int*)(F.lds + LDS_TOK + 2048);
    LAS int* hist = (LAS int*)(F.lds + LDS_TOK + 3072); LAS int* base = hist + 32;
    LAS float* lgt = (LAS float*)(F.lds + LDS_RX + 9216); LAS float* rsl = lgt + 64 * 33;
    for (int tile = (tile0 >= 0 ? tile0 : F.vcu); tile < (tile0 >= 0 ? tile0 + 1 : T_ / 64); tile += F.G) {
        if (F.tid < 32) hist[F.tid] = 0;
        { const int tq = F.tid >> 3, part = F.tid & 7, t = tile * 64 + tq;
          const float* pl = F.PL() + pl_idx(t) + 4 * part;
          const f32x4 p0 = *(const f32x4*)pl, p1 = *(const f32x4*)(pl + 32), p2 = *(const f32x4*)(pl + 64), p3 = *(const f32x4*)(pl + 96);
          const f32x4 sq = *(const f32x4*)(F.PL() + pss_idx(t));
          const float rstd = 1.f / sqrtf(((sq[0] + sq[1]) + (sq[2] + sq[3])) * (1.f / D_) + EPS);
          const f32x4 br = *(const f32x4*)(F.b_r + 4 * part);
          const f32x4 lg = ((p0 + p1) + (p2 + p3)) * rstd + br;
          LAS float* lp = lgt + tq * 33 + 4 * part; lp[0] = lg[0]; lp[1] = lg[1]; lp[2] = lg[2]; lp[3] = lg[3];
          if (part == 0) rsl[tq] = rstd; }
        __syncthreads();
        if (F.tid < 64) {
            const LAS float* lp = lgt + F.tid * 33;
            float bv0 = -INFINITY, bv1 = -INFINITY, bv2 = -INFINITY, bv3 = -INFINITY; int bi0 = 0, bi1 = 0, bi2 = 0, bi3 = 0;
#pragma unroll 8
            for (int e = 0; e < 32; ++e) { const float d = lp[e];
                if (d > bv0) { bv3 = bv2; bi3 = bi2; bv2 = bv1; bi2 = bi1; bv1 = bv0; bi1 = bi0; bv0 = d; bi0 = e; }
                else if (d > bv1) { bv3 = bv2; bi3 = bi2; bv2 = bv1; bi2 = bi1; bv1 = d; bi1 = e; }
                else if (d > bv2) { bv3 = bv2; bi3 = bi2; bv2 = d; bi2 = e; }
                else if (d > bv3) { bv3 = d; bi3 = e; } }
            const float e1 = __expf(bv1 - bv0), e2 = __expf(bv2 - bv0), e3 = __expf(bv3 - bv0), inv = 1.f / (1.f + e1 + e2 + e3);
            te[F.tid * 4 + 0] = bi0; te[F.tid * 4 + 1] = bi1; te[F.tid * 4 + 2] = bi2; te[F.tid * 4 + 3] = bi3;
            tw[F.tid * 4 + 0] = inv; tw[F.tid * 4 + 1] = e1 * inv; tw[F.tid * 4 + 2] = e2 * inv; tw[F.tid * 4 + 3] = e3 * inv;
            rk[F.tid * 4 + 0] = atomicAdd((int*)&hist[bi0], 1); rk[F.tid * 4 + 1] = atomicAdd((int*)&hist[bi1], 1); rk[F.tid * 4 + 2] = atomicAdd((int*)&hist[bi2], 1); rk[F.tid * 4 + 3] = atomicAdd((int*)&hist[bi3], 1);
        }
        __syncthreads();
        if (F.tid < 32) base[F.tid] = (int)__hip_atomic_fetch_add((unsigned*)F.CNT() + CNT_STRIDE * F.tid, (unsigned)hist[F.tid], __ATOMIC_RELAXED, __HIP_MEMORY_SCOPE_AGENT);
        __syncthreads();
        if (F.tid < 256) {
            const int tq = F.tid >> 2, tk = tile * 64 + tq, e = te[F.tid], slot = base[e] + rk[F.tid];
            F.LISTS()[(size_t)e * T_ + slot] = tk; F.RS()[(size_t)e * T_ + slot] = rsl[tq];
            F.TOKE()[tk * 4 + (F.tid & 3)] = e; F.TOKS()[tk * 4 + (F.tid & 3)] = slot; F.TOKW()[tk * 4 + (F.tid & 3)] = tw[F.tid];
        }
        __syncthreads();
    }
}

struct MoeTable { LAS int* cnt; LAS int* tstart; LAS int* texp; };
__device__ __forceinline__ MoeTable moe_table(Frame& F, const bool reuse) {
    MoeTable M; M.cnt = (LAS int*)(F.lds + LDSCTL_OFF); M.tstart = M.cnt + 32; M.texp = (LAS int*)(F.lds + LDS_TOK);
    if (reuse) return M;
    if (F.tid < 64) {
        const int l = F.tid; int c = 0;
        if (l < 32) c = (int)__hip_atomic_load((unsigned*)F.CNT() + CNT_STRIDE * l, __ATOMIC_RELAXED, __HIP_MEMORY_SCOPE_AGENT);
        const int tl = (c + 255) >> 8; int inc = tl;
#pragma unroll
        for (int d = 1; d < 32; d <<= 1) { const int o = __shfl_up(inc, d); if (l >= d) inc += o; }
        if (l < 32) { M.cnt[l] = c; M.tstart[l] = inc - tl; for (int mt = inc - tl; mt < inc; ++mt) M.texp[mt] = l; }
        if (l == 31) M.tstart[32] = inc;
    }
    __syncthreads();
    return M;
}
template <int NN, bool GU>
struct MoeOrder {
    MoeTable M; const char* A; const char* Bt; const int* lists; int G, c, total;
    __device__ void init(const MoeTable& M_, const void* A_, const void* Bt_, const int* lists_, int G_, int c_) { M = M_; A = (const char*)A_; Bt = (const char*)Bt_; lists = lists_; G = G_; c = c_; total = M.tstart[32] * NN; }
    __device__ bool next(int i, pg8::Unit& u) const {
        const int L = i * G + c; if (L >= total) return false;
        const int mt = L / NN, pn = L % NN;
        const int e = M.texp[mt];
        u.pm = mt; u.pn = pn; u.e = e; u.rows = (mt - M.tstart[e]) * 256;
        u.b = Bt + ((size_t)e * (NN * 256) + (size_t)pn * 256) * 1024;
        u.a = GU ? A : A + (size_t)mt * 256 * 1024;
        return true;
    }
    __device__ __forceinline__ unsigned row_off(const pg8::Unit& u, int r) const {
        int lr = u.rows + r; const int ce = M.cnt[u.e]; if (lr >= ce) lr = 0;
        return (unsigned)lists[(size_t)u.e * T_ + lr] * 1024u;
    }
};

__device__ __forceinline__ void p8_final(Frame& F, const MoeTable& M) {
    const int gw = F.vcu * NWAVES + F.wave, NGW = F.G * NWAVES, lane = F.lane;
    for (int t = gw; t < T_; t += NGW) {
        int e4 = 0, s4 = 0; float w4 = 0.f;
        if (lane < 4) { e4 = F.TOKE()[t * 4 + lane]; s4 = F.TOKS()[t * 4 + lane]; w4 = F.TOKW()[t * 4 + lane]; }
        f32x4 a[4];
        GAS f32x4* op = (GAS f32x4*)(F.out + (size_t)t * D_) + 2 * lane;
        const bf16* xb = F.X1B() + (size_t)t * D_ + 8 * lane;
#pragma unroll
        for (int h = 0; h < 2; ++h) { const u32x4 xv = *(const u32x4*)(xb + 512 * h); a[2 * h] = (f32x4){bf_lo(xv.x), bf_hi(xv.x), bf_lo(xv.y), bf_hi(xv.y)}; a[2 * h + 1] = (f32x4){bf_lo(xv.z), bf_hi(xv.z), bf_lo(xv.w), bf_hi(xv.w)}; }
#pragma unroll
        for (int k = 0; k < 4; ++k) {
            const int e = __shfl(e4, k), sl = __shfl(s4, k); const float w = __shfl(w4, k);
            const unsigned char* yr = (const unsigned char*)F.YS() + ((size_t)M.tstart[e] * 256 + sl) * 1024 + 8 * lane;
#pragma unroll
            for (int h = 0; h < 2; ++h) { const u32x2 y = *(const u32x2*)(yr + 512 * h);
                const f32x2 p0 = __builtin_amdgcn_cvt_pk_f32_fp8((int)y.x, false), p1 = __builtin_amdgcn_cvt_pk_f32_fp8((int)y.x, true), p2 = __builtin_amdgcn_cvt_pk_f32_fp8((int)y.y, false), p3 = __builtin_amdgcn_cvt_pk_f32_fp8((int)y.y, true);
                a[2 * h] += w * (f32x4){p0[0], p0[1], p1[0], p1[1]}; a[2 * h + 1] += w * (f32x4){p2[0], p2[1], p3[0], p3[1]}; }
        }
#pragma unroll
        for (int h = 0; h < 2; ++h) { op[128 * h] = a[2 * h]; op[128 * h + 1] = a[2 * h + 1]; }
    }
}
struct Args { const float* in[17]; float* out; unsigned char* ws; int ph_lo, ph_hi; };
constexpr int N_PHASES = 10;
__global__ void __launch_bounds__(NWAVES * 64, 2) mk_fwd(Args args) {
    extern __shared__ __attribute__((aligned(16))) unsigned char lds[];
    Frame F;
    F.lds = (LAS unsigned char*)lds;
    F.MISC = (volatile LAS unsigned*)(F.lds + MISC_OFF);
    F.tid = threadIdx.x; F.lane = F.tid & 63; F.wave = __builtin_amdgcn_readfirstlane(F.tid >> 6);
    F.G = gridDim.x; { const int bx = blockIdx.x; F.vcu = (F.G % 8 == 0) ? (bx % 8) * (F.G / 8) + bx / 8 : bx; }
    unsigned char* ws = args.ws;
    F.ctl = (gu32*)g_ctl;
    F.x = args.in[0]; F.n1g = args.in[1]; F.w_in = args.in[2]; F.gq = args.in[3]; F.gk = args.in[4]; F.relb = args.in[5]; F.convw = args.in[6]; F.w_bc = args.in[7]; F.w_ba = args.in[8];
    F.w_out = args.in[9]; F.n2g = args.in[10]; F.w_r = args.in[11]; F.b_r = args.in[12]; F.w_gu = args.in[13]; F.b_gu = args.in[14]; F.w_d = args.in[15]; F.b_d = args.in[16]; F.out = args.out;
    F.ws = (GAS unsigned char*)ws;
    for (int u = F.tid; u < (LDS_BYTES - LDSCTL_OFF) / 4; u += NWAVES * 64) ((LAS unsigned*)(F.lds + LDSCTL_OFF))[u] = 0u;
    __syncthreads();
    const int lo = args.ph_lo, hi = args.ph_hi;
    const bool multi = (hi - lo) > 1;
    XcdBarrier bar; bar.bar = (unsigned*)(F.ctl + CW_BAR); bar.x = 0; bar.st = nullptr; bar.wave = (unsigned)F.wave;
    if (multi) bar = xcd_barrier_post((unsigned*)(F.ctl + CW_BAR), F.MISC + 8, (unsigned)F.wave);
#ifndef PH_MASK
#define PH_MASK 0x3ff
#endif
#define IN(k) (((PH_MASK >> (k)) & 1) && lo <= (k) && (k) < hi)
#ifdef TSEL
#define TSG ((GAS unsigned long long*)((GAS unsigned char*)args.ws + 65536))
#define TS_BEGIN(k) do { if ((k) == TSEL && (F.wave * 64 + lane_fresh()) == 0 && blockIdx.x == 0) TSG[0] = __builtin_amdgcn_s_memrealtime(); } while (0)
#define SEAM(k) do { if (IN(k) && IN((k) + 1)) xcd_barrier(bar); if ((k) == TSEL && (F.wave * 64 + lane_fresh()) == 0 && blockIdx.x == 0) TSG[1] = __builtin_amdgcn_s_memrealtime(); TS_BEGIN((k) + 1); } while (0)
#else
#define SEAM(k) do { if (IN(k) && IN((k) + 1)) xcd_barrier(bar); } while (0)
#endif
#ifdef TSEL
    TS_BEGIN(0);
#endif
#ifndef NO_FLAGS
    const bool fastseam = (F.G == 256) && multi && IN(0) && IN(1) && IN(2) && IN(3) && IN(4) && IN(5) && IN(6);
#else
    const bool fastseam = false;
#endif
    const int own_pm = ((int)blockIdx.x % 8) * 8 + ((int)blockIdx.x / 8) % 8, own_pn = (int)blockIdx.x / 64;
    if (multi && (F.wave * 64 + lane_fresh()) == 0) __hip_atomic_store(g_ctl + CW_XCC + (blockIdx.x & 255u), xb_xcc_id() + 1u, __ATOMIC_RELAXED, __HIP_MEMORY_SCOPE_AGENT);
    bool same_l2 = false;
#define FLAGW(k) ((unsigned*)(F.ctl + CW_FLAG + 1024 * (k) + 16 * own_pm))
#define SEAMF(k, j) do { if (fastseam) flag_signal(FLAGW(j), (unsigned)F.wave, same_l2); else SEAM(k); } while (0)
#define WAITF(j) do { if (fastseam) flag_wait(FLAGW(j), 4u, (unsigned*)(F.ctl + CW_BAR), (unsigned)F.wave, same_l2); } while (0)
#ifndef STAG1
#define STAG1 0
#endif
#ifndef STAG7
#define STAG7 0
#endif
#ifndef STAG8
#define STAG8 0
#endif
#define STAGGER(ticks_per_level) do { if ((ticks_per_level) > 0) { const unsigned long long t0_ = __builtin_amdgcn_s_memrealtime(); const unsigned long long w_ = (unsigned long long)(((unsigned)blockIdx.x >> 3) & 7u) * (unsigned)(ticks_per_level); \
        while (__builtin_amdgcn_s_memrealtime() - t0_ < w_) __builtin_amdgcn_s_sleep(8); } } while (0)
    if (IN(0)) { { GAS unsigned char* w_ = (GAS unsigned char*)args.ws; asm volatile("" : "+s"(w_)); F.ws = w_; int t_ = F.wave * 64 + lane_fresh(); F.tid = t_; F.lane = t_ & 63; } p0_prologue(F); } SEAM(0);
    if (fastseam) {
        const int i_ = (F.wave * 64 + lane_fresh()) & 255;
        const unsigned e_ = __hip_atomic_load(g_ctl + CW_XCC + i_, __ATOMIC_RELAXED, __HIP_MEMORY_SCOPE_AGENT), l_ = __hip_atomic_load(g_ctl + CW_XCC + (i_ & 7), __ATOMIC_RELAXED, __HIP_MEMORY_SCOPE_AGENT);
        const unsigned long long bal_ = __builtin_amdgcn_ballot_w64(e_ == l_ && e_ != 0u);
        if (lane_fresh() == 0) F.MISC[16 + F.wave] = (bal_ == ~0ull) ? 1u : 0u;
        __syncthreads();
        same_l2 = __builtin_amdgcn_readfirstlane((int)(F.MISC[16] & F.MISC[17] & F.MISC[18] & F.MISC[19])) != 0;
    }
    if (IN(1)) { { GAS unsigned char* w_ = (GAS unsigned char*)args.ws; asm volatile("" : "+s"(w_)); F.ws = w_; int t_ = F.wave * 64 + lane_fresh(); F.tid = t_; F.lane = t_ & 63; }
        p2_load_bias(F);
        constexpr int NU1 = (T_ / 256) * (INW / 256), R1 = P1_ROUNDS, G1 = (NU1 + R1 - 1) / R1;
        const int g1 = (F.G == 256) ? G1 : F.G;
        if ((int)blockIdx.x < g1) {
            STAGGER(STAG1);
            pg8::DenseOrder<T_ / 256, INW / 256> S; S.init(F.H(), F.WT1(), 2048, g1, (int)blockIdx.x);
            Epi1 E{F.U(), F.CB(), F.QG(), F.KG(), F.VG(), F.SGC(), F.RAT(), F.gq, F.gk};
            pg8::gemm_phase<Epi1, pg8::DenseOrder<T_ / 256, INW / 256>, true, false, false, 1>(F.lds + RING_OFF, 2048, S, E, F.wave);
        } else p0_items(F, P0_N0, P0_N0 + P0_DEFER1, ((int)blockIdx.x - g1) * NWAVES + F.wave, (F.G - g1) * NWAVES);
        if (g1 == F.G && F.G != 256) p0_items(F, P0_N0, P0_N0 + P0_DEFER1, (int)blockIdx.x * NWAVES + F.wave, F.G * NWAVES);
    } SEAM(1);
    if (IN(2)) { { GAS unsigned char* w_ = (GAS unsigned char*)args.ws; asm volatile("" : "+s"(w_)); F.ws = w_; int t_ = F.wave * 64 + lane_fresh(); F.tid = t_; F.lane = t_ & 63; } p2_attn_conv(F, !IN(1)); }
    if (fastseam && same_l2) { unsigned* lb_ = (unsigned*)(F.ctl + CW_FLAG + 3 * 1024 + 16 * (own_pm / 8)); flag_signal(lb_, (unsigned)F.wave, true); flag_wait(lb_, 32u, (unsigned*)(F.ctl + CW_BAR), (unsigned)F.wave, true); }
    else SEAM(2);
    if (IN(3)) { { GAS unsigned char* w_ = (GAS unsigned char*)args.ws; asm volatile("" : "+s"(w_)); F.ws = w_; int t_ = F.wave * 64 + lane_fresh(); F.tid = t_; F.lane = t_ & 63; } p2b_combine(F, fastseam ? own_pm * 256 + own_pn * 64 : -1); } SEAMF(3, 0);
    if (IN(4)) { { GAS unsigned char* w_ = (GAS unsigned char*)args.ws; asm volatile("" : "+s"(w_)); F.ws = w_; int t_ = F.wave * 64 + lane_fresh(); F.tid = t_; F.lane = t_ & 63; }
        WAITF(0);
        pg8::DenseOrder<T_ / 256, 4> S; S.init(F.A2(), F.WT2(), K2 * 2, F.G, (int)blockIdx.x);
        Epi2 E{F.SGC(), F.RAT(), F.MERGED()};
        pg8::gemm_phase<Epi2, pg8::DenseOrder<T_ / 256, 4>, true, false, false>(F.lds + RING_OFF, K2 * 2, S, E, F.wave);
    } SEAMF(4, 1);
    if (IN(5)) { { GAS unsigned char* w_ = (GAS unsigned char*)args.ws; asm volatile("" : "+s"(w_)); F.ws = w_; int t_ = F.wave * 64 + lane_fresh(); F.tid = t_; F.lane = t_ & 63; }
        WAITF(1);
        pg8::DenseOrder<T_ / 256, 4> S; S.init(F.MERGED(), F.WT3(), 2048, F.G, (int)blockIdx.x);
        Epi3 E{F.x, F.n2g, F.ws, F.lds, (long)(F.G >= 256)};
        pg8::gemm_phase<Epi3, pg8::DenseOrder<T_ / 256, 4>, true, false, false>(F.lds + RING_OFF, 2048, S, E, F.wave);
    } SEAMF(5, 2);
    if (IN(6)) { { GAS unsigned char* w_ = (GAS unsigned char*)args.ws; asm volatile("" : "+s"(w_)); F.ws = w_; int t_ = F.wave * 64 + lane_fresh(); F.tid = t_; F.lane = t_ & 63; } WAITF(2); p5_router(F, fastseam ? own_pm * 4 + own_pn : -1); } SEAM(6);
    if (IN(7)) { { GAS unsigned char* w_ = (GAS unsigned char*)args.ws; asm volatile("" : "+s"(w_)); F.ws = w_; int t_ = F.wave * 64 + lane_fresh(); F.tid = t_; F.lane = t_ & 63; }
        const MoeTable M = moe_table(F, false);
        const int tot7 = M.tstart[32] * 8, r7 = (tot7 + F.G - 1) / F.G, g7 = (tot7 + r7 - 1) / (r7 > 0 ? r7 : 1);
        if (F.vcu < g7) {
            STAGGER(STAG7);
            MoeOrder<8, true> S; S.init(M, F.H(), F.WGU(), F.LISTS(), g7, F.vcu);
            EpiGU E{(unsigned char*)F.ACT(), F.b_gu, F.RS(), M.cnt};
            pg8::gemm_phase<EpiGU, MoeOrder<8, true>, true, true, true, 7>(F.lds + RING_OFF, 1024, S, E, F.wave);
        } else p0_items(F, P0_N0 + P0_DEFER1, P0_NITEMS, (F.vcu - g7) * NWAVES + F.wave, (F.G - g7) * NWAVES);
        if (g7 >= F.G) p0_items(F, P0_N0 + P0_DEFER1, P0_NITEMS, F.vcu * NWAVES + F.wave, F.G * NWAVES);
    } SEAM(7);
    if (IN(8)) { { GAS unsigned char* w_ = (GAS unsigned char*)args.ws; asm volatile("" : "+s"(w_)); F.ws = w_; int t_ = F.wave * 64 + lane_fresh(); F.tid = t_; F.lane = t_ & 63; }
        const MoeTable M = moe_table(F, IN(7));
        STAGGER(STAG8);
        MoeOrder<4, false> S; S.init(M, F.ACT(), F.WD(), F.LISTS(), F.G, F.vcu);
        EpiDN E{(unsigned char*)F.YS(), F.b_d};
        pg8::gemm_phase<EpiDN, MoeOrder<4, false>, true, false, true, 8>(F.lds + RING_OFF, 1024, S, E, F.wave);
    } SEAM(8);
    if (IN(9)) { { GAS unsigned char* w_ = (GAS unsigned char*)args.ws; asm volatile("" : "+s"(w_)); F.ws = w_; int t_ = F.wave * 64 + lane_fresh(); F.tid = t_; F.lane = t_ & 63; } const MoeTable M = moe_table(F, IN(7) || IN(8)); p8_final(F, M); }
#ifdef TSEL
    xcd_barrier(bar);
    if (TSEL == 9 && (F.wave * 64 + lane_fresh()) == 0 && blockIdx.x == 0) TSG[1] = __builtin_amdgcn_s_memrealtime();
    if (blockIdx.x == 0 && (F.wave * 64 + lane_fresh()) == 0) { float dt_us = (float)(TSG[1] - TSG[0]) * 0.01f; if (TSEL < 0) dt_us = 100.f;
#ifdef TPW
        { const LAS unsigned* tpw = (const LAS unsigned*)(F.lds + 163840 - 64); dt_us = (float)tpw[TPW] * 0.01f / (float)(tpw[3] ? tpw[3] : 1u) * 10.f; }
#endif
        F.out[0] += dt_us * 0.1f; }
#endif
    if (multi) {
        __syncthreads();
        volatile LAS unsigned* lastf = F.MISC + 12;
        if ((F.wave * 64 + lane_fresh()) == 0) { const unsigned old = __hip_atomic_fetch_add(g_ctl + CW_DONE, 1u, __ATOMIC_RELAXED, __HIP_MEMORY_SCOPE_AGENT); lastf[0] = (old == (unsigned)F.G - 1u) ? 1u : 0u; }
        __syncthreads();
        if (lastf[0]) {
            for (int i = (F.wave * 64 + lane_fresh()); i < XCD_BAR_WORDS; i += NWAVES * 64) __hip_atomic_store(g_ctl + CW_BAR + i, 0u, __ATOMIC_RELAXED, __HIP_MEMORY_SCOPE_AGENT);
            for (int i = (F.wave * 64 + lane_fresh()); i < CW_FLAG_WORDS; i += NWAVES * 64) __hip_atomic_store(g_ctl + CW_FLAG + i, 0u, __ATOMIC_RELAXED, __HIP_MEMORY_SCOPE_AGENT);
            if ((F.wave * 64 + lane_fresh()) < 32) __hip_atomic_store(g_ctl + CW_CNT + CNT_STRIDE * (F.wave * 64 + lane_fresh()), 0u, __ATOMIC_RELAXED, __HIP_MEMORY_SCOPE_AGENT);
            if ((F.wave * 64 + lane_fresh()) == 0) { __hip_atomic_store(g_ctl + CW_TMO, 0u, __ATOMIC_RELAXED, __HIP_MEMORY_SCOPE_AGENT); __hip_atomic_store(g_ctl + CW_DONE, 0u, __ATOMIC_RELAXED, __HIP_MEMORY_SCOPE_AGENT); }
        }
    }
#undef IN
#undef SEAM
#undef SEAMF
#undef WAITF
#undef FLAGW
}

static int mk_grid = 0;
static int mk_setup() {
    if (mk_grid != 0) return mk_grid;
    int dev = 0, cus = 0, per_cu = 0;
    if (hipGetDevice(&dev) != hipSuccess || hipDeviceGetAttribute(&cus, hipDeviceAttributeMultiprocessorCount, dev) != hipSuccess) { mk_grid = -1; return mk_grid; }
    if (hipFuncSetAttribute((const void*)mk_fwd, hipFuncAttributeMaxDynamicSharedMemorySize, LDS_BYTES) != hipSuccess) { fprintf(stderr, "hipFuncSetAttribute failed\n"); mk_grid = -1; return mk_grid; }
    if (hipOccupancyMaxActiveBlocksPerMultiprocessor(&per_cu, (const void*)mk_fwd, NWAVES * 64, LDS_BYTES) != hipSuccess || per_cu < 1) { fprintf(stderr, "occupancy query: %d blocks/CU\n", per_cu); (void)hipGetLastError(); mk_grid = -1; return mk_grid; }
    mk_grid = cus;
    return mk_grid;
}
static void mk_launch(void* const* d_in, void* d_out, void* d_ws, hipStream_t stream, int lo, int hi) {
    const int grid = mk_setup(); if (grid <= 0) return;
    Args a{};
    for (int i = 0; i < 17; ++i) a.in[i] = (const float*)d_in[i];
    a.out = (float*)d_out; a.ws = (unsigned char*)d_ws; a.ph_lo = lo; a.ph_hi = hi;
    hipLaunchKernelGGL(mk_fwd, dim3(grid), dim3(NWAVES * 64), LDS_BYTES, stream, a);
}
extern "C" void kernel_launch(void* const* d_in, const int* in_sizes, int n_in, void* d_out, int out_size, void* d_ws, size_t ws_size, hipStream_t stream) {
    mk_launch(d_in, d_out, d_ws, stream, 0, N_PHASES);
}
```
